# Optimizing an MI355X kernel written in HIP

```python
import math
import jax, jax.numpy as jnp
from jax import lax
import numpy as np

D_MODEL = 1024
BATCH = 8
SEQ = 2048
DEPTH = 1

HEAD_DIM = 64
SWA_Q_HEADS = 8
SWA_KV_HEADS = 2
SWA_WINDOW = 128
SWA_BLOCK = 128
SWA_WIDTH = SWA_Q_HEADS * HEAD_DIM
SWA_KV_WIDTH = SWA_KV_HEADS * HEAD_DIM
MOBA_HEADS = 8
MOBA_BLOCK = 256
MOBA_TOPK = 3
MOBA_QCHUNK = 32
MOBA_WIDTH = MOBA_HEADS * HEAD_DIM
N_HEADS = SWA_Q_HEADS + MOBA_HEADS
MIX_WIDTH = SWA_WIDTH + MOBA_WIDTH
IN_COLS = SWA_WIDTH + 2 * SWA_KV_WIDTH + 3 * MOBA_WIDTH
ATTN_SCALE = HEAD_DIM ** -0.5
REL_BUCKETS = 32
REL_MAX_DIST = 1024
N_EXPERTS = 256
TOP_K = 8
N_GROUPS = 8
TOPK_GROUPS = 4
EXPERT_DIM = 256
SHARED_DIM = 256
ROUTED_SCALE = 2.5
MOE_BLOCK = 64
EPS = 1e-6
NEG_INF = -1e30

kernel_name = "hymba_swa_moba_moe_layer"


def rmsnorm(x, g):
    xf = x.astype(jnp.float32)
    y = xf * lax.rsqrt(jnp.mean(xf * xf, axis=-1, keepdims=True) + EPS)
    return (y * g.astype(jnp.float32)).astype(x.dtype)


def modulate(h, shift, scale):
    return h * (1.0 + scale[:, None, :]) + shift[:, None, :]


def t5_bucket(dist):
    n = jnp.maximum(dist, 0)
    max_exact = REL_BUCKETS // 2
    nf = jnp.maximum(n, 1).astype(jnp.float32)
    large = max_exact + (jnp.log(nf / max_exact) / math.log(REL_MAX_DIST / max_exact)
                         * (REL_BUCKETS - max_exact)).astype(jnp.int32)
    large = jnp.minimum(large, REL_BUCKETS - 1)
    return jnp.where(n < max_exact, n, large)


def swa_attention(q, k, v, sinks, rel_table):
    B, S = q.shape[0], q.shape[1]
    nb = S // SWA_BLOCK
    G = SWA_Q_HEADS // SWA_KV_HEADS
    qb = q.reshape(B, nb, SWA_BLOCK, SWA_KV_HEADS, G, HEAD_DIM)
    kb = k.reshape(B, nb, SWA_BLOCK, SWA_KV_HEADS, HEAD_DIM)
    vb = v.reshape(B, nb, SWA_BLOCK, SWA_KV_HEADS, HEAD_DIM)
    prev = lambda t: jnp.concatenate([jnp.zeros_like(t[:, :1]), t[:, :-1]], axis=1)
    kk = jnp.concatenate([prev(kb), kb], axis=2)
    vv = jnp.concatenate([prev(vb), vb], axis=2)
    qi = jnp.arange(SWA_BLOCK)[:, None]
    kj = jnp.arange(2 * SWA_BLOCK)[None, :]
    dist = qi + SWA_BLOCK - kj
    in_band = (dist >= 0) & (dist < SWA_WINDOW)
    bias = jnp.transpose(rel_table.astype(jnp.float32)[t5_bucket(dist)], (2, 0, 1))
    bias = bias.reshape(SWA_KV_HEADS, G, SWA_BLOCK, 2 * SWA_BLOCK)
    has_prev = (jnp.arange(nb)[:, None, None] > 0) | (kj[None] >= SWA_BLOCK)
    valid = in_band[None] & has_prev
    logits = jnp.einsum('bnqhgd,bnkhd->bnhgqk', qb, kk).astype(jnp.float32) * ATTN_SCALE + bias
    logits = jnp.where(valid[None, :, None, None], logits, NEG_INF)
    sink_col = jnp.broadcast_to(sinks.astype(jnp.float32).reshape(1, 1, SWA_KV_HEADS, G, 1, 1),
                                logits.shape[:-1] + (1,))
    probs = jax.nn.softmax(jnp.concatenate([logits, sink_col], axis=-1), axis=-1)[..., :-1]
    out = jnp.einsum('bnhgqk,bnkhd->bnqhgd', probs.astype(v.dtype), vv)
    return out.reshape(B, S, SWA_WIDTH)


def moba_attention(q, k, v, rel_table):
    B, S, H, dh = q.shape
    Sp = -(-S // MOBA_BLOCK) * MOBA_BLOCK
    pad = ((0, 0), (0, Sp - S), (0, 0), (0, 0))
    q, k, v = jnp.pad(q, pad), jnp.pad(k, pad), jnp.pad(v, pad)
    nb = Sp // MOBA_BLOCK
    kb = k.reshape(B, nb, MOBA_BLOCK, H, dh).transpose(0, 3, 1, 2, 4)
    vb = v.reshape(B, nb, MOBA_BLOCK, H, dh).transpose(0, 3, 1, 2, 4)
    kmean = jnp.mean(kb.astype(jnp.float32), axis=3)
    gate = jnp.einsum('bshd,bhnd->bshn', q.astype(jnp.float32), kmean)
    qblk = jnp.arange(Sp) // MOBA_BLOCK
    past = jnp.arange(nb)[None, :] < qblk[:, None]
    gate = jnp.where(past[None, :, None, :], gate, -jnp.inf)
    k_sel = min(MOBA_TOPK, nb)
    _, sel = lax.top_k(gate, k_sel)
    sel_valid = jnp.arange(k_sel)[None, :] < qblk[:, None]

    nc = Sp // MOBA_QCHUNK
    qc = q.reshape(B, nc, MOBA_QCHUNK, H, dh).transpose(1, 0, 2, 3, 4)
    selc = sel.reshape(B, nc, MOBA_QCHUNK, H, k_sel).transpose(1, 0, 2, 3, 4)
    validc = sel_valid.reshape(nc, MOBA_QCHUNK, k_sel)
    table_h = rel_table.astype(jnp.float32).T
    b_idx = jnp.arange(B)[:, None, None, None]
    h_idx = jnp.arange(H)[None, None, :, None]
    t_off = jnp.arange(MOBA_BLOCK)

    def chunk(args):
        qx, sx, vx, ci = args
        qpos = ci * MOBA_QCHUNK + jnp.arange(MOBA_QCHUNK)
        kg = kb[b_idx, h_idx, sx]
        vg = vb[b_idx, h_idx, sx]
        kpos = sx[..., None] * MOBA_BLOCK + t_off
        dist_g = qpos[None, :, None, None, None] - kpos
        bias_g = table_h[h_idx[..., None], t5_bucket(dist_g)]
        lg = jnp.einsum('bqhd,bqhskd->bqhsk', qx, kg).astype(jnp.float32) * ATTN_SCALE + bias_g
        lg = jnp.where(vx[None, :, None, :, None], lg, NEG_INF)
        ob = (ci * MOBA_QCHUNK) // MOBA_BLOCK
        ko = lax.dynamic_index_in_dim(kb, ob, axis=2, keepdims=False)
        vo = lax.dynamic_index_in_dim(vb, ob, axis=2, keepdims=False)
        dist_o = qpos[:, None] - (ob * MOBA_BLOCK + t_off)[None, :]
        bias_o = table_h[:, t5_bucket(dist_o)].transpose(1, 0, 2)
        lo = jnp.einsum('bqhd,bhkd->bqhk', qx, ko).astype(jnp.float32) * ATTN_SCALE + bias_o[None]
        lo = jnp.where((dist_o >= 0)[None, :, None, :], lo, NEG_INF)
        n_g = k_sel * MOBA_BLOCK
        logits = jnp.concatenate([lg.reshape(B, MOBA_QCHUNK, H, n_g), lo], axis=-1)
        p = jax.nn.softmax(logits, axis=-1).astype(vo.dtype)
        pg = p[..., :n_g].reshape(B, MOBA_QCHUNK, H, k_sel, MOBA_BLOCK)
        return (jnp.einsum('bqhsk,bqhskd->bqhd', pg, vg)
                + jnp.einsum('bqhk,bhkd->bqhd', p[..., n_g:], vo))

    outs = lax.map(chunk, (qc, selc, validc, jnp.arange(nc)))
    return outs.transpose(1, 0, 2, 3, 4).reshape(B, Sp, H * dh)[:, :S]


def moe_ffn(h, w_router, e_bias, w1, w3, w2, ws1, ws3, ws2):
    B, S, D = h.shape
    N = B * S
    x = h.reshape(N, D)
    scores = jax.nn.sigmoid(x.astype(jnp.float32) @ w_router.astype(jnp.float32))
    sel_scores = scores + e_bias.astype(jnp.float32)
    per_group = N_EXPERTS // N_GROUPS
    grp_score = lax.top_k(sel_scores.reshape(N, N_GROUPS, per_group), 2)[0].sum(-1)
    _, gidx = lax.top_k(grp_score, TOPK_GROUPS)
    gmask = jnp.any(gidx[:, :, None] == jnp.arange(N_GROUPS)[None, None, :], axis=1)
    masked = jnp.where(jnp.repeat(gmask, per_group, axis=1), sel_scores, -jnp.inf)
    _, eidx = lax.top_k(masked, TOP_K)
    w = jnp.take_along_axis(scores, eidx, axis=-1)
    w = w / jnp.sum(w, axis=-1, keepdims=True) * ROUTED_SCALE

    A = N * TOP_K
    flat_e = eidx.reshape(A)
    flat_tok = jnp.arange(A, dtype=jnp.int32) // TOP_K
    flat_w = w.reshape(A)
    order = jnp.argsort(flat_e)
    se, stok, sw = flat_e[order], flat_tok[order], flat_w[order]
    counts = jax.ops.segment_sum(jnp.ones((A,), jnp.int32), flat_e, num_segments=N_EXPERTS)
    starts = jnp.cumsum(counts) - counts
    pcounts = (counts + MOE_BLOCK - 1) // MOE_BLOCK * MOE_BLOCK
    pends = jnp.cumsum(pcounts)
    pstarts = pends - pcounts
    dest = pstarts[se] + (jnp.arange(A, dtype=jnp.int32) - starts[se])
    P = A + N_EXPERTS * MOE_BLOCK
    nblk = P // MOE_BLOCK
    buf_tok = jnp.full((P,), N, jnp.int32).at[dest].set(stok)
    buf_w = jnp.zeros((P,), jnp.float32).at[dest].set(sw)
    blk_e = jnp.minimum(jnp.searchsorted(pends, jnp.arange(nblk) * MOE_BLOCK, side='right'),
                        N_EXPERTS - 1)
    xpad = jnp.concatenate([x, jnp.zeros((1, D), x.dtype)], axis=0)

    def expert_rows(args):
        tok, e = args
        xb = xpad[tok]
        return (jax.nn.silu(xb @ w1[e]) * (xb @ w3[e])) @ w2[e]

    ys = lax.map(expert_rows, (buf_tok.reshape(nblk, MOE_BLOCK), blk_e)).reshape(P, D)
    ys = ys * buf_w[:, None].astype(ys.dtype)
    routed = jnp.zeros((N + 1, D), ys.dtype).at[buf_tok].add(ys)[:N]
    shared = (jax.nn.silu(x @ ws1) * (x @ ws3)) @ ws2
    return (routed + shared).reshape(B, S, D)


def setup_inputs(seed: int = 0) -> dict:
    key = jax.random.key(seed)
    ks = jax.random.split(key, 24)
    D, L = D_MODEL, DEPTH
    nrm = lambda k, shape, s: jax.random.normal(k, shape, jnp.float32) * s
    return {
        "x": nrm(ks[0], (BATCH, SEQ, D), 1.0),
        "c": nrm(ks[1], (BATCH, D), 1.0),
        "w_ada": nrm(ks[2], (L, D, 6 * D), 0.5 * D ** -0.5),
        "b_ada": nrm(ks[3], (L, 6 * D), 0.02),
        "norm1_g": 1.0 + nrm(ks[4], (L, D), 0.05),
        "w_in": nrm(ks[5], (L, D, IN_COLS), D ** -0.5),
        "sinks": nrm(ks[6], (L, SWA_Q_HEADS), 1.0),
        "rel_table": nrm(ks[7], (REL_BUCKETS, N_HEADS), 0.3),
        "out_norm_a": 1.0 + nrm(ks[8], (L, SWA_WIDTH), 0.05),
        "out_norm_b": 1.0 + nrm(ks[9], (L, MOBA_WIDTH), 0.05),
        "w_out": nrm(ks[10], (L, MIX_WIDTH, D), MIX_WIDTH ** -0.5),
        "norm2_g": 1.0 + nrm(ks[11], (L, D), 0.05),
        "w_router": nrm(ks[12], (L, D, N_EXPERTS), D ** -0.5),
        "e_bias": nrm(ks[13], (L, N_EXPERTS), 0.01),
        "w1": nrm(ks[14], (L, N_EXPERTS, D, EXPERT_DIM), D ** -0.5),
        "w3": nrm(ks[15], (L, N_EXPERTS, D, EXPERT_DIM), D ** -0.5),
        "w2": nrm(ks[16], (L, N_EXPERTS, EXPERT_DIM, D), EXPERT_DIM ** -0.5),
        "ws1": nrm(ks[17], (L, D, SHARED_DIM), D ** -0.5),
        "ws3": nrm(ks[18], (L, D, SHARED_DIM), D ** -0.5),
        "ws2": nrm(ks[19], (L, SHARED_DIM, D), SHARED_DIM ** -0.5),
        "final_g": 1.0 + nrm(ks[20], (D,), 0.05),
    }


def reference(x, c, w_ada, b_ada, norm1_g, w_in, sinks, rel_table, out_norm_a, out_norm_b,
              w_out, norm2_g, w_router, e_bias, w1, w3, w2, ws1, ws3, ws2, final_g):
    B, S, _ = x.shape
    c_act = jax.nn.silu(c)
    splits = [SWA_WIDTH, SWA_WIDTH + SWA_KV_WIDTH, SWA_WIDTH + 2 * SWA_KV_WIDTH,
              SWA_WIDTH + 2 * SWA_KV_WIDTH + MOBA_WIDTH,
              SWA_WIDTH + 2 * SWA_KV_WIDTH + 2 * MOBA_WIDTH]
    rel_a = rel_table[:, :SWA_Q_HEADS]
    rel_b = rel_table[:, SWA_Q_HEADS:]
    for l in range(DEPTH):
        mod = c_act @ w_ada[l] + b_ada[l]
        sh1, sc1, g1, sh2, sc2, g2 = jnp.split(mod, 6, axis=-1)
        h = modulate(rmsnorm(x, norm1_g[l]), sh1, sc1)
        proj = h @ w_in[l]
        qa, ka, va, qb, kb, vb = jnp.split(proj, splits, axis=-1)
        ya = swa_attention(qa.reshape(B, S, SWA_Q_HEADS, HEAD_DIM),
                           ka.reshape(B, S, SWA_KV_HEADS, HEAD_DIM),
                           va.reshape(B, S, SWA_KV_HEADS, HEAD_DIM), sinks[l], rel_a)
        yb = moba_attention(qb.reshape(B, S, MOBA_HEADS, HEAD_DIM),
                            kb.reshape(B, S, MOBA_HEADS, HEAD_DIM),
                            vb.reshape(B, S, MOBA_HEADS, HEAD_DIM), rel_b)
        y = jnp.concatenate([rmsnorm(ya, out_norm_a[l]), rmsnorm(yb, out_norm_b[l])], axis=-1) @ w_out[l]
        x = x + g1[:, None, :] * y
        h2 = modulate(rmsnorm(x, norm2_g[l]), sh2, sc2)
        x = x + g2[:, None, :] * moe_ffn(h2, w_router[l], e_bias[l], w1[l], w3[l], w2[l],
                                          ws1[l], ws3[l], ws2[l])
    return rmsnorm(x, final_g)
```

```cpp
#include <hip/hip_runtime.h>
#include <cstdio>
#include <cstdint>

constexpr int D = 1024, NB = 8, S = 2048, NTOK = NB * S;
constexpr int HD = 64, INC = 2304;
constexpr int NE = 256, TOPK = 8, ED = 256;
constexpr float EPS = 1e-6f;
constexpr float LOG2E = 1.4426950408889634f;
constexpr float QSCALE = 0.125f * LOG2E;
constexpr float NEGBIG = -1e30f;

typedef unsigned short bf16;
__device__ __forceinline__ float bf2f(bf16 v) { return __uint_as_float(((unsigned)v) << 16); }
__device__ __forceinline__ bf16 f2bf(float f) { unsigned u = __float_as_uint(f); return (bf16)((u + 0x7fffu + ((u >> 16) & 1u)) >> 16); }

constexpr size_t MiB = 1u << 20;
constexpr size_t WS_CTL   = 0;
constexpr size_t CTL_BYTES = 1 * MiB;
constexpr size_t C_MOD   = 64 * 1024;
constexpr size_t C_KSUM  = 320 * 1024;
constexpr size_t C_SSQA  = 512 * 1024;
constexpr size_t C_SSQB  = 576 * 1024;
constexpr size_t C_CNT   = 640 * 1024;
constexpr size_t WS_LUT  = 1 * MiB;
constexpr size_t WS_H    = 2 * MiB;
constexpr size_t WS_QA   = 34 * MiB;
constexpr size_t WS_KA   = 50 * MiB;
constexpr size_t WS_VAT  = 54 * MiB;
constexpr size_t WS_QB   = 58 * MiB;
constexpr size_t WS_KB   = 74 * MiB;
constexpr size_t WS_VBT  = 90 * MiB;
constexpr size_t WS_ATT  = 106 * MiB;
constexpr size_t WS_X1   = 138 * MiB;
constexpr size_t WS_H2   = 202 * MiB;
constexpr size_t WS_EW   = 234 * MiB;
constexpr size_t WS_LIST = 236 * MiB;
constexpr size_t WS_YSH  = 256 * MiB;
constexpr size_t WS_YBUF = 288 * MiB;
constexpr size_t WS_END  = 544 * MiB;

constexpr int LUT_NEG = 256;
constexpr int LUTN = 2560;

__device__ __forceinline__ int t5_bucket(int n) {
    if (n < 16) return n;
    const int thr[15] = {21, 27, 35, 46, 59, 77, 99, 128, 166, 216, 280, 363, 470, 609, 790};
    int b = 16;
#pragma unroll
    for (int i = 0; i < 15; ++i) b += (n >= thr[i]) ? 1 : 0;
    return b;
}

__global__ void k_mod(const float* c, const float* w_ada, const float* b_ada, float* mod) {
    int j = blockIdx.x * blockDim.x + threadIdx.x;
    if (j >= 6 * D) return;
    float acc[NB];
#pragma unroll
    for (int b = 0; b < NB; ++b) acc[b] = 0.f;
    for (int k = 0; k < D; ++k) {
        float w = w_ada[(size_t)k * 6 * D + j];
#pragma unroll
        for (int b = 0; b < NB; ++b) { float cv = c[b * D + k]; float sv = cv / (1.f + __expf(-cv)); acc[b] += sv * w; }
    }
#pragma unroll
    for (int b = 0; b < NB; ++b) mod[b * 6 * D + j] = acc[b] + b_ada[j];
}
__global__ void k_lut(const float* rel_table, float* lut) {
    int i = blockIdx.x * blockDim.x + threadIdx.x;
    if (i >= 16 * LUTN) return;
    int h = i / LUTN, p = i % LUTN, dist = p - LUT_NEG;
    float v = NEGBIG;
    bool ok = dist >= 0 && (h < 8 ? dist < 128 : dist < S);
    if (ok) v = rel_table[t5_bucket(dist) * 16 + h] * LOG2E;
    lut[i] = v;
}
__global__ void k_norm_mod(const float* x, const float* g, const float* mod, int sh_off, int sc_off, bf16* out) {
    int t = blockIdx.x, b = t / S, tid = threadIdx.x;
    __shared__ float red[256];
    float v[4]; float s = 0.f;
#pragma unroll
    for (int i = 0; i < 4; ++i) { v[i] = x[(size_t)t * D + tid + 256 * i]; s += v[i] * v[i]; }
    red[tid] = s; __syncthreads();
    for (int o = 128; o > 0; o >>= 1) { if (tid < o) red[tid] += red[tid + o]; __syncthreads(); }
    float rstd = rsqrtf(red[0] / D + EPS);
#pragma unroll
    for (int i = 0; i < 4; ++i) { int col = tid + 256 * i;
        float hv = v[i] * rstd * g[col] * (1.f + mod[b * 6 * D + sc_off + col]) + mod[b * 6 * D + sh_off + col];
        out[(size_t)t * D + col] = f2bf(hv); }
}
__global__ void k_inproj(const bf16* h, const float* w_in, bf16* QA, bf16* KA, bf16* VAT, bf16* QB, bf16* KB, bf16* VBT, float* ksum) {
    int col = blockIdx.x * blockDim.x + threadIdx.x;
    int t = blockIdx.y;
    if (col >= INC) return;
    float acc = 0.f;
    const bf16* hr = h + (size_t)t * D;
    for (int k = 0; k < D; ++k) acc += bf2f(hr[k]) * w_in[(size_t)k * INC + col];
    int b = t / S, s = t % S;
    if (col < 512) { int hh = col / 64, d = col % 64; QA[(((size_t)b * 8 + hh) * S + s) * 64 + d] = f2bf(acc * QSCALE); }
    else if (col < 640) { int c2 = col - 512, hh = c2 / 64, d = c2 % 64; KA[(((size_t)b * 2 + hh) * S + s) * 64 + d] = f2bf(acc); }
    else if (col < 768) { int c2 = col - 640, hh = c2 / 64, d = c2 % 64; VAT[(((size_t)b * 2 + hh) * 64 + d) * S + s] = f2bf(acc); }
    else if (col < 1280) { int c2 = col - 768, hh = c2 / 64, d = c2 % 64; QB[(((size_t)b * 8 + hh) * S + s) * 64 + d] = f2bf(acc * QSCALE); }
    else if (col < 1792) { int c2 = col - 1280, hh = c2 / 64, d = c2 % 64; bf16 kb = f2bf(acc); KB[(((size_t)b * 8 + hh) * S + s) * 64 + d] = kb;
        atomicAdd(&ksum[(((size_t)b * 8 + hh) * 8 + s / 256) * 64 + d], bf2f(kb)); }
    else { int c2 = col - 1792, hh = c2 / 64, d = c2 % 64; VBT[(((size_t)b * 8 + hh) * 64 + d) * S + s] = f2bf(acc); }
}
__global__ void __launch_bounds__(64) k_swa(const bf16* QA, const bf16* KA, const bf16* VAT, const float* lut, const float* sinks, const float* gain, bf16* att, float* ssq) {
    int idx = blockIdx.x * blockDim.x + threadIdx.x;
    if (idx >= NTOK * 8) return;
    int hh = idx % 8, t = idx / 8, b = t / S, s = t % S, kv = hh / 4;
    float q[64];
    const bf16* qp = QA + (((size_t)b * 8 + hh) * S + s) * 64;
#pragma unroll
    for (int d = 0; d < 64; ++d) q[d] = bf2f(qp[d]);
    const float* L = lut + hh * LUTN + LUT_NEG;
    int n = s / 128;
    int k0 = (n == 0) ? 0 : (n - 1) * 128, k1 = s;
    float m = NEGBIG, l = 0.f; float o[64];
#pragma unroll
    for (int d = 0; d < 64; ++d) o[d] = 0.f;
    for (int kp = k0; kp <= k1; ++kp) {
        const bf16* kr = KA + (((size_t)b * 2 + kv) * S + kp) * 64;
        float sc = 0.f;
#pragma unroll
        for (int d = 0; d < 64; ++d) sc += q[d] * bf2f(kr[d]);
        sc += L[s - kp];
        float mn = fmaxf(m, sc), a = exp2f(m - mn), p = exp2f(sc - mn);
        l = l * a + p;
#pragma unroll
        for (int d = 0; d < 64; ++d) o[d] = o[d] * a + p * bf2f(VAT[(((size_t)b * 2 + kv) * 64 + d) * S + kp]);
        m = mn;
    }
    float sk = sinks[hh] * LOG2E;
    float mn = fmaxf(m, sk), a = exp2f(m - mn);
    l = l * a + exp2f(sk - mn);
    float inv = a / l, sq = 0.f;
#pragma unroll
    for (int d = 0; d < 64; ++d) { float ov = o[d] * inv; sq += ov * ov; att[(size_t)t * D + hh * 64 + d] = f2bf(ov * gain[hh * 64 + d]); }
    atomicAdd(&ssq[t], sq);
}
__global__ void __launch_bounds__(64) k_moba(const bf16* QB, const bf16* KB, const bf16* VBT, const float* ksum, const float* lut, const float* gain, bf16* att, float* ssq) {
    int idx = blockIdx.x * blockDim.x + threadIdx.x;
    if (idx >= NTOK * 8) return;
    int hh = idx % 8, t = idx / 8, b = t / S, s = t % S;
    float q[64];
    const bf16* qp = QB + (((size_t)b * 8 + hh) * S + s) * 64;
#pragma unroll
    for (int d = 0; d < 64; ++d) q[d] = bf2f(qp[d]);
    const float* L = lut + (8 + hh) * LUTN + LUT_NEG;
    int qb = s / 256;
    float gate[8];
#pragma unroll
    for (int j = 0; j < 8; ++j) {
        float gsum = -INFINITY;
        if (j < qb) { gsum = 0.f; const float* km = ksum + (((size_t)b * 8 + hh) * 8 + j) * 64;
#pragma unroll
            for (int d = 0; d < 64; ++d) gsum += q[d] * km[d]; }
        gate[j] = gsum;
    }
    unsigned sel = 0; int nsel = qb < 3 ? qb : 3;
    for (int r = 0; r < nsel; ++r) { int best = -1; float bv = -INFINITY;
#pragma unroll
        for (int j = 0; j < 8; ++j) if (j < qb && !((sel >> j) & 1) && (best < 0 || gate[j] > bv)) { best = j; bv = gate[j]; }
        sel |= 1u << best; }
    sel |= 1u << qb;
    float m = NEGBIG, l = 0.f; float o[64];
#pragma unroll
    for (int d = 0; d < 64; ++d) o[d] = 0.f;
    for (int j = 0; j <= qb; ++j) {
        if (!((sel >> j) & 1)) continue;
        int kend = (j == qb) ? s : (j * 256 + 255);
        for (int kp = j * 256; kp <= kend; ++kp) {
            const bf16* kr = KB + (((size_t)b * 8 + hh) * S + kp) * 64;
            float sc = 0.f;
#pragma unroll
            for (int d = 0; d < 64; ++d) sc += q[d] * bf2f(kr[d]);
            sc += L[s - kp];
            float mn = fmaxf(m, sc), a = exp2f(m - mn), p = exp2f(sc - mn);
            l = l * a + p;
#pragma unroll
            for (int d = 0; d < 64; ++d) o[d] = o[d] * a + p * bf2f(VBT[(((size_t)b * 8 + hh) * 64 + d) * S + kp]);
            m = mn;
        }
    }
    float inv = 1.f / l, sq = 0.f;
#pragma unroll
    for (int d = 0; d < 64; ++d) { float ov = o[d] * inv; sq += ov * ov; att[(size_t)t * D + 512 + hh * 64 + d] = f2bf(ov * gain[hh * 64 + d]); }
    atomicAdd(&ssq[t], sq);
}
__global__ void k_outproj(const bf16* att, const float* ssqa, const float* ssqb, const float* w_out, const float* x, const float* mod, float* x1) {
    int col = blockIdx.x * blockDim.x + threadIdx.x, t = blockIdx.y, b = t / S;
    float ra = rsqrtf(ssqa[t] / 512.f + EPS), rb = rsqrtf(ssqb[t] / 512.f + EPS);
    const bf16* ar = att + (size_t)t * D;
    float a0 = 0.f, a1 = 0.f;
    for (int k = 0; k < 512; ++k) a0 += bf2f(ar[k]) * w_out[(size_t)k * D + col];
    for (int k = 512; k < 1024; ++k) a1 += bf2f(ar[k]) * w_out[(size_t)k * D + col];
    float y = a0 * ra + a1 * rb;
    x1[(size_t)t * D + col] = x[(size_t)t * D + col] + mod[b * 6 * D + 2 * D + col] * y;
}
__global__ void k_router(const bf16* h2, const float* w_router, const float* e_bias, int* cnt, int* list, float* ew) {
    int t = blockIdx.x, e = threadIdx.x;
    __shared__ float sc[256], sel[256], gs[8]; __shared__ int chosen[8];
    const bf16* hr = h2 + (size_t)t * D;
    float acc = 0.f;
    for (int k = 0; k < D; ++k) acc += bf2f(hr[k]) * w_router[(size_t)k * NE + e];
    float s = 1.f / (1.f + __expf(-acc));
    sc[e] = s; sel[e] = s + e_bias[e];
    __syncthreads();
    if (e < 8) { float m1 = -INFINITY, m2 = -INFINITY;
        for (int i = 0; i < 32; ++i) { float v = sel[e * 32 + i]; if (v > m1) { m2 = m1; m1 = v; } else if (v > m2) m2 = v; }
        gs[e] = m1 + m2; }
    __syncthreads();
    if (e == 0) {
        unsigned gm = 0;
        for (int r = 0; r < 4; ++r) { int best = -1; float bv = 0.f;
            for (int g = 0; g < 8; ++g) if (!((gm >> g) & 1) && (best < 0 || gs[g] > bv)) { best = g; bv = gs[g]; }
            gm |= 1u << best; }
        float wsum = 0.f;
        for (int r = 0; r < 8; ++r) { int best = -1; float bv = 0.f;
            for (int i = 0; i < 256; ++i) { if (!((gm >> (i / 32)) & 1)) continue; bool used = false; for (int q = 0; q < r; ++q) used |= (chosen[q] == i);
                if (used) continue; if (best < 0 || sel[i] > bv) { best = i; bv = sel[i]; } }
            chosen[r] = best; wsum += sc[best]; }
        for (int r = 0; r < 8; ++r) { int ex = chosen[r]; int slot = atomicAdd(&cnt[ex], 1); list[(size_t)ex * NTOK + slot] = t * 8 + r; ew[t * 8 + r] = sc[ex] / wsum * 2.5f; }
    }
}
__global__ void k_moe(const bf16* h2, const int* cnt, const int* list, const float* ew, const float* w1, const float* w3, const float* w2,
                      const float* ws1, const float* ws3, const float* ws2, bf16* ybuf, bf16* ysh) {
    int e = blockIdx.y, g = blockIdx.x, tid = threadIdx.x;
    int n = (e < NE) ? cnt[e] : NTOK;
    if (g * 8 >= n) return;
    const float* W1 = (e < NE) ? w1 + (size_t)e * D * ED : ws1;
    const float* W3 = (e < NE) ? w3 + (size_t)e * D * ED : ws3;
    const float* W2 = (e < NE) ? w2 + (size_t)e * ED * D : ws2;
    __shared__ float xs[8][1024]; __shared__ float hs[8][256]; __shared__ int aid[8];
    if (tid < 8) { int i = g * 8 + tid; aid[tid] = (i < n) ? ((e < NE) ? list[(size_t)e * NTOK + i] : i) : -1; }
    __syncthreads();
    for (int r = 0; r < 8; ++r) { int a = aid[r]; int tok = (a < 0) ? 0 : ((e < NE) ? a / 8 : a);
        for (int k = tid; k < D; k += 256) xs[r][k] = (a < 0) ? 0.f : bf2f(h2[(size_t)tok * D + k]); }
    __syncthreads();
    float gg[8], uu[8];
#pragma unroll
    for (int r = 0; r < 8; ++r) { gg[r] = 0.f; uu[r] = 0.f; }
    for (int k = 0; k < D; ++k) { float a = W1[(size_t)k * ED + tid], b = W3[(size_t)k * ED + tid];
#pragma unroll
        for (int r = 0; r < 8; ++r) { gg[r] += xs[r][k] * a; uu[r] += xs[r][k] * b; } }
#pragma unroll
    for (int r = 0; r < 8; ++r) hs[r][tid] = gg[r] / (1.f + __expf(-gg[r])) * uu[r];
    __syncthreads();
    float y[8][4];
#pragma unroll
    for (int r = 0; r < 8; ++r) {
#pragma unroll
        for (int c = 0; c < 4; ++c) y[r][c] = 0.f; }
    for (int k = 0; k < ED; ++k) {
#pragma unroll
        for (int c = 0; c < 4; ++c) { float w = W2[(size_t)k * D + tid + 256 * c];
#pragma unroll
            for (int r = 0; r < 8; ++r) y[r][c] += hs[r][k] * w; } }
#pragma unroll
    for (int r = 0; r < 8; ++r) { int a = aid[r]; if (a < 0) continue;
        float wgt = (e < NE) ? ew[a] : 1.f; bf16* dst = (e < NE) ? ybuf + (size_t)a * D : ysh + (size_t)a * D;
#pragma unroll
        for (int c = 0; c < 4; ++c) dst[tid + 256 * c] = f2bf(y[r][c] * wgt); }
}
__global__ void k_final(const float* x1, const bf16* ybuf, const bf16* ysh, const float* mod, const float* fg, float* out) {
    int t = blockIdx.x, b = t / S, tid = threadIdx.x;
    __shared__ float red[256];
    float v[4]; float s = 0.f;
#pragma unroll
    for (int i = 0; i < 4; ++i) { int col = tid + 256 * i; float m = bf2f(ysh[(size_t)t * D + col]);
        for (int r = 0; r < 8; ++r) m += bf2f(ybuf[((size_t)t * 8 + r) * D + col]);
        v[i] = x1[(size_t)t * D + col] + mod[b * 6 * D + 5 * D + col] * m; s += v[i] * v[i]; }
    red[tid] = s; __syncthreads();
    for (int o = 128; o > 0; o >>= 1) { if (tid < o) red[tid] += red[tid + o]; __syncthreads(); }
    float rstd = rsqrtf(red[0] / D + EPS);
#pragma unroll
    for (int i = 0; i < 4; ++i) { int col = tid + 256 * i; out[(size_t)t * D + col] = v[i] * rstd * fg[col]; }
}

extern "C" void kernel_launch(void* const* d_in, const int* in_sizes, int n_in, void* d_out, int out_size, void* d_ws, size_t ws_size, hipStream_t stream) {
    if (n_in != 21 || ws_size < WS_END) { fprintf(stderr, "kernel_launch: unexpected n_in %d or ws_size %zu\n", n_in, ws_size); return; }
    const float* x = (const float*)d_in[0]; const float* c = (const float*)d_in[1]; const float* w_ada = (const float*)d_in[2]; const float* b_ada = (const float*)d_in[3];
    const float* norm1_g = (const float*)d_in[4]; const float* w_in = (const float*)d_in[5]; const float* sinks = (const float*)d_in[6]; const float* rel_table = (const float*)d_in[7];
    const float* out_norm_a = (const float*)d_in[8]; const float* out_norm_b = (const float*)d_in[9]; const float* w_out = (const float*)d_in[10]; const float* norm2_g = (const float*)d_in[11];
    const float* w_router = (const float*)d_in[12]; const float* e_bias = (const float*)d_in[13]; const float* w1 = (const float*)d_in[14]; const float* w3 = (const float*)d_in[15];
    const float* w2 = (const float*)d_in[16]; const float* ws1 = (const float*)d_in[17]; const float* ws3 = (const float*)d_in[18]; const float* ws2 = (const float*)d_in[19]; const float* final_g = (const float*)d_in[20];
    unsigned char* ws = (unsigned char*)d_ws;
    float* mod = (float*)(ws + C_MOD); float* ksum = (float*)(ws + C_KSUM); float* ssqa = (float*)(ws + C_SSQA); float* ssqb = (float*)(ws + C_SSQB); int* cnt = (int*)(ws + C_CNT);
    float* lut = (float*)(ws + WS_LUT); bf16* H = (bf16*)(ws + WS_H);
    bf16* QA = (bf16*)(ws + WS_QA); bf16* KA = (bf16*)(ws + WS_KA); bf16* VAT = (bf16*)(ws + WS_VAT); bf16* QB = (bf16*)(ws + WS_QB); bf16* KB = (bf16*)(ws + WS_KB); bf16* VBT = (bf16*)(ws + WS_VBT);
    bf16* ATT = (bf16*)(ws + WS_ATT); float* X1 = (float*)(ws + WS_X1); bf16* H2 = (bf16*)(ws + WS_H2); float* EW = (float*)(ws + WS_EW); int* LIST = (int*)(ws + WS_LIST);
    bf16* YSH = (bf16*)(ws + WS_YSH); bf16* YBUF = (bf16*)(ws + WS_YBUF);
    hipMemsetAsync(ws + WS_CTL, 0, CTL_BYTES, stream);
    k_mod<<<24, 256, 0, stream>>>(c, w_ada, b_ada, mod);
    k_lut<<<(16 * LUTN + 255) / 256, 256, 0, stream>>>(rel_table, lut);
    k_norm_mod<<<NTOK, 256, 0, stream>>>(x, norm1_g, mod, 0, D, H);
    k_inproj<<<dim3(INC / 256, NTOK), 256, 0, stream>>>(H, w_in, QA, KA, VAT, QB, KB, VBT, ksum);
    k_swa<<<NTOK * 8 / 64, 64, 0, stream>>>(QA, KA, VAT, lut, sinks, out_norm_a, ATT, ssqa);
    k_moba<<<NTOK * 8 / 64, 64, 0, stream>>>(QB, KB, VBT, ksum, lut, out_norm_b, ATT, ssqb);
    k_outproj<<<dim3(D / 256, NTOK), 256, 0, stream>>>(ATT, ssqa, ssqb, w_out, x, mod, X1);
    k_norm_mod<<<NTOK, 256, 0, stream>>>(X1, norm2_g, mod, 3 * D, 4 * D, H2);
    k_router<<<NTOK, 256, 0, stream>>>(H2, w_router, e_bias, cnt, LIST, EW);
    k_moe<<<dim3(NTOK / 8, NE + 1), 256, 0, stream>>>(H2, cnt, LIST, EW, w1, w3, w2, ws1, ws3, ws2, YBUF, YSH);
    k_final<<<NTOK, 256, 0, stream>>>(X1, YBUF, YSH, mod, final_g, (float*)d_out);
}
```

```cpp
#include <hip/hip_runtime.h>
#include <cstdio>
#include <cstdint>

constexpr int D = 1024, NB = 8, S = 2048, NTOK = NB * S;
constexpr int HD = 64, INC = 2304;
constexpr int NE = 256, TOPK = 8, ED = 256;
constexpr float EPS = 1e-6f;
constexpr float LOG2E = 1.4426950408889634f;
constexpr float QSCALE = 0.125f * LOG2E;
constexpr float NEGBIG = -1e30f;

typedef unsigned short bf16;
__device__ __forceinline__ float bf2f(bf16 v) { return __uint_as_float(((unsigned)v) << 16); }
__device__ __forceinline__ bf16 f2bf(float f) { unsigned u = __float_as_uint(f); return (bf16)((u + 0x7fffu + ((u >> 16) & 1u)) >> 16); }

constexpr size_t MiB = 1u << 20;
constexpr size_t WS_CTL   = 0;
constexpr size_t CTL_BYTES = 1 * MiB;
constexpr size_t C_MOD   = 64 * 1024;
constexpr size_t C_KSUM  = 320 * 1024;
constexpr size_t C_SSQA  = 512 * 1024;
constexpr size_t C_SSQB  = 576 * 1024;
constexpr size_t C_CNT   = 640 * 1024;
constexpr size_t WS_LUT  = 1 * MiB;
constexpr size_t WS_H    = 2 * MiB;
constexpr size_t WS_QA   = 34 * MiB;
constexpr size_t WS_KA   = 50 * MiB;
constexpr size_t WS_VAT  = 54 * MiB;
constexpr size_t WS_QB   = 58 * MiB;
constexpr size_t WS_KB   = 74 * MiB;
constexpr size_t WS_VBT  = 90 * MiB;
constexpr size_t WS_ATT  = 106 * MiB;
constexpr size_t WS_X1   = 138 * MiB;
constexpr size_t WS_H2   = 202 * MiB;
constexpr size_t WS_EW   = 234 * MiB;
constexpr size_t WS_SSQ  = 235 * MiB;
constexpr size_t WS_LIST = 236 * MiB;
constexpr size_t WS_YSH  = 256 * MiB;
constexpr size_t WS_YBUF = 288 * MiB;
constexpr size_t WS_END  = 544 * MiB;

constexpr int LUT_NEG = 256;
constexpr int LUTN = 2560;

__device__ __forceinline__ int t5_bucket(int n) {
    if (n < 16) return n;
    const int thr[15] = {21, 27, 35, 46, 59, 77, 99, 128, 166, 216, 280, 363, 470, 609, 790};
    int b = 16;
#pragma unroll
    for (int i = 0; i < 15; ++i) b += (n >= thr[i]) ? 1 : 0;
    return b;
}

__global__ void k_mod(const float* c, const float* w_ada, const float* b_ada, float* mod) {
    int j = blockIdx.x * blockDim.x + threadIdx.x;
    if (j >= 6 * D) return;
    float acc[NB];
#pragma unroll
    for (int b = 0; b < NB; ++b) acc[b] = 0.f;
    for (int k = 0; k < D; ++k) {
        float w = w_ada[(size_t)k * 6 * D + j];
#pragma unroll
        for (int b = 0; b < NB; ++b) { float cv = c[b * D + k]; float sv = cv / (1.f + __expf(-cv)); acc[b] += sv * w; }
    }
#pragma unroll
    for (int b = 0; b < NB; ++b) mod[b * 6 * D + j] = acc[b] + b_ada[j];
}
__global__ void k_lut(const float* rel_table, float* lut) {
    int i = blockIdx.x * blockDim.x + threadIdx.x;
    if (i >= 16 * LUTN) return;
    int h = i / LUTN, p = i % LUTN, dist = p - LUT_NEG;
    float v = NEGBIG;
    bool ok = dist >= 0 && (h < 8 ? dist < 128 : dist < S);
    if (ok) v = rel_table[t5_bucket(dist) * 16 + h] * LOG2E;
    lut[i] = v;
}
__global__ void k_norm_mod(const float* x, const float* g, const float* mod, int sh_off, int sc_off, bf16* out) {
    int t = blockIdx.x, b = t / S, tid = threadIdx.x;
    __shared__ float red[256];
    float v[4]; float s = 0.f;
#pragma unroll
    for (int i = 0; i < 4; ++i) { v[i] = x[(size_t)t * D + tid + 256 * i]; s += v[i] * v[i]; }
    red[tid] = s; __syncthreads();
    for (int o = 128; o > 0; o >>= 1) { if (tid < o) red[tid] += red[tid + o]; __syncthreads(); }
    float rstd = rsqrtf(red[0] / D + EPS);
#pragma unroll
    for (int i = 0; i < 4; ++i) { int col = tid + 256 * i;
        float hv = v[i] * rstd * g[col] * (1.f + mod[b * 6 * D + sc_off + col]) + mod[b * 6 * D + sh_off + col];
        out[(size_t)t * D + col] = f2bf(hv); }
}
__global__ void k_inproj(const bf16* h, const float* w_in, bf16* QA, bf16* KA, bf16* VAT, bf16* QB, bf16* KB, bf16* VBT, float* ksum) {
    int col = blockIdx.x * blockDim.x + threadIdx.x;
    int t = blockIdx.y;
    if (col >= INC) return;
    float acc = 0.f;
    const bf16* hr = h + (size_t)t * D;
    for (int k = 0; k < D; ++k) acc += bf2f(hr[k]) * w_in[(size_t)k * INC + col];
    int b = t / S, s = t % S;
    if (col < 512) { int hh = col / 64, d = col % 64; QA[(((size_t)b * 8 + hh) * S + s) * 64 + d] = f2bf(acc * QSCALE); }
    else if (col < 640) { int c2 = col - 512, hh = c2 / 64, d = c2 % 64; KA[(((size_t)b * 2 + hh) * S + s) * 64 + d] = f2bf(acc); }
    else if (col < 768) { int c2 = col - 640, hh = c2 / 64, d = c2 % 64; VAT[(((size_t)b * 2 + hh) * 64 + d) * S + s] = f2bf(acc); }
    else if (col < 1280) { int c2 = col - 768, hh = c2 / 64, d = c2 % 64; QB[(((size_t)b * 8 + hh) * S + s) * 64 + d] = f2bf(acc * QSCALE); }
    else if (col < 1792) { int c2 = col - 1280, hh = c2 / 64, d = c2 % 64; bf16 kb = f2bf(acc); KB[(((size_t)b * 8 + hh) * S + s) * 64 + d] = kb;
        atomicAdd(&ksum[(((size_t)b * 8 + hh) * 8 + s / 256) * 64 + d], bf2f(kb)); }
    else { int c2 = col - 1792, hh = c2 / 64, d = c2 % 64; VBT[(((size_t)b * 8 + hh) * 64 + d) * S + s] = f2bf(acc); }
}
__global__ void __launch_bounds__(64) k_swa(const bf16* QA, const bf16* KA, const bf16* VAT, const float* lut, const float* sinks, const float* gain, bf16* att, float* ssq) {
    int idx = blockIdx.x * blockDim.x + threadIdx.x;
    if (idx >= NTOK * 8) return;
    int hh = idx % 8, t = idx / 8, b = t / S, s = t % S, kv = hh / 4;
    float q[64];
    const bf16* qp = QA + (((size_t)b * 8 + hh) * S + s) * 64;
#pragma unroll
    for (int d = 0; d < 64; ++d) q[d] = bf2f(qp[d]);
    const float* L = lut + hh * LUTN + LUT_NEG;
    int n = s / 128;
    int k0 = (n == 0) ? 0 : (n - 1) * 128, k1 = s;
    float m = NEGBIG, l = 0.f; float o[64];
#pragma unroll
    for (int d = 0; d < 64; ++d) o[d] = 0.f;
    for (int kp = k0; kp <= k1; ++kp) {
        const bf16* kr = KA + (((size_t)b * 2 + kv) * S + kp) * 64;
        float sc = 0.f;
#pragma unroll
        for (int d = 0; d < 64; ++d) sc += q[d] * bf2f(kr[d]);
        sc += L[s - kp];
        float mn = fmaxf(m, sc), a = exp2f(m - mn), p = exp2f(sc - mn);
        l = l * a + p;
#pragma unroll
        for (int d = 0; d < 64; ++d) o[d] = o[d] * a + p * bf2f(VAT[(((size_t)b * 2 + kv) * 64 + d) * S + kp]);
        m = mn;
    }
    float sk = sinks[hh] * LOG2E;
    float mn = fmaxf(m, sk), a = exp2f(m - mn);
    l = l * a + exp2f(sk - mn);
    float inv = a / l, sq = 0.f;
#pragma unroll
    for (int d = 0; d < 64; ++d) { float ov = o[d] * inv; sq += ov * ov; att[(size_t)t * D + hh * 64 + d] = f2bf(ov * gain[hh * 64 + d]); }
    ssq[t * 16 + hh] = sq;
}
__global__ void __launch_bounds__(64) k_moba(const bf16* QB, const bf16* KB, const bf16* VBT, const float* ksum, const float* lut, const float* gain, bf16* att, float* ssq) {
    int idx = blockIdx.x * blockDim.x + threadIdx.x;
    if (idx >= NTOK * 8) return;
    int hh = idx % 8, t = idx / 8, b = t / S, s = t % S;
    float q[64];
    const bf16* qp = QB + (((size_t)b * 8 + hh) * S + s) * 64;
#pragma unroll
    for (int d = 0; d < 64; ++d) q[d] = bf2f(qp[d]);
    const float* L = lut + (8 + hh) * LUTN + LUT_NEG;
    int qb = s / 256;
    float gate[8];
#pragma unroll
    for (int j = 0; j < 8; ++j) {
        float gsum = -INFINITY;
        if (j < qb) { gsum = 0.f; const float* km = ksum + (((size_t)b * 8 + hh) * 8 + j) * 64;
#pragma unroll
            for (int d = 0; d < 64; ++d) gsum += q[d] * km[d]; }
        gate[j] = gsum;
    }
    unsigned sel = 0; int nsel = qb < 3 ? qb : 3;
    for (int r = 0; r < nsel; ++r) { int best = -1; float bv = -INFINITY;
#pragma unroll
        for (int j = 0; j < 8; ++j) if (j < qb && !((sel >> j) & 1) && (best < 0 || gate[j] > bv)) { best = j; bv = gate[j]; }
        sel |= 1u << best; }
    sel |= 1u << qb;
    float m = NEGBIG, l = 0.f; float o[64];
#pragma unroll
    for (int d = 0; d < 64; ++d) o[d] = 0.f;
    for (int j = 0; j <= qb; ++j) {
        if (!((sel >> j) & 1)) continue;
        int kend = (j == qb) ? s : (j * 256 + 255);
        for (int kp = j * 256; kp <= kend; ++kp) {
            const bf16* kr = KB + (((size_t)b * 8 + hh) * S + kp) * 64;
            float sc = 0.f;
#pragma unroll
            for (int d = 0; d < 64; ++d) sc += q[d] * bf2f(kr[d]);
            sc += L[s - kp];
            float mn = fmaxf(m, sc), a = exp2f(m - mn), p = exp2f(sc - mn);
            l = l * a + p;
#pragma unroll
            for (int d = 0; d < 64; ++d) o[d] = o[d] * a + p * bf2f(VBT[(((size_t)b * 8 + hh) * 64 + d) * S + kp]);
            m = mn;
        }
    }
    float inv = 1.f / l, sq = 0.f;
#pragma unroll
    for (int d = 0; d < 64; ++d) { float ov = o[d] * inv; sq += ov * ov; att[(size_t)t * D + 512 + hh * 64 + d] = f2bf(ov * gain[hh * 64 + d]); }
    ssq[t * 16 + 8 + hh] = sq;
}
__global__ void k_outproj(const bf16* att, const float* ssq, const float* w_out, const float* x, const float* mod, float* x1) {
    int col = blockIdx.x * blockDim.x + threadIdx.x, t = blockIdx.y, b = t / S;
    float sa = 0.f, sb = 0.f; for (int i = 0; i < 8; ++i) { sa += ssq[t * 16 + i]; sb += ssq[t * 16 + 8 + i]; }
    float ra = rsqrtf(sa / 512.f + EPS), rb = rsqrtf(sb / 512.f + EPS);
    const bf16* ar = att + (size_t)t * D;
    float a0 = 0.f, a1 = 0.f;
    for (int k = 0; k < 512; ++k) a0 += bf2f(ar[k]) * w_out[(size_t)k * D + col];
    for (int k = 512; k < 1024; ++k) a1 += bf2f(ar[k]) * w_out[(size_t)k * D + col];
    float y = a0 * ra + a1 * rb;
    x1[(size_t)t * D + col] = x[(size_t)t * D + col] + mod[b * 6 * D + 2 * D + col] * y;
}
__global__ void k_router(const bf16* h2, const float* w_router, const float* e_bias, int* cnt, int* list, float* ew) {
    int t = blockIdx.x, e = threadIdx.x;
    __shared__ float sc[256], sel[256], gs[8]; __shared__ int chosen[8];
    const bf16* hr = h2 + (size_t)t * D;
    float acc = 0.f;
    for (int k = 0; k < D; ++k) acc += bf2f(hr[k]) * w_router[(size_t)k * NE + e];
    float s = 1.f / (1.f + __expf(-acc));
    sc[e] = s; sel[e] = s + e_bias[e];
    __syncthreads();
    if (e < 8) { float m1 = -INFINITY, m2 = -INFINITY;
        for (int i = 0; i < 32; ++i) { float v = sel[e * 32 + i]; if (v > m1) { m2 = m1; m1 = v; } else if (v > m2) m2 = v; }
        gs[e] = m1 + m2; }
    __syncthreads();
    if (e == 0) {
        unsigned gm = 0;
        for (int r = 0; r < 4; ++r) { int best = -1; float bv = 0.f;
            for (int g = 0; g < 8; ++g) if (!((gm >> g) & 1) && (best < 0 || gs[g] > bv)) { best = g; bv = gs[g]; }
            gm |= 1u << best; }
        float wsum = 0.f;
        for (int r = 0; r < 8; ++r) { int best = -1; float bv = 0.f;
            for (int i = 0; i < 256; ++i) { if (!((gm >> (i / 32)) & 1)) continue; bool used = false; for (int q = 0; q < r; ++q) used |= (chosen[q] == i);
                if (used) continue; if (best < 0 || sel[i] > bv) { best = i; bv = sel[i]; } }
            chosen[r] = best; wsum += sc[best]; }
        for (int r = 0; r < 8; ++r) { int ex = chosen[r]; int slot = atomicAdd(&cnt[ex], 1); list[(size_t)ex * NTOK + slot] = t * 8 + r; ew[t * 8 + r] = sc[ex] / wsum * 2.5f; }
    }
}
__global__ void k_moe(const bf16* h2, const int* cnt, const int* list, const float* ew, const float* w1, const float* w3, const float* w2,
                      const float* ws1, const float* ws3, const float* ws2, bf16* ybuf, bf16* ysh) {
    int e = blockIdx.y, g = blockIdx.x, tid = threadIdx.x;
    int n = (e < NE) ? cnt[e] : NTOK;
    if (g * 8 >= n) return;
    const float* W1 = (e < NE) ? w1 + (size_t)e * D * ED : ws1;
    const float* W3 = (e < NE) ? w3 + (size_t)e * D * ED : ws3;
    const float* W2 = (e < NE) ? w2 + (size_t)e * ED * D : ws2;
    __shared__ float xs[8][1024]; __shared__ float hs[8][256]; __shared__ int aid[8];
    if (tid < 8) { int i = g * 8 + tid; aid[tid] = (i < n) ? ((e < NE) ? list[(size_t)e * NTOK + i] : i) : -1; }
    __syncthreads();
    for (int r = 0; r < 8; ++r) { int a = aid[r]; int tok = (a < 0) ? 0 : ((e < NE) ? a / 8 : a);
        for (int k = tid; k < D; k += 256) xs[r][k] = (a < 0) ? 0.f : bf2f(h2[(size_t)tok * D + k]); }
    __syncthreads();
    float gg[8], uu[8];
#pragma unroll
    for (int r = 0; r < 8; ++r) { gg[r] = 0.f; uu[r] = 0.f; }
    for (int k = 0; k < D; ++k) { float a = W1[(size_t)k * ED + tid], b = W3[(size_t)k * ED + tid];
#pragma unroll
        for (int r = 0; r < 8; ++r) { gg[r] += xs[r][k] * a; uu[r] += xs[r][k] * b; } }
#pragma unroll
    for (int r = 0; r < 8; ++r) hs[r][tid] = gg[r] / (1.f + __expf(-gg[r])) * uu[r];
    __syncthreads();
    float y[8][4];
#pragma unroll
    for (int r = 0; r < 8; ++r) {
#pragma unroll
        for (int c = 0; c < 4; ++c) y[r][c] = 0.f; }
    for (int k = 0; k < ED; ++k) {
#pragma unroll
        for (int c = 0; c < 4; ++c) { float w = W2[(size_t)k * D + tid + 256 * c];
#pragma unroll
            for (int r = 0; r < 8; ++r) y[r][c] += hs[r][k] * w; } }
#pragma unroll
    for (int r = 0; r < 8; ++r) { int a = aid[r]; if (a < 0) continue;
        float wgt = (e < NE) ? ew[a] : 1.f; bf16* dst = (e < NE) ? ybuf + (size_t)a * D : ysh + (size_t)a * D;
#pragma unroll
        for (int c = 0; c < 4; ++c) dst[tid + 256 * c] = f2bf(y[r][c] * wgt); }
}
__global__ void k_final(const float* x1, const bf16* ybuf, const bf16* ysh, const float* mod, const float* fg, float* out) {
    int t = blockIdx.x, b = t / S, tid = threadIdx.x;
    __shared__ float red[256];
    float v[4]; float s = 0.f;
#pragma unroll
    for (int i = 0; i < 4; ++i) { int col = tid + 256 * i; float m = bf2f(ysh[(size_t)t * D + col]);
        for (int r = 0; r < 8; ++r) m += bf2f(ybuf[((size_t)t * 8 + r) * D + col]);
        v[i] = x1[(size_t)t * D + col] + mod[b * 6 * D + 5 * D + col] * m; s += v[i] * v[i]; }
    red[tid] = s; __syncthreads();
    for (int o = 128; o > 0; o >>= 1) { if (tid < o) red[tid] += red[tid + o]; __syncthreads(); }
    float rstd = rsqrtf(red[0] / D + EPS);
#pragma unroll
    for (int i = 0; i < 4; ++i) { int col = tid + 256 * i; out[(size_t)t * D + col] = v[i] * rstd * fg[col]; }
}

#define OPT_MASK 0xFF

#define LAS __attribute__((address_space(3)))
typedef short bf16x8 __attribute__((ext_vector_type(8)));
typedef float f32x16 __attribute__((ext_vector_type(16)));
typedef float f32x4 __attribute__((ext_vector_type(4)));
typedef unsigned u32x4 __attribute__((ext_vector_type(4)));
typedef unsigned u32x2 __attribute__((ext_vector_type(2)));

constexpr int NTHR = 512, NWAVE = 8;
constexpr int LDS_CTL_OFF = 147456;
constexpr int LDS_BYTES = LDS_CTL_OFF + 1024;
constexpr size_t C_BAR = 4096;

__device__ __forceinline__ unsigned cvt_pk(float lo, float hi) { unsigned r; asm("v_cvt_pk_bf16_f32 %0, %1, %2" : "=v"(r) : "v"(lo), "v"(hi)); return r; }
__device__ __forceinline__ float wave_sum(float v) {
#pragma unroll
    for (int o = 1; o < 64; o <<= 1) v += __shfl_xor(v, o);
    return v;
}
#define MFMA32(a, b, c) __builtin_amdgcn_mfma_f32_32x32x16_bf16((a), (b), (c), 0, 0, 0)

#define XB_TMO      128
#define XB_XCNT(j)  (256  + 64 * (j))
#define XB_XSUB(j)  (1280 + 64 * (j))
#define XB_XGEN(j)  (2304 + 64 * (j))
#define XB_TOP      3328
#define XB_TOPGEN   3392
#define XCD_BAR_WORDS 3456
#define XB_SPIN_CAP (1u << 22)
__device__ __forceinline__ unsigned xb_ld(unsigned* p)              { return __hip_atomic_load(p, __ATOMIC_RELAXED, __HIP_MEMORY_SCOPE_AGENT); }
__device__ __forceinline__ unsigned xb_add(unsigned* p, unsigned v) { return __hip_atomic_fetch_add(p, v, __ATOMIC_RELAXED, __HIP_MEMORY_SCOPE_AGENT); }
__device__ __forceinline__ unsigned xb_xcc_id() { return (unsigned)__builtin_amdgcn_s_getreg((3 << 11) | 20) & 0xFu; }
#define XB_SPIN(cond, bar) do { unsigned _sp = 0; while (cond) { __builtin_amdgcn_s_sleep(1); \
    if ((++_sp & 255u) == 0u) { if (xb_ld(&(bar)[XB_TMO])) break; if (_sp > XB_SPIN_CAP) { atomicAdd(&(bar)[XB_TMO], 1u); break; } } } } while (0)
struct XcdBarrier { unsigned* bar; unsigned x; volatile LAS unsigned* st; };
__device__ __forceinline__ XcdBarrier xcd_barrier_post(unsigned* bar, volatile LAS unsigned* st) {
    XcdBarrier b; b.bar = bar; b.x = xb_xcc_id(); b.st = st;
    if (threadIdx.x == 0) (void)xb_add(&bar[XB_XCNT(b.x)], 1u);
    return b;
}
__device__ __forceinline__ void xcd_barrier_complete(unsigned* bar, unsigned x, unsigned& nloc, unsigned& nx) {
    const unsigned G = gridDim.x * gridDim.y * gridDim.z;
    unsigned sum, cnt, mine, sp = 0u;
    for (;;) {
        sum = 0u; cnt = 0u; mine = 0u;
#pragma unroll
        for (unsigned j = 0; j < 16; ++j) { const unsigned c = xb_ld(&bar[XB_XCNT(j)]); sum += c; cnt += (c > 0u) ? 1u : 0u; mine = (j == x) ? c : mine; }
        if (sum == G) break;
        __builtin_amdgcn_s_sleep(1);
        if ((++sp & 255u) == 0u) { if (xb_ld(&bar[XB_TMO])) break; if (sp > XB_SPIN_CAP) { atomicAdd(&bar[XB_TMO], 1u); break; } }
    }
    nloc = mine > 0u ? mine : 1u; nx = cnt > 0u ? cnt : 1u;
}
__device__ __forceinline__ void xcd_barrier(const XcdBarrier& b) {
    asm volatile("s_waitcnt vmcnt(0)" ::: "memory");
    __syncthreads();
    if (threadIdx.x == 0) {
        unsigned* bar = b.bar;
        __builtin_amdgcn_s_waitcnt(0);
        unsigned nloc = b.st[0], nx = b.st[1];
        if (nloc == 0u) { xcd_barrier_complete(bar, b.x, nloc, nx); b.st[0] = nloc; b.st[1] = nx; }
        const unsigned old = xb_add(&bar[XB_XSUB(b.x)], 1u);
        const unsigned gen = old / nloc;
        if (old + 1u == (gen + 1u) * nloc) {
            __builtin_amdgcn_fence(__ATOMIC_RELEASE, "agent");
            asm volatile("s_waitcnt vmcnt(0)" ::: "memory");
            const unsigned og = xb_add(&bar[XB_TOP], 1u);
            const unsigned tg = og / nx;
            if (og + 1u == (tg + 1u) * nx) xb_add(&bar[XB_TOPGEN], 1u);
            else XB_SPIN(xb_ld(&bar[XB_TOPGEN]) == tg, bar);
            __builtin_amdgcn_fence(__ATOMIC_ACQUIRE, "agent");
            xb_add(&bar[XB_XGEN(b.x)], 1u);
            asm volatile("s_waitcnt vmcnt(0)" ::: "memory");
        } else {
            XB_SPIN(xb_ld(&bar[XB_XGEN(b.x)]) == gen, bar);
            __builtin_amdgcn_fence(__ATOMIC_ACQUIRE, "agent");
            asm volatile("s_waitcnt vmcnt(0)" ::: "memory");
        }
    }
    __syncthreads();
}

struct Args {
    const float *x, *c, *w_ada, *b_ada, *norm1_g, *w_in, *sinks, *rel_table, *out_norm_a, *out_norm_b, *w_out, *norm2_g, *w_router, *e_bias,
                *w1, *w3, *w2, *ws1, *ws3, *ws2, *final_g;
    float* out; unsigned char* ws; int ph_lo, ph_hi;
};

template <int RM, int RN, int WM, int WN, int KR, bool A_RES, bool SWAP>
struct GemmCore {
    static constexpr int BM = 32 * RM * WM, BN = 32 * RN * WN;
    static constexpr int A_BYTES = BM * 64, B_BYTES = BN * 64, STAGE = (A_RES ? 0 : A_BYTES) + B_BYTES;
    static constexpr int NA = (BM * 4 + NTHR - 1) / NTHR;
    static constexpr int BTASKS = (32 / KR) * (BN / 4), NBT = BTASKS / NTHR;
    static_assert(WM * WN == NWAVE && BTASKS % NTHR == 0 && (KR == 4 || KR == 8), "GemmCore geometry");
    static constexpr int LDS_NEED = 2 * STAGE;

    template <class AF, class BF>
    static __device__ __forceinline__ void run(LAS unsigned char* lds, AF arow, BF bsrc, int ldb, int nk, f32x16 (&acc)[RM][RN], LAS unsigned char* ares) {
        run_h(lds, arow, bsrc, ldb, nk, acc, ares, [](int, f32x16 (&)[RM][RN]) {});
    }
    template <class AF, class BF, class HK>
    static __device__ __forceinline__ void run_h(LAS unsigned char* lds, AF arow, BF bsrc, int ldb, int nk, f32x16 (&acc)[RM][RN], LAS unsigned char* ares, HK hook) {
        const int tid = threadIdx.x, lane = tid & 63, wave = __builtin_amdgcn_readfirstlane(tid >> 6);
        const int wm = wave / WN, wn = wave % WN, h = lane >> 5, l31 = lane & 31;
        const bf16* ap[NA]; int awo[NA];
#pragma unroll
        for (int i = 0; i < NA; ++i) { const int p = tid + NTHR * i, row = (p >> 2) % BM, ch = p & 3; ap[i] = A_RES ? nullptr : (arow(row) + ch * 8); awo[i] = row * 64 + ((ch ^ ((row >> 2) & 3)) << 4); }
        const float* bp[NBT]; int bwo[NBT];
#pragma unroll
        for (int i = 0; i < NBT; ++i) { const int q = tid + NTHR * i, cg = q % (BN / 4), kg = q / (BN / 4);
            bp[i] = bsrc(4 * cg) + (size_t)(KR * kg) * ldb;
            const int ch = (KR == 8) ? kg : (kg >> 1), hf = (KR == 8) ? 0 : (kg & 1);
            bwo[i] = (4 * cg) * 64 + ((ch ^ (cg & 3)) << 4) + hf * 8; }
        const int swz = (l31 >> 2) & 3;
        const int xs0 = ((0 + h) ^ swz) << 4, xs1 = ((2 + h) ^ swz) << 4;
        const int aro = (wm * RM * 32 + l31) * 64, bro = (wn * RN * 32 + l31) * 64;
        u32x4 areg[NA]; f32x4 breg[NBT][KR];
        auto gload = [&](int ks) {
            if (!A_RES) {
#pragma unroll
                for (int i = 0; i < NA; ++i) if (NA * NTHR == BM * 4 || tid + NTHR * i < BM * 4) areg[i] = *(const u32x4*)(ap[i] + (size_t)ks * 32);
            }
#pragma unroll
            for (int i = 0; i < NBT; ++i) {
#pragma unroll
                for (int r = 0; r < KR; ++r) breg[i][r] = *(const f32x4*)(bp[i] + ((size_t)ks * 32 + r) * ldb);
            }
        };
        auto lwrite = [&](int buf) {
            LAS unsigned char* sb = lds + buf * STAGE;
            if (!A_RES) {
#pragma unroll
                for (int i = 0; i < NA; ++i) if (NA * NTHR == BM * 4 || tid + NTHR * i < BM * 4) *(LAS u32x4*)(sb + awo[i]) = areg[i];
            }
            LAS unsigned char* bb = sb + (A_RES ? 0 : A_BYTES);
#pragma unroll
            for (int i = 0; i < NBT; ++i) {
#pragma unroll
                for (int j = 0; j < 4; ++j) {
                    if (KR == 8) { u32x4 w; w.x = cvt_pk(breg[i][0][j], breg[i][1][j]); w.y = cvt_pk(breg[i][2][j], breg[i][3][j]); w.z = cvt_pk(breg[i][4][j], breg[i][5][j]); w.w = cvt_pk(breg[i][6][j], breg[i][7][j]);
                        *(LAS u32x4*)(bb + bwo[i] + j * 64) = w; }
                    else { u32x2 w; w.x = cvt_pk(breg[i][0][j], breg[i][1][j]); w.y = cvt_pk(breg[i][2][j], breg[i][3][j]); *(LAS u32x2*)(bb + bwo[i] + j * 64) = w; }
                }
            }
        };
        gload(0); lwrite(0); __syncthreads();
        for (int ks = 0; ks < nk; ++ks) {
            const int cur = ks & 1;
            if (ks + 1 < nk) gload(ks + 1);
            hook(ks, acc);
            const LAS unsigned char* abase = A_RES ? (ares + ks * A_BYTES) : (lds + cur * STAGE);
            const LAS unsigned char* bbase = lds + cur * STAGE + (A_RES ? 0 : A_BYTES);
#pragma unroll
            for (int s = 0; s < 2; ++s) {
                const int xs = s ? xs1 : xs0;
                bf16x8 af[RM], bfv[RN];
#pragma unroll
                for (int rb = 0; rb < RM; ++rb) af[rb] = *(const LAS bf16x8*)(abase + aro + rb * 2048 + xs);
#pragma unroll
                for (int cb = 0; cb < RN; ++cb) bfv[cb] = *(const LAS bf16x8*)(bbase + bro + cb * 2048 + xs);
#pragma unroll
                for (int rb = 0; rb < RM; ++rb)
#pragma unroll
                    for (int cb = 0; cb < RN; ++cb) acc[rb][cb] = SWAP ? MFMA32(bfv[cb], af[rb], acc[rb][cb]) : MFMA32(af[rb], bfv[cb], acc[rb][cb]);
            }
            if (ks + 1 < nk) lwrite(cur ^ 1);
            __syncthreads();
        }
    }
};
template <int RM, int RN> __device__ __forceinline__ void zero_acc(f32x16 (&acc)[RM][RN]) {
#pragma unroll
    for (int a = 0; a < RM; ++a)
#pragma unroll
        for (int b = 0; b < RN; ++b)
#pragma unroll
            for (int r = 0; r < 16; ++r) acc[a][b][r] = 0.f;
}
__device__ __forceinline__ int roff(int r, int h) { return (r & 3) + 8 * (r >> 2) + 4 * h; }

__device__ __forceinline__ void phase0(const Args& a, LAS unsigned char* lds, int vcu, int G) {
    const int tid = threadIdx.x, lane = tid & 63, wave = tid >> 6;
    float* mod = (float*)(a.ws + C_MOD); float* lut = (float*)(a.ws + WS_LUT);
    LAS float* sc = (LAS float*)lds;
    for (int i = tid; i < NB * D; i += NTHR) { float cv = a.c[i]; sc[i] = cv / (1.f + __expf(-cv)); }
    __syncthreads();
    LAS float* red = (LAS float*)(lds + 32768);
    for (int u = vcu; u < 192; u += G) {
        const int col = u * 32 + (lane & 31), rp = lane >> 5, k0 = wave * 128 + rp;
        float acc[NB];
#pragma unroll
        for (int b = 0; b < NB; ++b) acc[b] = 0.f;
#pragma unroll 16
        for (int i = 0; i < 64; ++i) { const float w = a.w_ada[(size_t)(k0 + 2 * i) * (6 * D) + col];
#pragma unroll
            for (int b = 0; b < NB; ++b) acc[b] += sc[b * D + k0 + 2 * i] * w; }
#pragma unroll
        for (int b = 0; b < NB; ++b) { acc[b] += __shfl_xor(acc[b], 32); if (rp == 0) red[(wave * NB + b) * 32 + lane] = acc[b]; }
        __syncthreads();
        if (tid < 256) { const int b = tid >> 5, c = tid & 31; float s = 0.f;
#pragma unroll
          for (int w = 0; w < NWAVE; ++w) s += red[(w * NB + b) * 32 + c];
          mod[b * 6 * D + u * 32 + c] = s + a.b_ada[u * 32 + c]; }
        __syncthreads();
    }
    for (int i = vcu * NTHR + tid; i < 16 * LUTN; i += G * NTHR) {
        const int hh = i / LUTN, p = i % LUTN, dist = p - LUT_NEG;
        float v = NEGBIG;
        const bool ok = dist >= 0 && (hh < 8 ? dist < 128 : dist < S);
        if (ok) v = a.rel_table[t5_bucket(dist) * 16 + hh] * LOG2E;
        lut[i] = v;
    }
}
__device__ __forceinline__ void norm_mod_row(const float* xr, const float* g, const float* sh, const float* scl, bf16* orow, int lane) {
    f32x4 v[4]; float s = 0.f;
#pragma unroll
    for (int j = 0; j < 4; ++j) { v[j] = *(const f32x4*)(xr + j * 256 + lane * 4); s += (v[j].x * v[j].x + v[j].y * v[j].y) + (v[j].z * v[j].z + v[j].w * v[j].w); }
    const float rstd = rsqrtf(wave_sum(s) * (1.f / D) + EPS);
#pragma unroll
    for (int j = 0; j < 4; ++j) { const int c = j * 256 + lane * 4;
        const f32x4 gg = *(const f32x4*)(g + c), s1 = *(const f32x4*)(scl + c), s0 = *(const f32x4*)(sh + c);
        const float o0 = v[j].x * rstd * gg.x * (1.f + s1.x) + s0.x, o1 = v[j].y * rstd * gg.y * (1.f + s1.y) + s0.y;
        const float o2 = v[j].z * rstd * gg.z * (1.f + s1.z) + s0.z, o3 = v[j].w * rstd * gg.w * (1.f + s1.w) + s0.w;
        u32x2 w; w.x = cvt_pk(o0, o1); w.y = cvt_pk(o2, o3); *(u32x2*)(orow + c) = w; }
}
__device__ __forceinline__ void phase1(const Args& a, int vcu, int G) {
    const int lane = threadIdx.x & 63, gw = vcu * NWAVE + (threadIdx.x >> 6), NGW = G * NWAVE;
    const float* mod = (const float*)(a.ws + C_MOD); bf16* H = (bf16*)(a.ws + WS_H);
    for (int t = gw; t < NTOK; t += NGW) { const int b = t / S;
        norm_mod_row(a.x + (size_t)t * D, a.norm1_g, mod + b * 6 * D, mod + b * 6 * D + D, H + (size_t)t * D, lane); }
}
__device__ __forceinline__ void phase2(const Args& a, LAS unsigned char* lds, int vcu, int G) {
    typedef GemmCore<4, 2, 2, 4, 4, false, false> GC;
    const int lane = threadIdx.x & 63, wave = __builtin_amdgcn_readfirstlane(threadIdx.x >> 6), wm = wave / 4, wn = wave % 4, h = lane >> 5, l31 = lane & 31;
    const bf16* H = (const bf16*)(a.ws + WS_H);
    bf16* QA = (bf16*)(a.ws + WS_QA); bf16* KA = (bf16*)(a.ws + WS_KA); bf16* VAT = (bf16*)(a.ws + WS_VAT);
    bf16* QB = (bf16*)(a.ws + WS_QB); bf16* KB = (bf16*)(a.ws + WS_KB); bf16* VBT = (bf16*)(a.ws + WS_VBT); float* ksum = (float*)(a.ws + C_KSUM);
    constexpr int NPM = NTOK / 256, NPN = INC / 256;
    for (int u = vcu; u < NPM * NPN; u += G) {
        const int pm = u / NPN, pn = u % NPN;
        f32x16 acc[4][2]; zero_acc(acc);
        const bf16* Ab = H + (size_t)pm * 256 * D; const float* Wb = a.w_in + pn * 256;
        GC::run(lds, [&](int r) { return Ab + (size_t)r * D; }, [&](int c) { return Wb + c; }, INC, D / 32, acc, nullptr);
        const int b = (pm * 256) / S, s0 = (pm * 256) % S + wm * 128;
#pragma unroll
        for (int cb = 0; cb < 2; ++cb) {
            const int col = pn * 256 + wn * 64 + cb * 32 + l31;
            int kind, hh, d;
            bf16* base; int nh; bool isKB = false;
            if (col < 512)       { kind = 0; hh = col >> 6; d = col & 63; base = QA; nh = 8; }
            else if (col < 640)  { kind = 1; hh = (col - 512) >> 6; d = col & 63; base = KA; nh = 2; }
            else if (col < 768)  { kind = 2; hh = (col - 640) >> 6; d = col & 63; base = VAT; nh = 2; }
            else if (col < 1280) { kind = 0; hh = (col - 768) >> 6; d = col & 63; base = QB; nh = 8; }
            else if (col < 1792) { kind = 1; hh = (col - 1280) >> 6; d = col & 63; base = KB; nh = 8; isKB = true; }
            else                 { kind = 2; hh = (col - 1792) >> 6; d = col & 63; base = VBT; nh = 8; }
            if (kind == 2) {
                bf16* vp = base + ((size_t)(b * nh + hh) * 64 + d) * S + s0;
#pragma unroll
                for (int rb = 0; rb < 4; ++rb)
#pragma unroll
                    for (int g4 = 0; g4 < 4; ++g4) { u32x2 w; w.x = cvt_pk(acc[rb][cb][4 * g4], acc[rb][cb][4 * g4 + 1]); w.y = cvt_pk(acc[rb][cb][4 * g4 + 2], acc[rb][cb][4 * g4 + 3]);
                        *(u32x2*)(vp + rb * 32 + 8 * g4 + 4 * h) = w; }
            } else {
                const float sc = (kind == 0) ? QSCALE : 1.f;
                bf16* qp = base + ((size_t)(b * nh + hh) * S + s0) * 64 + d;
                float csum = 0.f;
#pragma unroll
                for (int rb = 0; rb < 4; ++rb)
#pragma unroll
                    for (int r = 0; r < 16; ++r) { const float v = acc[rb][cb][r]; csum += v; qp[(size_t)(rb * 32 + roff(r, h)) * 64] = f2bf(v * sc); }
                if (isKB) { csum += __shfl_xor(csum, 32); if (h == 0) atomicAdd(&ksum[((size_t)(b * 8 + hh) * 8 + (s0 >> 8)) * 64 + d], csum); }
            }
        }
    }
}
constexpr int KT_STRIDE = 144, VT_STRIDE = 528;
constexpr int AT_K_OFF = 0, AT_V_OFF = 256 * KT_STRIDE  , AT_LUT_OFF = AT_V_OFF + 64 * VT_STRIDE  , AT_KS_OFF = AT_LUT_OFF + 10240, AT_END = AT_KS_OFF + 2048;
struct AttnSt { f32x16 o0, o1; float m, l; };
__device__ __forceinline__ void attn_tile(const LAS unsigned char* lds, int kt, int lut_idx, const bf16x8 (&bq)[4], AttnSt& st, int lane) {
    const int i = lane & 31, hh = lane >> 5;
    const int kap = (i & 0x13) | ((i & 4) << 1) | ((i & 8) >> 1);
    const LAS unsigned char* kp = lds + AT_K_OFF + (kt * 32 + kap) * KT_STRIDE + 16 * hh;
    f32x16 p;
#pragma unroll
    for (int r = 0; r < 16; ++r) p[r] = 0.f;
#pragma unroll
    for (int s = 0; s < 4; ++s) { const bf16x8 kf = *(const LAS bf16x8*)(kp + 32 * s); p = MFMA32(kf, bq[s], p); }
    const LAS float* lp = (const LAS float*)(lds + AT_LUT_OFF) + lut_idx;
    float tmax = NEGBIG;
#pragma unroll
    for (int r = 0; r < 16; ++r) { p[r] += lp[23 - (16 * (r >> 3) + (r & 7))]; tmax = fmaxf(tmax, p[r]); }
    tmax = fmaxf(tmax, __shfl_xor(tmax, 32));
    const float mn = fmaxf(st.m, tmax), alpha = exp2f(st.m - mn);
    float ps = 0.f;
#pragma unroll
    for (int r = 0; r < 16; ++r) { p[r] = exp2f(p[r] - mn); ps += p[r]; }
    st.l = st.l * alpha + ps; st.m = mn;
#pragma unroll
    for (int r = 0; r < 16; ++r) { st.o0[r] *= alpha; st.o1[r] *= alpha; }
    bf16x8 pb[2];
#pragma unroll
    for (int s = 0; s < 2; ++s) { u32x4 w; w.x = cvt_pk(p[8 * s], p[8 * s + 1]); w.y = cvt_pk(p[8 * s + 2], p[8 * s + 3]); w.z = cvt_pk(p[8 * s + 4], p[8 * s + 5]); w.w = cvt_pk(p[8 * s + 6], p[8 * s + 7]);
        pb[s] = __builtin_bit_cast(bf16x8, w); }
    const LAS unsigned char* vp = lds + AT_V_OFF + i * VT_STRIDE + (kt * 32 + 8 * hh) * 2;
#pragma unroll
    for (int s = 0; s < 2; ++s) {
        const bf16x8 v0 = *(const LAS bf16x8*)(vp + 32 * s), v1 = *(const LAS bf16x8*)(vp + 32 * VT_STRIDE + 32 * s);
        st.o0 = MFMA32(v0, pb[s], st.o0); st.o1 = MFMA32(v1, pb[s], st.o1);
    }
}
__device__ __forceinline__ void attn_stage(LAS unsigned char* lds, const bf16* kg, const bf16* vtg, int tid) {
#pragma unroll
    for (int i = 0; i < 4; ++i) { const int p = tid + NTHR * i, key = p >> 3, c = p & 7;
        *(LAS u32x4*)(lds + AT_K_OFF + key * KT_STRIDE + c * 16) = *(const u32x4*)(kg + (size_t)key * 64 + c * 8); }
#pragma unroll
    for (int i = 0; i < 4; ++i) { const int p = tid + NTHR * i, d = p >> 5, c = p & 31;
        *(LAS u32x4*)(lds + AT_V_OFF + d * VT_STRIDE + c * 16) = *(const u32x4*)(vtg + (size_t)d * S + c * 8); }
}
__device__ __forceinline__ void attn_init(AttnSt& st) {
#pragma unroll
    for (int r = 0; r < 16; ++r) { st.o0[r] = 0.f; st.o1[r] = 0.f; }
    st.m = NEGBIG; st.l = 0.f;
}
__device__ __forceinline__ void attn_loadq(const bf16* qrow, bf16x8 (&bq)[4], int lane) {
    const int hh = lane >> 5;
#pragma unroll
    for (int s = 0; s < 4; ++s) bq[s] = *(const bf16x8*)(qrow + 16 * s + 8 * hh);
}
__device__ __forceinline__ void attn_finish(AttnSt& st, bool has_sink, float sink_l2, const float* gain, bf16* attrow, float* ssq_tok, int lane) {
    const int hh = lane >> 5;
    float l = st.l + __shfl_xor(st.l, 32), inv;
    if (has_sink) { const float mn = fmaxf(st.m, sink_l2), al = exp2f(st.m - mn); l = l * al + exp2f(sink_l2 - mn); inv = al / l; } else inv = 1.f / l;
    float sq = 0.f;
#pragma unroll
    for (int db = 0; db < 2; ++db)
#pragma unroll
        for (int g4 = 0; g4 < 4; ++g4) { const int d0 = db * 32 + 8 * g4 + 4 * hh; const f32x4 gg = *(const f32x4*)(gain + d0);
            const f32x16& o = db ? st.o1 : st.o0;
            const float v0 = o[4 * g4] * inv, v1 = o[4 * g4 + 1] * inv, v2 = o[4 * g4 + 2] * inv, v3 = o[4 * g4 + 3] * inv;
            sq += (v0 * v0 + v1 * v1) + (v2 * v2 + v3 * v3);
            u32x2 w; w.x = cvt_pk(v0 * gg.x, v1 * gg.y); w.y = cvt_pk(v2 * gg.z, v3 * gg.w); *(u32x2*)(attrow + d0) = w; }
    sq += __shfl_xor(sq, 32);
    if (hh == 0) *ssq_tok = sq;
}
__device__ __forceinline__ void phase3(const Args& a, LAS unsigned char* lds, int vcu, int G) {
    const int tid = threadIdx.x, lane = tid & 63, wave = __builtin_amdgcn_readfirstlane(tid >> 6), l31 = lane & 31, hh2 = lane >> 5;
    const bf16* QA = (const bf16*)(a.ws + WS_QA); const bf16* KA = (const bf16*)(a.ws + WS_KA); const bf16* VAT = (const bf16*)(a.ws + WS_VAT);
    const bf16* QB = (const bf16*)(a.ws + WS_QB); const bf16* KB = (const bf16*)(a.ws + WS_KB); const bf16* VBT = (const bf16*)(a.ws + WS_VBT);
    const float* ksum = (const float*)(a.ws + C_KSUM); const float* lut = (const float*)(a.ws + WS_LUT);
    bf16* ATT = (bf16*)(a.ws + WS_ATT); float* ssq = (float*)(a.ws + WS_SSQ);
    LAS float* lutl = (LAS float*)(lds + AT_LUT_OFF); LAS float* ksl = (LAS float*)(lds + AT_KS_OFF);
    for (int uu = vcu; uu < 256; uu += G) {
        const int bh = uu >> 2, b = bh >> 3, hd = bh & 7;
        for (int half = 0; half < 2; ++half) {
            const int qb = half ? (uu & 3) : 7 - (uu & 3);
            __syncthreads();
            for (int i = tid; i < LUTN; i += NTHR) lutl[i] = lut[(8 + hd) * LUTN + i];
            if (tid < 512) ksl[tid] = ksum[((size_t)bh * 8) * 64 + tid];
            const bf16* kbase = KB + (size_t)bh * S * 64; const bf16* vbase = VBT + (size_t)bh * 64 * S;
            attn_stage(lds, kbase + (size_t)qb * 256 * 64, vbase + qb * 256, tid);
            const int q0 = qb * 256 + wave * 32, qpos = q0 + l31;
            bf16x8 bq[4]; attn_loadq(QB + ((size_t)bh * S + qpos) * 64, bq, lane);
            __syncthreads();
            unsigned sel = 0;
            {
                float g[7];
#pragma unroll
                for (int j = 0; j < 7; ++j) { float s = 0.f;
#pragma unroll
                    for (int sI = 0; sI < 4; ++sI)
#pragma unroll
                        for (int e = 0; e < 8; ++e) s += bf2f((bf16)bq[sI][e]) * ksl[j * 64 + 16 * sI + 8 * hh2 + e];
                    s += __shfl_xor(s, 32); g[j] = (j < qb) ? s : -INFINITY; }
#pragma unroll
                for (int r = 0; r < 3; ++r) if (r < qb) { int best = 0; float bv = -INFINITY;
#pragma unroll
                    for (int j = 6; j >= 0; --j) if (j < qb && !((sel >> j) & 1u) && g[j] >= bv) { bv = g[j]; best = j; }
                    sel |= 1u << best; }
            }
            AttnSt st; attn_init(st);
            for (int kt = 0; kt <= wave; ++kt) attn_tile(lds, kt, LUT_NEG + qpos - (qb * 256 + kt * 32) - 8 * hh2 - 23, bq, st, lane);
            for (int j = 0; j < qb; ++j) {
                __syncthreads();
                attn_stage(lds, kbase + (size_t)j * 256 * 64, vbase + j * 256, tid);
                __syncthreads();
                const bool mine = (sel >> j) & 1u;
                if (__ballot(mine) != 0ull) {
                    for (int kt = 0; kt < 8; ++kt) { const int li = mine ? (LUT_NEG + qpos - (j * 256 + kt * 32) - 8 * hh2 - 23) : 64;
                        attn_tile(lds, kt, li, bq, st, lane); }
                }
            }
            const int t = b * S + qpos;
            attn_finish(st, false, 0.f, a.out_norm_b + hd * 64, ATT + (size_t)t * D + 512 + hd * 64, ssq + t * 16 + 8 + hd, lane);
        }
    }
    for (int u = vcu; u < 256; u += G) {
        const int b = u >> 5, kv = (u >> 4) & 1, n = u & 15;
        __syncthreads();
        for (int i = tid; i < 4 * 512; i += NTHR) { const int g = i >> 9, p = i & 511; lutl[i] = lut[(kv * 4 + g) * LUTN + p]; }
        const int kb0 = (n - 1) * 128, kld = kb0 < 0 ? 0 : kb0;
        attn_stage(lds, KA + ((size_t)(b * 2 + kv) * S + kld) * 64, VAT + (size_t)(b * 2 + kv) * 64 * S + kld, tid);
        __syncthreads();
        for (int ti = 0; ti < 2; ++ti) {
            const int tk = wave * 2 + ti, g = tk >> 2, jq = tk & 3, hd = kv * 4 + g;
            const int qpos = n * 128 + jq * 32 + l31, t = b * S + qpos;
            bf16x8 bq[4]; attn_loadq(QA + ((size_t)(b * 8 + hd) * S + qpos) * 64, bq, lane);
            AttnSt st; attn_init(st);
            if (n > 0) { for (int kt = jq + 4; kt >= jq; --kt) attn_tile(lds, kt, g * 512 + 256 + qpos - (kb0 + kt * 32) - 8 * hh2 - 23, bq, st, lane); }
            else { for (int kt = jq; kt >= 0; --kt) attn_tile(lds, kt, g * 512 + 256 + qpos - (kt * 32) - 8 * hh2 - 23, bq, st, lane); }
            attn_finish(st, true, a.sinks[hd] * LOG2E, a.out_norm_a + hd * 64, ATT + (size_t)t * D + hd * 64, ssq + t * 16 + hd, lane);
        }
    }
}
__device__ __forceinline__ void phase4(const Args& a, LAS unsigned char* lds, int vcu, int G) {
    typedef GemmCore<4, 2, 2, 4, 4, false, false> GC;
    const int tid = threadIdx.x, lane = tid & 63, wave = __builtin_amdgcn_readfirstlane(tid >> 6), wm = wave / 4, wn = wave % 4, h = lane >> 5, l31 = lane & 31;
    const bf16* ATT = (const bf16*)(a.ws + WS_ATT); const float* ssq = (const float*)(a.ws + WS_SSQ);
    const float* mod = (const float*)(a.ws + C_MOD); float* X1 = (float*)(a.ws + WS_X1);
    LAS float* rsc = (LAS float*)(lds + GC::LDS_NEED);
    for (int u = vcu; u < 64 * 4; u += G) {
        const int pm = u >> 2, pn = u & 3;
        __syncthreads();
        if (tid < 256) { const int t = pm * 256 + tid; const f32x4 q0 = *(const f32x4*)(ssq + t * 16), q1 = *(const f32x4*)(ssq + t * 16 + 4), q2 = *(const f32x4*)(ssq + t * 16 + 8), q3 = *(const f32x4*)(ssq + t * 16 + 12);
            const float sa = ((q0.x + q0.y) + (q0.z + q0.w)) + ((q1.x + q1.y) + (q1.z + q1.w)), sb = ((q2.x + q2.y) + (q2.z + q2.w)) + ((q3.x + q3.y) + (q3.z + q3.w));
            const float ra = rsqrtf(sa * (1.f / 512.f) + EPS), rb = rsqrtf(sb * (1.f / 512.f) + EPS); rsc[tid] = ra / rb; rsc[256 + tid] = rb; }
        f32x16 acc[4][2]; zero_acc(acc);
        const bf16* Ab = ATT + (size_t)pm * 256 * D; const float* Wb = a.w_out + pn * 256;
        GC::run_h(lds, [&](int r) { return Ab + (size_t)r * D; }, [&](int c) { return Wb + c; }, D, 32, acc, nullptr,
            [&](int ks, f32x16 (&ac)[4][2]) { if (ks == 16) {
#pragma unroll
                for (int rb = 0; rb < 4; ++rb)
#pragma unroll
                    for (int r = 0; r < 16; ++r) { const float f = rsc[wm * 128 + rb * 32 + roff(r, h)]; ac[rb][0][r] *= f; ac[rb][1][r] *= f; } } });
        const int b = (pm * 256) / S;
#pragma unroll
        for (int cb = 0; cb < 2; ++cb) { const int col = pn * 256 + wn * 64 + cb * 32 + l31; const float g1 = mod[b * 6 * D + 2 * D + col];
#pragma unroll
            for (int rb = 0; rb < 4; ++rb)
#pragma unroll
                for (int g4 = 0; g4 < 4; ++g4) { const int lr = wm * 128 + rb * 32 + 8 * g4 + 4 * h;
                    size_t o4 = (size_t)(pm * 256 + lr) * D + col; asm volatile("" : "+v"(o4));
                    const f32x4 rv = *(const LAS f32x4*)(rsc + 256 + lr);
#pragma unroll
                    for (int e = 0; e < 4; ++e) X1[o4 + (size_t)e * D] = a.x[o4 + (size_t)e * D] + g1 * acc[rb][cb][4 * g4 + e] * rv[e]; } }
    }
}
__device__ __forceinline__ void phase5(const Args& a, LAS unsigned char* lds, int vcu, int G) {
    typedef GemmCore<2, 1, 1, 8, 4, false, false> GC;
    const int tid = threadIdx.x, lane = tid & 63, wave = __builtin_amdgcn_readfirstlane(tid >> 6), h = lane >> 5, l31 = lane & 31;
    const float* X1 = (const float*)(a.ws + WS_X1); const float* mod = (const float*)(a.ws + C_MOD); bf16* H2 = (bf16*)(a.ws + WS_H2);
    int* cnt = (int*)(a.ws + C_CNT); int* list = (int*)(a.ws + WS_LIST); float* ew = (float*)(a.ws + WS_EW);
    LAS float* lg = (LAS float*)(lds + 65536);
    for (int u = vcu; u < NTOK / 64; u += G) {
        const int t0 = u * 64, b = t0 / S;
        for (int i = 0; i < 8; ++i) { const int t = t0 + wave * 8 + i;
            norm_mod_row(X1 + (size_t)t * D, a.norm2_g, mod + b * 6 * D + 3 * D, mod + b * 6 * D + 4 * D, H2 + (size_t)t * D, lane); }
        asm volatile("s_waitcnt vmcnt(0)" ::: "memory");
        __syncthreads();
        f32x16 acc[2][1]; zero_acc(acc);
        const bf16* Ab = H2 + (size_t)t0 * D;
        GC::run(lds, [&](int r) { return Ab + (size_t)r * D; }, [&](int c) { return a.w_router + c; }, NE, D / 32, acc, nullptr);
#pragma unroll
        for (int rb = 0; rb < 2; ++rb)
#pragma unroll
            for (int r = 0; r < 16; ++r) lg[(rb * 32 + roff(r, h)) * 256 + wave * 32 + l31] = acc[rb][0][r];
        __syncthreads();
        for (int i = 0; i < 8; ++i) {
            const int row = wave * 8 + i, t = t0 + row;
            const f32x4 lv = *(const LAS f32x4*)(lg + row * 256 + lane * 4); const f32x4 eb = *(const f32x4*)(a.e_bias + lane * 4);
            float sc[4], sl[4];
#pragma unroll
            for (int j = 0; j < 4; ++j) { sc[j] = 1.f / (1.f + __expf(-lv[j])); sl[j] = sc[j] + eb[j]; }
            float m1 = fmaxf(sl[0], sl[1]), m2 = fminf(sl[0], sl[1]);
            { const float c1 = fmaxf(sl[2], sl[3]), c2 = fminf(sl[2], sl[3]); const float n1 = fmaxf(m1, c1), n2 = fmaxf(fminf(m1, c1), fmaxf(m2, c2)); m1 = n1; m2 = n2; }
#pragma unroll
            for (int o = 1; o < 8; o <<= 1) { const float c1 = __shfl_xor(m1, o), c2 = __shfl_xor(m2, o); const float n1 = fmaxf(m1, c1), n2 = fmaxf(fminf(m1, c1), fmaxf(m2, c2)); m1 = n1; m2 = n2; }
            const float gs = m1 + m2; const int grp = lane >> 3;
            int rank = 0;
#pragma unroll
            for (int g2 = 0; g2 < 8; ++g2) { const float og = __shfl(gs, g2 * 8); rank += (og > gs || (og == gs && g2 < grp)) ? 1 : 0; }
            const bool gsel = rank < 4;
#pragma unroll
            for (int j = 0; j < 4; ++j) if (!gsel) sl[j] = -INFINITY;
            int myidx = 0; float mysc = 0.f, wsum = 0.f;
            for (int r = 0; r < TOPK; ++r) {
                float bv = sl[0]; int bi = 0;
#pragma unroll
                for (int j = 1; j < 4; ++j) if (sl[j] > bv) { bv = sl[j]; bi = j; }
                bi += lane * 4;
#pragma unroll
                for (int o = 1; o < 64; o <<= 1) { const float ov = __shfl_xor(bv, o); const int oi = __shfl_xor(bi, o); if (ov > bv || (ov == bv && oi < bi)) { bv = ov; bi = oi; } }
                const int j = bi & 3; const bool own = (bi >> 2) == lane;
                const float scj = (j == 0) ? sc[0] : (j == 1) ? sc[1] : (j == 2) ? sc[2] : sc[3];
                const float scw = __shfl(scj, bi >> 2);
                if (own) { if (j == 0) sl[0] = -INFINITY; else if (j == 1) sl[1] = -INFINITY; else if (j == 2) sl[2] = -INFINITY; else sl[3] = -INFINITY; }
                wsum += scw;
                if (lane == r) { myidx = bi; mysc = scw; }
            }
            if (lane < TOPK) { const int slot = atomicAdd(&cnt[myidx], 1); list[(size_t)myidx * NTOK + slot] = t * 8 + lane; ew[t * 8 + lane] = mysc / wsum * 2.5f; }
        }
        __syncthreads();
    }
}
constexpr int MOE_H_OFF = 81920;
__device__ __forceinline__ void phase6(const Args& a, LAS unsigned char* lds, int vcu, int G) {
    typedef GemmCore<2, 4, 2, 4, 8, false, true> G1;
    typedef GemmCore<2, 4, 2, 4, 8, true, true> G2;
    static_assert(G1::LDS_NEED <= MOE_H_OFF && MOE_H_OFF + 8 * 8192 <= LDS_CTL_OFF, "MoE LDS map");
    const int tid = threadIdx.x, lane = tid & 63, wave = __builtin_amdgcn_readfirstlane(tid >> 6), wm = wave / 4, wn = wave % 4, h = lane >> 5, l31 = lane & 31;
    const bf16* H2 = (const bf16*)(a.ws + WS_H2); const int* cnt = (const int*)(a.ws + C_CNT); const int* list = (const int*)(a.ws + WS_LIST); const float* ew = (const float*)(a.ws + WS_EW);
    bf16* YBUF = (bf16*)(a.ws + WS_YBUF); bf16* YSH = (bf16*)(a.ws + WS_YSH);
    LAS int* pf = (LAS int*)(lds + 0);
    __syncthreads();
    if (tid < NE) pf[tid + 1] = (cnt[tid] + 127) >> 7;
    if (tid == 0) pf[0] = 0;
    __syncthreads();
    if (tid == 0) { int s = 0; for (int e = 0; e < NE; ++e) { s += pf[e + 1]; pf[e + 1] = s; } }
    __syncthreads();
    const int R = pf[NE];
    const int NSH = NTOK / 128;
    LAS int* myu = (LAS int*)(lds + LDS_CTL_OFF + 256);
    const int total = NSH + R;
    int nmy = 0;
    for (int u = vcu; u < total; u += G) ++nmy;
    if (nmy > 16) nmy = 16;
    if (tid < nmy) { const int u = vcu + tid * G; int e, ci;
        if (u < NSH) { e = NE; ci = u; }
        else { const int ru = u - NSH; int lo = 0, hi = NE - 1; while (lo < hi) { const int mid = (lo + hi) >> 1; if (pf[mid + 1] > ru) hi = mid; else lo = mid + 1; } e = lo; ci = ru - pf[lo]; }
        myu[tid] = e; myu[16 + tid] = ci; }
    __syncthreads();
    LAS int* rowa = (LAS int*)(lds + LDS_CTL_OFF + 384);
    for (int iu = 0; iu < nmy; ++iu) {
        const int e = myu[iu], ci = myu[16 + iu];
        const int n = (e < NE) ? min(128, cnt[e] - ci * 128) : 128;
        const float* W1 = (e < NE) ? a.w1 + (size_t)e * D * ED : a.ws1; const float* W3 = (e < NE) ? a.w3 + (size_t)e * D * ED : a.ws3; const float* W2 = (e < NE) ? a.w2 + (size_t)e * ED * D : a.ws2;
        __syncthreads();
        if (tid < 128) rowa[tid] = (tid < n) ? ((e < NE) ? list[(size_t)e * NTOK + ci * 128 + tid] : ci * 128 + tid) : -1;
        __syncthreads();
        f32x16 acc[2][4]; zero_acc(acc);
        G1::run(lds, [&](int r) { const int aid = rowa[r]; const int tok = (aid < 0) ? 0 : ((e < NE) ? (aid >> 3) : aid); return H2 + (size_t)tok * D; },
                [&](int c) { const int w4 = c >> 7, within = c & 127; return (within < 64) ? (W1 + 64 * w4 + within) : (W3 + 64 * w4 + within - 64); }, ED, D / 32, acc, nullptr);
        {
#pragma unroll
            for (int rb = 0; rb < 2; ++rb) { const int row = wm * 64 + rb * 32 + l31;
#pragma unroll
                for (int cb = 0; cb < 2; ++cb)
#pragma unroll
                    for (int g4 = 0; g4 < 4; ++g4) { float hv[4];
#pragma unroll
                        for (int e4 = 0; e4 < 4; ++e4) { const float gt = acc[rb][cb][4 * g4 + e4], up = acc[rb][cb + 2][4 * g4 + e4]; hv[e4] = gt / (1.f + __expf(-gt)) * up; }
                        u32x2 w; w.x = cvt_pk(hv[0], hv[1]); w.y = cvt_pk(hv[2], hv[3]);
                        const int ks2 = 2 * wn + cb;
                        *(LAS u32x2*)(lds + MOE_H_OFF + ks2 * 8192 + row * 64 + ((g4 ^ ((row >> 2) & 3)) << 4) + 8 * h) = w; } }
        }
        __syncthreads();
        const int aid0 = rowa[wm * 64 + l31], aid1 = rowa[wm * 64 + 32 + l31];
        for (int nh = 0; nh < 2; ++nh) {
            zero_acc(acc);
            G2::run(lds, [&](int) { return (const bf16*)nullptr; }, [&](int c) { return W2 + nh * 512 + c; }, D, ED / 32, acc, lds + MOE_H_OFF);
#pragma unroll
            for (int rb = 0; rb < 2; ++rb) { const int aid = rb ? aid1 : aid0; if (aid < 0) continue;
                const float wgt = (e < NE) ? ew[aid] : 1.f; bf16* dst = ((e < NE) ? YBUF : YSH) + (size_t)aid * D + nh * 512 + wn * 128;
#pragma unroll
                for (int cb = 0; cb < 4; ++cb)
#pragma unroll
                    for (int g4 = 0; g4 < 4; ++g4) { u32x2 w; w.x = cvt_pk(acc[rb][cb][4 * g4] * wgt, acc[rb][cb][4 * g4 + 1] * wgt); w.y = cvt_pk(acc[rb][cb][4 * g4 + 2] * wgt, acc[rb][cb][4 * g4 + 3] * wgt);
                        *(u32x2*)(dst + cb * 32 + 8 * g4 + 4 * h) = w; } }
        }
    }
}
__device__ __forceinline__ void phase7(const Args& a, int vcu, int G) {
    const int lane = threadIdx.x & 63, gw = vcu * NWAVE + (threadIdx.x >> 6), NGW = G * NWAVE;
    const float* X1 = (const float*)(a.ws + WS_X1); const float* mod = (const float*)(a.ws + C_MOD);
    const bf16* YBUF = (const bf16*)(a.ws + WS_YBUF); const bf16* YSH = (const bf16*)(a.ws + WS_YSH);
    for (int t = gw; t < NTOK; t += NGW) { const int b = t / S;
        f32x4 v[4]; float s = 0.f;
#pragma unroll
        for (int j = 0; j < 4; ++j) { const int c = j * 256 + lane * 4;
            u32x2 w = *(const u32x2*)(YSH + (size_t)t * D + c);
            float m0 = __uint_as_float(w.x << 16), m1 = __uint_as_float(w.x & 0xffff0000u), m2 = __uint_as_float(w.y << 16), m3 = __uint_as_float(w.y & 0xffff0000u);
#pragma unroll
            for (int r = 0; r < 8; ++r) { w = *(const u32x2*)(YBUF + ((size_t)t * 8 + r) * D + c);
                m0 += __uint_as_float(w.x << 16); m1 += __uint_as_float(w.x & 0xffff0000u); m2 += __uint_as_float(w.y << 16); m3 += __uint_as_float(w.y & 0xffff0000u); }
            const f32x4 xv = *(const f32x4*)(X1 + (size_t)t * D + c), g2 = *(const f32x4*)(mod + b * 6 * D + 5 * D + c);
            v[j].x = xv.x + g2.x * m0; v[j].y = xv.y + g2.y * m1; v[j].z = xv.z + g2.z * m2; v[j].w = xv.w + g2.w * m3;
            s += (v[j].x * v[j].x + v[j].y * v[j].y) + (v[j].z * v[j].z + v[j].w * v[j].w); }
        const float rstd = rsqrtf(wave_sum(s) * (1.f / D) + EPS);
#pragma unroll
        for (int j = 0; j < 4; ++j) { const int c = j * 256 + lane * 4; const f32x4 fg = *(const f32x4*)(a.final_g + c);
            f32x4 o; o.x = v[j].x * rstd * fg.x; o.y = v[j].y * rstd * fg.y; o.z = v[j].z * rstd * fg.z; o.w = v[j].w * rstd * fg.w;
            *(f32x4*)(a.out + (size_t)t * D + c) = o; }
    }
}
__global__ void __launch_bounds__(NTHR, 2) mega(Args a) {
    extern __shared__ __attribute__((aligned(16))) unsigned char lds_raw[];
    LAS unsigned char* lds = (LAS unsigned char*)lds_raw;
    const int tid = threadIdx.x, G = gridDim.x;
    const int bx = blockIdx.x, vcu = (G % 8 == 0) ? (bx % 8) * (G / 8) + bx / 8 : bx;
    volatile LAS unsigned* ctl = (volatile LAS unsigned*)(lds + LDS_CTL_OFF);
    if (tid < 64) ctl[tid] = 0u;
    __syncthreads();
    XcdBarrier bar; bar.bar = (unsigned*)(a.ws + C_BAR); bar.x = 0; bar.st = ctl;
    if (a.ph_hi - a.ph_lo > 1) bar = xcd_barrier_post((unsigned*)(a.ws + C_BAR), ctl);
    const int lo = a.ph_lo, hi = a.ph_hi;
#ifndef ONLY_PHASE
#define ONLY_PHASE -1
#endif
#define IN(k) (lo <= (k) && (k) < hi && (ONLY_PHASE < 0 || ONLY_PHASE == (k)))
#define SEAM(k) do { if (IN(k) && IN((k) + 1)) xcd_barrier(bar); } while (0)
    if (IN(0)) phase0(a, lds, vcu, G);
    SEAM(0);
    if (IN(1)) phase1(a, vcu, G);
    SEAM(1);
    if (IN(2)) phase2(a, lds, vcu, G);
    SEAM(2);
    if (IN(3)) phase3(a, lds, vcu, G);
    SEAM(3);
    if (IN(4)) phase4(a, lds, vcu, G);
    SEAM(4);
    if (IN(5)) phase5(a, lds, vcu, G);
    SEAM(5);
    if (IN(6)) phase6(a, lds, vcu, G);
    SEAM(6);
    if (IN(7)) phase7(a, vcu, G);
#undef IN
#undef SEAM
}

#ifndef OPT_MASK
#define OPT_MASK 0xFF
#endif
static void launch_mega(const Args& base, int lo, int hi, int grid, hipStream_t stream) {
    Args a = base; a.ph_lo = lo; a.ph_hi = hi;
    hipLaunchKernelGGL(mega, dim3(grid), dim3(NTHR), LDS_BYTES, stream, a);
}
extern "C" void kernel_launch(void* const* d_in, const int* in_sizes, int n_in, void* d_out, int out_size, void* d_ws, size_t ws_size, hipStream_t stream) {
    static int grid = 0;
    if (grid == 0) {
        if (n_in != 21 || ws_size < WS_END) { fprintf(stderr, "kernel_launch: unexpected n_in %d or ws_size %zu\n", n_in, ws_size); grid = -1; return; }
        int dev = 0, cus = 0, per_cu = 0;
        if (hipGetDevice(&dev) != hipSuccess || hipDeviceGetAttribute(&cus, hipDeviceAttributeMultiprocessorCount, dev) != hipSuccess) { grid = -1; return; }
        if (hipFuncSetAttribute((const void*)mega, hipFuncAttributeMaxDynamicSharedMemorySize, LDS_BYTES) != hipSuccess) { fprintf(stderr, "kernel_launch: hipFuncSetAttribute failed\n"); grid = -1; return; }
        if (hipOccupancyMaxActiveBlocksPerMultiprocessor(&per_cu, (const void*)mega, NTHR, LDS_BYTES) != hipSuccess || per_cu < 1) { fprintf(stderr, "kernel_launch: occupancy query says %d blocks per CU\n", per_cu); (void)hipGetLastError(); grid = -1; return; }
        grid = cus;
    }
    if (grid < 0) return;
    unsigned char* ws = (unsigned char*)d_ws;
    Args a{};
    a.x = (const float*)d_in[0]; a.c = (const float*)d_in[1]; a.w_ada = (const float*)d_in[2]; a.b_ada = (const float*)d_in[3]; a.norm1_g = (const float*)d_in[4]; a.w_in = (const float*)d_in[5];
    a.sinks = (const float*)d_in[6]; a.rel_table = (const float*)d_in[7]; a.out_norm_a = (const float*)d_in[8]; a.out_norm_b = (const float*)d_in[9]; a.w_out = (const float*)d_in[10];
    a.norm2_g = (const float*)d_in[11]; a.w_router = (const float*)d_in[12]; a.e_bias = (const float*)d_in[13]; a.w1 = (const float*)d_in[14]; a.w3 = (const float*)d_in[15]; a.w2 = (const float*)d_in[16];
    a.ws1 = (const float*)d_in[17]; a.ws3 = (const float*)d_in[18]; a.ws2 = (const float*)d_in[19]; a.final_g = (const float*)d_in[20];
    a.out = (float*)d_out; a.ws = ws; a.ph_lo = 0; a.ph_hi = 8;
    (void)hipMemsetAsync(ws + WS_CTL, 0, CTL_BYTES, stream);
#if OPT_MASK == 0xFF && !defined(SPLIT_LAUNCH)
    launch_mega(a, 0, 8, grid, stream);
#else
    float* mod = (float*)(ws + C_MOD); float* ksum = (float*)(ws + C_KSUM); float* ssq = (float*)(ws + WS_SSQ); int* cnt = (int*)(ws + C_CNT);
    float* lut = (float*)(ws + WS_LUT); bf16* H = (bf16*)(ws + WS_H);
    bf16* QA = (bf16*)(ws + WS_QA); bf16* KA = (bf16*)(ws + WS_KA); bf16* VAT = (bf16*)(ws + WS_VAT); bf16* QB = (bf16*)(ws + WS_QB); bf16* KB = (bf16*)(ws + WS_KB); bf16* VBT = (bf16*)(ws + WS_VBT);
    bf16* ATT = (bf16*)(ws + WS_ATT); float* X1 = (float*)(ws + WS_X1); bf16* H2 = (bf16*)(ws + WS_H2); float* EW = (float*)(ws + WS_EW); int* LIST = (int*)(ws + WS_LIST);
    bf16* YSH = (bf16*)(ws + WS_YSH); bf16* YBUF = (bf16*)(ws + WS_YBUF);
    if (OPT_MASK & 1) launch_mega(a, 0, 1, grid, stream); else { k_mod<<<24, 256, 0, stream>>>(a.c, a.w_ada, a.b_ada, mod); k_lut<<<(16 * LUTN + 255) / 256, 256, 0, stream>>>(a.rel_table, lut); }
    if (OPT_MASK & 2) launch_mega(a, 1, 2, grid, stream); else k_norm_mod<<<NTOK, 256, 0, stream>>>(a.x, a.norm1_g, mod, 0, D, H);
    if (OPT_MASK & 4) launch_mega(a, 2, 3, grid, stream); else k_inproj<<<dim3(INC / 256, NTOK), 256, 0, stream>>>(H, a.w_in, QA, KA, VAT, QB, KB, VBT, ksum);
    if (OPT_MASK & 8) launch_mega(a, 3, 4, grid, stream); else { k_swa<<<NTOK * 8 / 64, 64, 0, stream>>>(QA, KA, VAT, lut, a.sinks, a.out_norm_a, ATT, ssq); k_moba<<<NTOK * 8 / 64, 64, 0, stream>>>(QB, KB, VBT, ksum, lut, a.out_norm_b, ATT, ssq); }
    if (OPT_MASK & 16) launch_mega(a, 4, 5, grid, stream); else k_outproj<<<dim3(D / 256, NTOK), 256, 0, stream>>>(ATT, ssq, a.w_out, a.x, mod, X1);
    if (OPT_MASK & 32) launch_mega(a, 5, 6, grid, stream); else { k_norm_mod<<<NTOK, 256, 0, stream>>>(X1, a.norm2_g, mod, 3 * D, 4 * D, H2); k_router<<<NTOK, 256, 0, stream>>>(H2, a.w_router, a.e_bias, cnt, LIST, EW); }
    if (OPT_MASK & 64) launch_mega(a, 6, 7, grid, stream); else k_moe<<<dim3(NTOK / 8, NE + 1), 256, 0, stream>>>(H2, cnt, LIST, EW, a.w1, a.w3, a.w2, a.ws1, a.ws3, a.ws2, YBUF, YSH);
    if (OPT_MASK & 128) launch_mega(a, 7, 8, grid, stream); else k_final<<<NTOK, 256, 0, stream>>>(X1, YBUF, YSH, mod, a.final_g, (float*)d_out);
#endif
}
```

```cpp
#include <hip/hip_runtime.h>
#include <cstdio>
#include <cstdint>

constexpr int D = 1024, NB = 8, S = 2048, NTOK = NB * S;
constexpr int HD = 64, INC = 2304;
constexpr int NE = 256, TOPK = 8, ED = 256;
constexpr float EPS = 1e-6f;
constexpr float LOG2E = 1.4426950408889634f;
constexpr float QSCALE = 0.125f * LOG2E;
constexpr float NEGBIG = -1e30f;

typedef unsigned short bf16;
__device__ __forceinline__ float bf2f(bf16 v) { return __uint_as_float(((unsigned)v) << 16); }
__device__ __forceinline__ bf16 f2bf(float f) { unsigned u = __float_as_uint(f); return (bf16)((u + 0x7fffu + ((u >> 16) & 1u)) >> 16); }

constexpr size_t MiB = 1u << 20;
constexpr size_t WS_CTL   = 0;
constexpr size_t CTL_BYTES = 1 * MiB;
constexpr size_t C_MOD   = 64 * 1024;
constexpr size_t C_KSUM  = 320 * 1024;
constexpr size_t C_SSQA  = 512 * 1024;
constexpr size_t C_SSQB  = 576 * 1024;
constexpr size_t C_CNT   = 640 * 1024;
constexpr size_t C_QHEAD = 644 * 1024;
constexpr size_t C_TS    = 648 * 1024;
constexpr size_t WS_LUT  = 1 * MiB;
constexpr size_t WS_H    = 2 * MiB;
constexpr size_t WS_QA   = 34 * MiB;
constexpr size_t WS_KA   = 50 * MiB;
constexpr size_t WS_VAT  = 54 * MiB;
constexpr size_t WS_QB   = 58 * MiB;
constexpr size_t WS_KB   = 74 * MiB;
constexpr size_t WS_VBT  = 90 * MiB;
constexpr size_t WS_ATT  = 106 * MiB;
constexpr size_t WS_X1   = 138 * MiB;
constexpr size_t WS_H2   = 202 * MiB;
constexpr size_t WS_EW   = 234 * MiB;
constexpr size_t WS_SSQ  = 235 * MiB;
constexpr size_t WS_LIST = 236 * MiB;
constexpr size_t WS_YSH  = 256 * MiB;
constexpr size_t WS_YBUF = 288 * MiB;
constexpr size_t WS_WTIN = 640 * MiB;
constexpr size_t WS_WTOUT= 645 * MiB;
constexpr size_t WS_WTR  = 647 * MiB;
constexpr size_t WS_WS13T= 648 * MiB;
constexpr size_t WS_WS2T = 649 * MiB;
constexpr size_t WS_HB   = 650 * MiB;
constexpr size_t WS_X8   = 842 * MiB;
constexpr size_t WS_END  = 858 * MiB;

constexpr int LUT_NEG = 256;
constexpr int LUTN = 2560;

__device__ __forceinline__ int t5_bucket(int n) {
    if (n < 16) return n;
    const int thr[15] = {21, 27, 35, 46, 59, 77, 99, 128, 166, 216, 280, 363, 470, 609, 790};
    int b = 16;
#pragma unroll
    for (int i = 0; i < 15; ++i) b += (n >= thr[i]) ? 1 : 0;
    return b;
}

__global__ void k_mod(const float* c, const float* w_ada, const float* b_ada, float* mod) {
    int j = blockIdx.x * blockDim.x + threadIdx.x;
    if (j >= 6 * D) return;
    float acc[NB];
#pragma unroll
    for (int b = 0; b < NB; ++b) acc[b] = 0.f;
    for (int k = 0; k < D; ++k) {
        float w = w_ada[(size_t)k * 6 * D + j];
#pragma unroll
        for (int b = 0; b < NB; ++b) { float cv = c[b * D + k]; float sv = cv / (1.f + __expf(-cv)); acc[b] += sv * w; }
    }
#pragma unroll
    for (int b = 0; b < NB; ++b) mod[b * 6 * D + j] = acc[b] + b_ada[j];
}
__global__ void k_lut(const float* rel_table, float* lut) {
    int i = blockIdx.x * blockDim.x + threadIdx.x;
    if (i >= 16 * LUTN) return;
    int h = i / LUTN, p = i % LUTN, dist = p - LUT_NEG;
    float v = NEGBIG;
    bool ok = dist >= 0 && (h < 8 ? dist < 128 : dist < S);
    if (ok) v = rel_table[t5_bucket(dist) * 16 + h] * LOG2E;
    lut[i] = v;
}
__global__ void k_norm_mod(const float* x, const float* g, const float* mod, int sh_off, int sc_off, bf16* out) {
    int t = blockIdx.x, b = t / S, tid = threadIdx.x;
    __shared__ float red[256];
    float v[4]; float s = 0.f;
#pragma unroll
    for (int i = 0; i < 4; ++i) { v[i] = x[(size_t)t * D + tid + 256 * i]; s += v[i] * v[i]; }
    red[tid] = s; __syncthreads();
    for (int o = 128; o > 0; o >>= 1) { if (tid < o) red[tid] += red[tid + o]; __syncthreads(); }
    float rstd = rsqrtf(red[0] / D + EPS);
#pragma unroll
    for (int i = 0; i < 4; ++i) { int col = tid + 256 * i;
        float hv = v[i] * rstd * g[col] * (1.f + mod[b * 6 * D + sc_off + col]) + mod[b * 6 * D + sh_off + col];
        out[(size_t)t * D + col] = f2bf(hv); }
}
__global__ void k_inproj(const bf16* h, const float* w_in, bf16* QA, bf16* KA, bf16* VAT, bf16* QB, bf16* KB, bf16* VBT, float* ksum) {
    int col = blockIdx.x * blockDim.x + threadIdx.x;
    int t = blockIdx.y;
    if (col >= INC) return;
    float acc = 0.f;
    const bf16* hr = h + (size_t)t * D;
    for (int k = 0; k < D; ++k) acc += bf2f(hr[k]) * w_in[(size_t)k * INC + col];
    int b = t / S, s = t % S;
    if (col < 512) { int hh = col / 64, d = col % 64; QA[(((size_t)b * 8 + hh) * S + s) * 64 + d] = f2bf(acc * QSCALE); }
    else if (col < 640) { int c2 = col - 512, hh = c2 / 64, d = c2 % 64; KA[(((size_t)b * 2 + hh) * S + s) * 64 + d] = f2bf(acc); }
    else if (col < 768) { int c2 = col - 640, hh = c2 / 64, d = c2 % 64; VAT[(((size_t)b * 2 + hh) * 64 + d) * S + s] = f2bf(acc); }
    else if (col < 1280) { int c2 = col - 768, hh = c2 / 64, d = c2 % 64; QB[(((size_t)b * 8 + hh) * S + s) * 64 + d] = f2bf(acc * QSCALE); }
    else if (col < 1792) { int c2 = col - 1280, hh = c2 / 64, d = c2 % 64; bf16 kb = f2bf(acc); KB[(((size_t)b * 8 + hh) * S + s) * 64 + d] = kb;
        atomicAdd(&ksum[(((size_t)b * 8 + hh) * 8 + s / 256) * 64 + d], bf2f(kb)); }
    else { int c2 = col - 1792, hh = c2 / 64, d = c2 % 64; VBT[(((size_t)b * 8 + hh) * 64 + d) * S + s] = f2bf(acc); }
}
__global__ void __launch_bounds__(64) k_swa(const bf16* QA, const bf16* KA, const bf16* VAT, const float* lut, const float* sinks, const float* gain, bf16* att, float* ssq) {
    int idx = blockIdx.x * blockDim.x + threadIdx.x;
    if (idx >= NTOK * 8) return;
    int hh = idx % 8, t = idx / 8, b = t / S, s = t % S, kv = hh / 4;
    float q[64];
    const bf16* qp = QA + (((size_t)b * 8 + hh) * S + s) * 64;
#pragma unroll
    for (int d = 0; d < 64; ++d) q[d] = bf2f(qp[d]);
    const float* L = lut + hh * LUTN + LUT_NEG;
    int n = s / 128;
    int k0 = (n == 0) ? 0 : (n - 1) * 128, k1 = s;
    float m = NEGBIG, l = 0.f; float o[64];
#pragma unroll
    for (int d = 0; d < 64; ++d) o[d] = 0.f;
    for (int kp = k0; kp <= k1; ++kp) {
        const bf16* kr = KA + (((size_t)b * 2 + kv) * S + kp) * 64;
        float sc = 0.f;
#pragma unroll
        for (int d = 0; d < 64; ++d) sc += q[d] * bf2f(kr[d]);
        sc += L[s - kp];
        float mn = fmaxf(m, sc), a = exp2f(m - mn), p = exp2f(sc - mn);
        l = l * a + p;
#pragma unroll
        for (int d = 0; d < 64; ++d) o[d] = o[d] * a + p * bf2f(VAT[(((size_t)b * 2 + kv) * 64 + d) * S + kp]);
        m = mn;
    }
    float sk = sinks[hh] * LOG2E;
    float mn = fmaxf(m, sk), a = exp2f(m - mn);
    l = l * a + exp2f(sk - mn);
    float inv = a / l, sq = 0.f;
#pragma unroll
    for (int d = 0; d < 64; ++d) { float ov = o[d] * inv; sq += ov * ov; att[(size_t)t * D + hh * 64 + d] = f2bf(ov * gain[hh * 64 + d]); }
    ssq[t * 16 + hh] = sq;
}
__global__ void __launch_bounds__(64) k_moba(const bf16* QB, const bf16* KB, const bf16* VBT, const float* ksum, const float* lut, const float* gain, bf16* att, float* ssq) {
    int idx = blockIdx.x * blockDim.x + threadIdx.x;
    if (idx >= NTOK * 8) return;
    int hh = idx % 8, t = idx / 8, b = t / S, s = t % S;
    float q[64];
    const bf16* qp = QB + (((size_t)b * 8 + hh) * S + s) * 64;
#pragma unroll
    for (int d = 0; d < 64; ++d) q[d] = bf2f(qp[d]);
    const float* L = lut + (8 + hh) * LUTN + LUT_NEG;
    int qb = s / 256;
    float gate[8];
#pragma unroll
    for (int j = 0; j < 8; ++j) {
        float gsum = -INFINITY;
        if (j < qb) { gsum = 0.f; const float* km = ksum + (((size_t)b * 8 + hh) * 8 + j) * 64;
#pragma unroll
            for (int d = 0; d < 64; ++d) gsum += q[d] * km[d]; }
        gate[j] = gsum;
    }
    unsigned sel = 0; int nsel = qb < 3 ? qb : 3;
    for (int r = 0; r < nsel; ++r) { int best = -1; float bv = -INFINITY;
#pragma unroll
        for (int j = 0; j < 8; ++j) if (j < qb && !((sel >> j) & 1) && (best < 0 || gate[j] > bv)) { best = j; bv = gate[j]; }
        sel |= 1u << best; }
    sel |= 1u << qb;
    float m = NEGBIG, l = 0.f; float o[64];
#pragma unroll
    for (int d = 0; d < 64; ++d) o[d] = 0.f;
    for (int j = 0; j <= qb; ++j) {
        if (!((sel >> j) & 1)) continue;
        int kend = (j == qb) ? s : (j * 256 + 255);
        for (int kp = j * 256; kp <= kend; ++kp) {
            const bf16* kr = KB + (((size_t)b * 8 + hh) * S + kp) * 64;
            float sc = 0.f;
#pragma unroll
            for (int d = 0; d < 64; ++d) sc += q[d] * bf2f(kr[d]);
            sc += L[s - kp];
            float mn = fmaxf(m, sc), a = exp2f(m - mn), p = exp2f(sc - mn);
            l = l * a + p;
#pragma unroll
            for (int d = 0; d < 64; ++d) o[d] = o[d] * a + p * bf2f(VBT[(((size_t)b * 8 + hh) * 64 + d) * S + kp]);
            m = mn;
        }
    }
    float inv = 1.f / l, sq = 0.f;
#pragma unroll
    for (int d = 0; d < 64; ++d) { float ov = o[d] * inv; sq += ov * ov; att[(size_t)t * D + 512 + hh * 64 + d] = f2bf(ov * gain[hh * 64 + d]); }
    ssq[t * 16 + 8 + hh] = sq;
}
__global__ void k_outproj(const bf16* att, const float* ssq, const float* w_out, const float* x, const float* mod, float* x1) {
    int col = blockIdx.x * blockDim.x + threadIdx.x, t = blockIdx.y, b = t / S;
    float sa = 0.f, sb = 0.f; for (int i = 0; i < 8; ++i) { sa += ssq[t * 16 + i]; sb += ssq[t * 16 + 8 + i]; }
    float ra = rsqrtf(sa / 512.f + EPS), rb = rsqrtf(sb / 512.f + EPS);
    const bf16* ar = att + (size_t)t * D;
    float a0 = 0.f, a1 = 0.f;
    for (int k = 0; k < 512; ++k) a0 += bf2f(ar[k]) * w_out[(size_t)k * D + col];
    for (int k = 512; k < 1024; ++k) a1 += bf2f(ar[k]) * w_out[(size_t)k * D + col];
    float y = a0 * ra + a1 * rb;
    x1[(size_t)t * D + col] = x[(size_t)t * D + col] + mod[b * 6 * D + 2 * D + col] * y;
}
__global__ void k_router(const bf16* h2, const float* w_router, const float* e_bias, int* cnt, int* list, float* ew) {
    int t = blockIdx.x, e = threadIdx.x;
    __shared__ float sc[256], sel[256], gs[8]; __shared__ int chosen[8];
    const bf16* hr = h2 + (size_t)t * D;
    float acc = 0.f;
    for (int k = 0; k < D; ++k) acc += bf2f(hr[k]) * w_router[(size_t)k * NE + e];
    float s = 1.f / (1.f + __expf(-acc));
    sc[e] = s; sel[e] = s + e_bias[e];
    __syncthreads();
    if (e < 8) { float m1 = -INFINITY, m2 = -INFINITY;
        for (int i = 0; i < 32; ++i) { float v = sel[e * 32 + i]; if (v > m1) { m2 = m1; m1 = v; } else if (v > m2) m2 = v; }
        gs[e] = m1 + m2; }
    __syncthreads();
    if (e == 0) {
        unsigned gm = 0;
        for (int r = 0; r < 4; ++r) { int best = -1; float bv = 0.f;
            for (int g = 0; g < 8; ++g) if (!((gm >> g) & 1) && (best < 0 || gs[g] > bv)) { best = g; bv = gs[g]; }
            gm |= 1u << best; }
        float wsum = 0.f;
        for (int r = 0; r < 8; ++r) { int best = -1; float bv = 0.f;
            for (int i = 0; i < 256; ++i) { if (!((gm >> (i / 32)) & 1)) continue; bool used = false; for (int q = 0; q < r; ++q) used |= (chosen[q] == i);
                if (used) continue; if (best < 0 || sel[i] > bv) { best = i; bv = sel[i]; } }
            chosen[r] = best; wsum += sc[best]; }
        for (int r = 0; r < 8; ++r) { int ex = chosen[r]; int slot = atomicAdd(&cnt[ex], 1); list[(size_t)ex * NTOK + slot] = t * 8 + r; ew[t * 8 + r] = sc[ex] / wsum * 2.5f; }
    }
}
__global__ void k_moe(const bf16* h2, const int* cnt, const int* list, const float* ew, const float* w1, const float* w3, const float* w2,
                      const float* ws1, const float* ws3, const float* ws2, bf16* ybuf, bf16* ysh) {
    int e = blockIdx.y, g = blockIdx.x, tid = threadIdx.x;
    int n = (e < NE) ? cnt[e] : NTOK;
    if (g * 8 >= n) return;
    const float* W1 = (e < NE) ? w1 + (size_t)e * D * ED : ws1;
    const float* W3 = (e < NE) ? w3 + (size_t)e * D * ED : ws3;
    const float* W2 = (e < NE) ? w2 + (size_t)e * ED * D : ws2;
    __shared__ float xs[8][1024]; __shared__ float hs[8][256]; __shared__ int aid[8];
    if (tid < 8) { int i = g * 8 + tid; aid[tid] = (i < n) ? ((e < NE) ? list[(size_t)e * NTOK + i] : i) : -1; }
    __syncthreads();
    for (int r = 0; r < 8; ++r) { int a = aid[r]; int tok = (a < 0) ? 0 : ((e < NE) ? a / 8 : a);
        for (int k = tid; k < D; k += 256) xs[r][k] = (a < 0) ? 0.f : bf2f(h2[(size_t)tok * D + k]); }
    __syncthreads();
    float gg[8], uu[8];
#pragma unroll
    for (int r = 0; r < 8; ++r) { gg[r] = 0.f; uu[r] = 0.f; }
    for (int k = 0; k < D; ++k) { float a = W1[(size_t)k * ED + tid], b = W3[(size_t)k * ED + tid];
#pragma unroll
        for (int r = 0; r < 8; ++r) { gg[r] += xs[r][k] * a; uu[r] += xs[r][k] * b; } }
#pragma unroll
    for (int r = 0; r < 8; ++r) hs[r][tid] = gg[r] / (1.f + __expf(-gg[r])) * uu[r];
    __syncthreads();
    float y[8][4];
#pragma unroll
    for (int r = 0; r < 8; ++r) {
#pragma unroll
        for (int c = 0; c < 4; ++c) y[r][c] = 0.f; }
    for (int k = 0; k < ED; ++k) {
#pragma unroll
        for (int c = 0; c < 4; ++c) { float w = W2[(size_t)k * D + tid + 256 * c];
#pragma unroll
            for (int r = 0; r < 8; ++r) y[r][c] += hs[r][k] * w; } }
#pragma unroll
    for (int r = 0; r < 8; ++r) { int a = aid[r]; if (a < 0) continue;
        float wgt = (e < NE) ? ew[a] : 1.f; bf16* dst = (e < NE) ? ybuf + (size_t)a * D : ysh + (size_t)a * D;
#pragma unroll
        for (int c = 0; c < 4; ++c) dst[tid + 256 * c] = f2bf(y[r][c] * wgt); }
}
__global__ void k_final(const float* x1, const bf16* ybuf, const bf16* ysh, const float* mod, const float* fg, float* out) {
    int t = blockIdx.x, b = t / S, tid = threadIdx.x;
    __shared__ float red[256];
    float v[4]; float s = 0.f;
#pragma unroll
    for (int i = 0; i < 4; ++i) { int col = tid + 256 * i; float m = bf2f(ysh[(size_t)t * D + col]);
        for (int r = 0; r < 8; ++r) m += bf2f(ybuf[((size_t)t * 8 + r) * D + col]);
        v[i] = x1[(size_t)t * D + col] + mod[b * 6 * D + 5 * D + col] * m; s += v[i] * v[i]; }
    red[tid] = s; __syncthreads();
    for (int o = 128; o > 0; o >>= 1) { if (tid < o) red[tid] += red[tid + o]; __syncthreads(); }
    float rstd = rsqrtf(red[0] / D + EPS);
#pragma unroll
    for (int i = 0; i < 4; ++i) { int col = tid + 256 * i; out[(size_t)t * D + col] = v[i] * rstd * fg[col]; }
}

#define OPT_MASK 0xFF

#define LAS __attribute__((address_space(3)))
typedef short bf16x8 __attribute__((ext_vector_type(8)));
typedef float f32x16 __attribute__((ext_vector_type(16)));
typedef float f32x4 __attribute__((ext_vector_type(4)));
typedef unsigned u32x4 __attribute__((ext_vector_type(4)));
typedef unsigned u32x2 __attribute__((ext_vector_type(2)));

constexpr int NTHR = 512, NWAVE = 8;
constexpr int LDS_CTL_OFF = 147456;
constexpr int LDS_BYTES = LDS_CTL_OFF + 1024;
constexpr size_t C_BAR = 768 * 1024;

__device__ __forceinline__ unsigned cvt_pk(float lo, float hi) { unsigned r; asm("v_cvt_pk_bf16_f32 %0, %1, %2" : "=v"(r) : "v"(lo), "v"(hi)); return r; }
__device__ __forceinline__ float wave_sum(float v) {
#pragma unroll
    for (int o = 1; o < 64; o <<= 1) v += __shfl_xor(v, o);
    return v;
}
#define MFMA32(a, b, c) __builtin_amdgcn_mfma_f32_32x32x16_bf16((a), (b), (c), 0, 0, 0)

#define XB_TMO      128
#define XB_XCNT(j)  (256  + 64 * (j))
#define XB_XSUB(j)  (1280 + 64 * (j))
#define XB_XGEN(j)  (2304 + 64 * (j))
#define XB_TOP      3328
#define XB_TOPGEN   3392
#define XCD_BAR_WORDS 3456
#define XB_SPIN_CAP (1u << 22)
__device__ __forceinline__ unsigned xb_ld(unsigned* p)              { return __hip_atomic_load(p, __ATOMIC_RELAXED, __HIP_MEMORY_SCOPE_AGENT); }
__device__ __forceinline__ unsigned xb_add(unsigned* p, unsigned v) { return __hip_atomic_fetch_add(p, v, __ATOMIC_RELAXED, __HIP_MEMORY_SCOPE_AGENT); }
__device__ __forceinline__ unsigned xb_xcc_id() { return (unsigned)__builtin_amdgcn_s_getreg((3 << 11) | 20) & 0xFu; }
#define XB_SPIN(cond, bar) do { unsigned _sp = 0; while (cond) { __builtin_amdgcn_s_sleep(1); \
    if ((++_sp & 255u) == 0u) { if (xb_ld(&(bar)[XB_TMO])) break; if (_sp > XB_SPIN_CAP) { atomicAdd(&(bar)[XB_TMO], 1u); break; } } } } while (0)
struct XcdBarrier { unsigned* bar; unsigned x; volatile LAS unsigned* st; };
__device__ __forceinline__ XcdBarrier xcd_barrier_post(unsigned* bar, volatile LAS unsigned* st) {
    XcdBarrier b; b.bar = bar; b.x = xb_xcc_id(); b.st = st;
    if (threadIdx.x == 0) (void)xb_add(&bar[XB_XCNT(b.x)], 1u);
    return b;
}
__device__ __forceinline__ void xcd_barrier_complete(unsigned* bar, unsigned x, unsigned& nloc, unsigned& nx) {
    const unsigned G = gridDim.x * gridDim.y * gridDim.z;
    unsigned sum, cnt, mine, sp = 0u;
    for (;;) {
        sum = 0u; cnt = 0u; mine = 0u;
#pragma unroll
        for (unsigned j = 0; j < 16; ++j) { const unsigned c = xb_ld(&bar[XB_XCNT(j)]); sum += c; cnt += (c > 0u) ? 1u : 0u; mine = (j == x) ? c : mine; }
        if (sum == G) break;
        __builtin_amdgcn_s_sleep(1);
        if ((++sp & 255u) == 0u) { if (xb_ld(&bar[XB_TMO])) break; if (sp > XB_SPIN_CAP) { atomicAdd(&bar[XB_TMO], 1u); break; } }
    }
    nloc = mine > 0u ? mine : 1u; nx = cnt > 0u ? cnt : 1u;
}
__device__ __forceinline__ void xcd_barrier(const XcdBarrier& b) {
    asm volatile("s_waitcnt vmcnt(0)" ::: "memory");
    __syncthreads();
    if (threadIdx.x == 0) {
        unsigned* bar = b.bar;
        __builtin_amdgcn_s_waitcnt(0);
        unsigned nloc = b.st[0], nx = b.st[1];
        if (nloc == 0u) { xcd_barrier_complete(bar, b.x, nloc, nx); b.st[0] = nloc; b.st[1] = nx; }
        const unsigned old = xb_add(&bar[XB_XSUB(b.x)], 1u);
        const unsigned gen = old / nloc;
        if (old + 1u == (gen + 1u) * nloc) {
            __builtin_amdgcn_fence(__ATOMIC_RELEASE, "agent");
            asm volatile("s_waitcnt vmcnt(0)" ::: "memory");
            const unsigned og = xb_add(&bar[XB_TOP], 1u);
            const unsigned tg = og / nx;
            if (og + 1u == (tg + 1u) * nx) xb_add(&bar[XB_TOPGEN], 1u);
            else XB_SPIN(xb_ld(&bar[XB_TOPGEN]) == tg, bar);
            __builtin_amdgcn_fence(__ATOMIC_ACQUIRE, "agent");
            xb_add(&bar[XB_XGEN(b.x)], 1u);
            asm volatile("s_waitcnt vmcnt(0)" ::: "memory");
        } else {
            XB_SPIN(xb_ld(&bar[XB_XGEN(b.x)]) == gen, bar);
            __builtin_amdgcn_fence(__ATOMIC_ACQUIRE, "agent");
            asm volatile("s_waitcnt vmcnt(0)" ::: "memory");
        }
    }
    __syncthreads();
}

struct Args {
    const float *x, *c, *w_ada, *b_ada, *norm1_g, *w_in, *sinks, *rel_table, *out_norm_a, *out_norm_b, *w_out, *norm2_g, *w_router, *e_bias,
                *w1, *w3, *w2, *ws1, *ws3, *ws2, *final_g;
    float* out; unsigned char* ws; int ph_lo, ph_hi;
};

template <int RM, int RN, int WM, int WN, int KR, bool A_RES, bool SWAP, int PD = 2, int BMD = 0, int DBG = 0>
struct GemmCore {
    static constexpr bool BT = (BMD == 1), PUB = (BMD == 2), F8 = (BMD == 3);
    static constexpr int BM = 32 * RM * WM, BN = 32 * RN * WN;
    static constexpr int A_BYTES = BM * 64, B_BYTES = BN * 64, STAGE = (A_RES ? 0 : A_BYTES) + B_BYTES;
    static constexpr int NA = (BM * 4 + NTHR - 1) / NTHR;
    static constexpr int BTASKS = BT ? BN * 4 : F8 ? BN * 2 : (32 / KR) * (BN / 4), NBT = BTASKS / NTHR, NBR = (BT || F8) ? 1 : KR, F8TILE = BN * 32;
    static_assert(!PUB || KR == 8, "publishing needs 8 k-rows per task");
    static_assert(WM * WN == NWAVE && BTASKS % NTHR == 0 && (KR == 2 || KR == 4 || KR == 8), "GemmCore geometry");
    static constexpr int LDS_NEED = 2 * STAGE;

    template <class AF, class BF>
    static __device__ __forceinline__ void run(LAS unsigned char* lds, AF arow, BF bsrc, int ldb, int nk, f32x16 (&acc)[RM][RN], LAS unsigned char* ares, unsigned char* f8p = nullptr, float pscale = 1.f, int rot = 0) {
        run_h(lds, arow, bsrc, ldb, nk, acc, ares, [](int, f32x16 (&)[RM][RN]) {}, f8p, pscale, rot);
    }
    template <class AF, class BF, class HK>
    static __device__ __forceinline__ void run_h(LAS unsigned char* lds, AF arow, BF bsrc, int ldb, int nk, f32x16 (&acc)[RM][RN], LAS unsigned char* ares, HK hook, unsigned char* f8p = nullptr, float pscale = 1.f, int rot = 0) {
        int tid = threadIdx.x; asm volatile("" : "+v"(tid));
        const int lane = tid & 63, wave = __builtin_amdgcn_readfirstlane(tid >> 6);
        const int wm = wave / WN, wn = wave % WN, h = lane >> 5, l31 = lane & 31;
        const bf16* ap[NA]; int awo[NA]; bool aval[NA];
#pragma unroll
        for (int i = 0; i < NA; ++i) { const int p = tid + NTHR * i, row = (p >> 2) % BM, ch = p & 3; const bf16* rp = A_RES ? nullptr : arow(row);
            aval[i] = !A_RES && rp != nullptr && (NA * NTHR == BM * 4 || p < BM * 4); ap[i] = rp + ch * 8; awo[i] = row * 64 + ((ch ^ ((row >> 2) & 3)) << 4); }
        decltype(bsrc(0)) bp[NBT]; int bwo[NBT];
#pragma unroll
        for (int i = 0; i < NBT; ++i) { const int q = tid + NTHR * i;
            if constexpr (BT) { const int col = q >> 2, ch = q & 3; bp[i] = bsrc(col) + ch * 8; bwo[i] = col * 64 + ((ch ^ ((col >> 2) & 3)) << 4); }
            else if constexpr (F8) { bp[i] = nullptr; bwo[i] = 0; }
            else { const int cg = q % (BN / 4), kg = q / (BN / 4);
                bp[i] = bsrc(4 * cg) + (size_t)(KR * kg) * ldb;
                const int ch = (KR == 8) ? kg : (KR == 4) ? (kg >> 1) : (kg >> 2), hf = (KR == 8) ? 0 : (KR == 4) ? (kg & 1) * 8 : (kg & 3) * 4;
                bwo[i] = (4 * cg) * 64 + ((ch ^ (cg & 3)) << 4) + hf; } }
        const int swz = (l31 >> 2) & 3;
        const int xs0 = ((0 + h) ^ swz) << 4, xs1 = ((2 + h) ^ swz) << 4;
        const int aro = (wm * RM * 32 + l31) * 64, bro = (wn * RN * 32 + l31) * 64;
        constexpr int NSET = PD < 1 ? 1 : PD;
        u32x4 aregs[NSET][NA]; f32x4 bregs[NSET][NBT][NBR];
#pragma unroll
        for (int d = 0; d < NSET; ++d)
#pragma unroll
            for (int i = 0; i < NA; ++i) aregs[d][i] = (u32x4){0u, 0u, 0u, 0u};
        auto gload = [&](u32x4 (&areg)[NA], f32x4 (&breg)[NBT][NBR], int ks0) {
            const int ks = (ks0 + rot) & (nk - 1);
            if (!A_RES) {
#pragma unroll
                for (int i = 0; i < NA; ++i) if (aval[i]) areg[i] = *(const u32x4*)(ap[i] + (size_t)ks * 32);
            }
#pragma unroll
            for (int i = 0; i < NBT; ++i) {
                if (DBG & 8) continue;
                if constexpr (BT) breg[i][0] = *(const f32x4*)(bp[i] + (size_t)ks * 32);
                else if constexpr (F8) breg[i][0] = *(const f32x4*)(f8p + (size_t)ks * F8TILE + (size_t)(tid + NTHR * i) * 16);
                else {
#pragma unroll
                    for (int r = 0; r < KR; ++r) breg[i][r] = *(const f32x4*)(bp[i] + ((size_t)ks * 32 + r) * ldb); }
            }
        };
        constexpr int NSLOT = 2 * (RM <= RN ? RN : RM);
        constexpr int BITEMS = BT ? NBT : F8 ? NBT * 2 : NBT * 4, NITEM = (A_RES ? 0 : NA) + BITEMS;
        auto lwrite = [&](const u32x4 (&areg)[NA], const f32x4 (&breg)[NBT][NBR], int buf, int ks0, int slot) {
            const int ks = (ks0 + rot) & (nk - 1); (void)ks;
            LAS unsigned char* sb = lds + buf * STAGE;
            LAS unsigned char* bb = sb + (A_RES ? 0 : A_BYTES);
#pragma unroll
            for (int it = 0; it < NITEM; ++it) {
                if (slot >= 0 && (it % NSLOT) != slot) continue;
                if (!A_RES && it < NA) { const int i = it; if (NA * NTHR == BM * 4 || tid + NTHR * i < BM * 4) *(LAS u32x4*)(sb + awo[i]) = areg[i]; continue; }
                const int bi = it - (A_RES ? 0 : NA);
                if (DBG & 4) continue;
                if constexpr (BT) { *(LAS f32x4*)(bb + bwo[bi]) = breg[bi][0]; }
                else if constexpr (F8) {
                    const int i = bi >> 1, hf = bi & 1;
                    const int p = tid + NTHR * i, q = p >> 1, jp = p & 1, cg = q % (BN / 4), kg = q / (BN / 4), col = 4 * cg + 2 * jp + hf;
                    const u32x4 raw = __builtin_bit_cast(u32x4, breg[i][0]); unsigned o[4];
#pragma unroll
                    for (int d = 0; d < 2; ++d) { const auto lo = __builtin_amdgcn_cvt_pk_f32_fp8((int)raw[2 * hf + d], false), hi = __builtin_amdgcn_cvt_pk_f32_fp8((int)raw[2 * hf + d], true);
                        o[2 * d] = cvt_pk(lo[0], lo[1]); o[2 * d + 1] = cvt_pk(hi[0], hi[1]); }
                    *(LAS u32x4*)(bb + col * 64 + ((kg ^ (cg & 3)) << 4)) = (u32x4){o[0], o[1], o[2], o[3]};
                } else {
                    const int i = bi >> 2, j = bi & 3;
                    if (KR == 8) { u32x4 w; w.x = cvt_pk(breg[i][0][j], breg[i][1][j]); w.y = cvt_pk(breg[i][2][j], breg[i][3][j]); w.z = cvt_pk(breg[i][4][j], breg[i][5][j]); w.w = cvt_pk(breg[i][6][j], breg[i][7][j]);
                        *(LAS u32x4*)(bb + bwo[i] + j * 64) = w;
                        if constexpr (PUB) {
                            int p0 = __builtin_amdgcn_cvt_pk_fp8_f32(breg[i][0][j] * pscale, breg[i][1][j] * pscale, 0, false); p0 = __builtin_amdgcn_cvt_pk_fp8_f32(breg[i][2][j] * pscale, breg[i][3][j] * pscale, p0, true);
                            int p1 = __builtin_amdgcn_cvt_pk_fp8_f32(breg[i][4][j] * pscale, breg[i][5][j] * pscale, 0, false); p1 = __builtin_amdgcn_cvt_pk_fp8_f32(breg[i][6][j] * pscale, breg[i][7][j] * pscale, p1, true);
                            *(u32x2*)(f8p + (size_t)ks * F8TILE + (size_t)(tid + NTHR * i) * 32 + j * 8) = (u32x2){(unsigned)p0, (unsigned)p1}; } }
                    else if (KR == 4) { u32x2 w; w.x = cvt_pk(breg[i][0][j], breg[i][1][j]); w.y = cvt_pk(breg[i][2][j], breg[i][3][j]); *(LAS u32x2*)(bb + bwo[i] + j * 64) = w; }
                    else { *(LAS unsigned*)(bb + bwo[i] + j * 64) = cvt_pk(breg[i][0][j], breg[i][1][j]); }
                }
            }
        };
        auto step = [&](int ks0, int cur, const u32x4 (&aw)[NA], const f32x4 (&bw)[NBT][NBR], int wbuf, int wks, bool dowrite) {
            const int ks = (ks0 + rot) & (nk - 1);
            const LAS unsigned char* abase = A_RES ? (ares + ks * A_BYTES) : (lds + cur * STAGE);
            const LAS unsigned char* bbase = lds + cur * STAGE + (A_RES ? 0 : A_BYTES);
#pragma unroll
            for (int s = 0; s < 2; ++s) {
                const int xs = s ? xs1 : xs0;
                if constexpr (RM <= RN) {
                    bf16x8 af[RM];
                    if (!(DBG & 2)) {
#pragma unroll
                        for (int rb = 0; rb < RM; ++rb) af[rb] = *(const LAS bf16x8*)(abase + aro + rb * 2048 + xs); }
#pragma unroll
                    for (int cb = 0; cb < RN; ++cb) {
                        if (!(DBG & 2)) { const bf16x8 bfv = *(const LAS bf16x8*)(bbase + bro + cb * 2048 + xs);
#pragma unroll
                            for (int rb = 0; rb < RM; ++rb) { if (DBG & 1) { asm volatile("" :: "v"(bfv), "v"(af[rb])); } else acc[rb][cb] = SWAP ? MFMA32(bfv, af[rb], acc[rb][cb]) : MFMA32(af[rb], bfv, acc[rb][cb]); } }
                        if (dowrite) lwrite(aw, bw, wbuf, wks, s * RN + cb);
                    }
                } else {
                    bf16x8 bfv[RN];
                    if (!(DBG & 2)) {
#pragma unroll
                        for (int cb = 0; cb < RN; ++cb) bfv[cb] = *(const LAS bf16x8*)(bbase + bro + cb * 2048 + xs); }
#pragma unroll
                    for (int rb = 0; rb < RM; ++rb) {
                        if (!(DBG & 2)) { const bf16x8 af = *(const LAS bf16x8*)(abase + aro + rb * 2048 + xs);
#pragma unroll
                            for (int cb = 0; cb < RN; ++cb) acc[rb][cb] = SWAP ? MFMA32(bfv[cb], af, acc[rb][cb]) : MFMA32(af, bfv[cb], acc[rb][cb]); }
                        if (dowrite) lwrite(aw, bw, wbuf, wks, s * RM + rb);
                    }
                }
            }
        };
        if constexpr (PD >= 2) {
            static_assert(PD % 2 == 0, "PD even");
#pragma unroll
            for (int d = 0; d < PD; ++d) gload(aregs[d], bregs[d], d);
            lwrite(aregs[0], bregs[0], 0, 0, -1); __syncthreads();
#pragma unroll 1
            for (int ks0 = 0; ks0 < nk; ks0 += PD) {
#pragma unroll
                for (int d = 0; d < PD; ++d) {
                    const int ks = ks0 + d;
                    gload(aregs[d], bregs[d], min(ks + PD, nk - PD + d));
                    asm volatile("" ::: "memory");
                    if (d == 0) hook(ks, acc);
                    step(ks, d & 1, aregs[(d + 1) % PD], bregs[(d + 1) % PD], (d + 1) & 1, min(ks + 1, nk - 1), true);
                    __syncthreads();
                }
            }
            asm volatile("s_waitcnt vmcnt(0)" ::: "memory");
        } else {
            gload(aregs[0], bregs[0], 0); lwrite(aregs[0], bregs[0], 0, 0, -1); __syncthreads();
#pragma unroll 1
            for (int ks = 0; ks < nk; ++ks) {
                const int cur = ks & 1;
                if (ks + 1 < nk) gload(aregs[0], bregs[0], ks + 1);
                hook(ks, acc);
                step(ks, cur, aregs[0], bregs[0], 0, 0, false);
                if (ks + 1 < nk) lwrite(aregs[0], bregs[0], cur ^ 1, ks + 1, -1);
                __syncthreads();
            }
        }
    }
};
template <int RM, int RN> __device__ __forceinline__ void zero_acc(f32x16 (&acc)[RM][RN]) {
#pragma unroll
    for (int a = 0; a < RM; ++a)
#pragma unroll
        for (int b = 0; b < RN; ++b)
#pragma unroll
            for (int r = 0; r < 16; ++r) acc[a][b][r] = 0.f;
}
__device__ __forceinline__ int roff(int r, int h) { return (r & 3) + 8 * (r >> 2) + 4 * h; }

__device__ __forceinline__ void phase0(const Args& a, LAS unsigned char* lds, int vcu, int G) {
    const int tid = threadIdx.x, lane = tid & 63, wave = tid >> 6;
    float* mod = (float*)(a.ws + C_MOD); float* lut = (float*)(a.ws + WS_LUT);
    LAS float* sc = (LAS float*)lds;
    for (int i = tid; i < NB * D; i += NTHR) { float cv = a.c[i]; sc[i] = cv / (1.f + __expf(-cv)); }
    __syncthreads();
    LAS float* red = (LAS float*)(lds + 32768);
    for (int u = vcu; u < 192; u += G) {
        const int col = u * 32 + (lane & 31), rp = lane >> 5, k0 = wave * 128 + rp;
        float acc[NB];
#pragma unroll
        for (int b = 0; b < NB; ++b) acc[b] = 0.f;
#pragma unroll 16
        for (int i = 0; i < 64; ++i) { const float w = a.w_ada[(size_t)(k0 + 2 * i) * (6 * D) + col];
#pragma unroll
            for (int b = 0; b < NB; ++b) acc[b] += sc[b * D + k0 + 2 * i] * w; }
#pragma unroll
        for (int b = 0; b < NB; ++b) { acc[b] += __shfl_xor(acc[b], 32); if (rp == 0) red[(wave * NB + b) * 32 + lane] = acc[b]; }
        __syncthreads();
        if (tid < 256) { const int b = tid >> 5, c = tid & 31; float s = 0.f;
#pragma unroll
          for (int w = 0; w < NWAVE; ++w) s += red[(w * NB + b) * 32 + c];
          mod[b * 6 * D + u * 32 + c] = s + a.b_ada[u * 32 + c]; }
        __syncthreads();
    }
    {
        LAS float* scr = (LAS float*)(lds + 49152 + wave * 8448);
        constexpr int I_IN = 16 * (INC / 32), I_OUT = 16 * (D / 32), I_R = 16 * (NE / 32), I_S = 16 * (ED / 32), I_S2 = 4 * (D / 32), NIT = I_IN + I_OUT + I_R + 2 * I_S + I_S2;
        for (int it = vcu * NWAVE + wave; it < NIT; it += G * NWAVE) {
            const float* W; int N, KD = D, roff0 = 0; bf16* WT; int r = it;
            if (r < I_IN) { W = a.w_in; N = INC; WT = (bf16*)(a.ws + WS_WTIN); }
            else if ((r -= I_IN) < I_OUT) { W = a.w_out; N = D; WT = (bf16*)(a.ws + WS_WTOUT); }
            else if ((r -= I_OUT) < I_R) { W = a.w_router; N = NE; WT = (bf16*)(a.ws + WS_WTR); }
            else if ((r -= I_R) < I_S) { W = a.ws1; N = ED; WT = (bf16*)(a.ws + WS_WS13T); }
            else if ((r -= I_S) < I_S) { W = a.ws3; N = ED; WT = (bf16*)(a.ws + WS_WS13T); roff0 = ED; }
            else { r -= I_S; W = a.ws2; N = D; KD = ED; WT = (bf16*)(a.ws + WS_WS2T); }
            const int nblk = N / 32, kb = r / nblk, nb = r % nblk, k0 = 64 * kb, n0 = 32 * nb;
#pragma unroll 8
            for (int i = 0; i < 32; ++i) { const int kk = 2 * i + (lane >> 5); scr[kk * 33 + (lane & 31)] = W[(size_t)(k0 + kk) * N + n0 + (lane & 31)]; }
            asm volatile("s_waitcnt lgkmcnt(0)" ::: "memory");
            const int c = lane & 7;
#pragma unroll
            for (int j = 0; j < 4; ++j) { const int nn = (lane >> 3) + 8 * j; const LAS float* s = scr + (8 * c) * 33 + nn;
                u32x4 o; o.x = cvt_pk(s[0 * 33], s[1 * 33]); o.y = cvt_pk(s[2 * 33], s[3 * 33]); o.z = cvt_pk(s[4 * 33], s[5 * 33]); o.w = cvt_pk(s[6 * 33], s[7 * 33]);
                *(u32x4*)(WT + (size_t)(roff0 + n0 + nn) * KD + k0 + 8 * c) = o; }
            asm volatile("s_waitcnt lgkmcnt(0)" ::: "memory");
        }
    }
    for (int i = vcu * NTHR + tid; i < 16 * LUTN; i += G * NTHR) {
        const int hh = i / LUTN, p = i % LUTN, dist = p - LUT_NEG;
        float v = NEGBIG;
        const bool ok = dist >= 0 && (hh < 8 ? dist < 128 : dist < S);
        if (ok) v = a.rel_table[t5_bucket(dist) * 16 + hh] * LOG2E;
        lut[i] = v;
    }
}
__device__ __forceinline__ void norm_mod_row(const float* xr, const float* g, const float* sh, const float* scl, bf16* orow, int lane, unsigned char* o8 = nullptr) {
    f32x4 v[4]; float s = 0.f;
#pragma unroll
    for (int j = 0; j < 4; ++j) { v[j] = *(const f32x4*)(xr + j * 256 + lane * 4); s += (v[j].x * v[j].x + v[j].y * v[j].y) + (v[j].z * v[j].z + v[j].w * v[j].w); }
    const float rstd = rsqrtf(wave_sum(s) * (1.f / D) + EPS);
#pragma unroll
    for (int j = 0; j < 4; ++j) { const int c = j * 256 + lane * 4;
        const f32x4 gg = *(const f32x4*)(g + c), s1 = *(const f32x4*)(scl + c), s0 = *(const f32x4*)(sh + c);
        const float o0 = v[j].x * rstd * gg.x * (1.f + s1.x) + s0.x, o1 = v[j].y * rstd * gg.y * (1.f + s1.y) + s0.y;
        const float o2 = v[j].z * rstd * gg.z * (1.f + s1.z) + s0.z, o3 = v[j].w * rstd * gg.w * (1.f + s1.w) + s0.w;
        u32x2 w; w.x = cvt_pk(o0, o1); w.y = cvt_pk(o2, o3); *(u32x2*)(orow + c) = w;
        if (o8) { int p = __builtin_amdgcn_cvt_pk_fp8_f32(o0, o1, 0, false); p = __builtin_amdgcn_cvt_pk_fp8_f32(o2, o3, p, true); *(int*)(o8 + c) = p; } }
}
__device__ __forceinline__ void phase1(const Args& a, int vcu, int G) {
    const int lane = threadIdx.x & 63, gw = vcu * NWAVE + (threadIdx.x >> 6), NGW = G * NWAVE;
    const float* mod = (const float*)(a.ws + C_MOD); bf16* H = (bf16*)(a.ws + WS_H);
    for (int t = gw; t < NTOK; t += NGW) { const int b = t / S;
        norm_mod_row(a.x + (size_t)t * D, a.norm1_g, mod + b * 6 * D, mod + b * 6 * D + D, H + (size_t)t * D, lane); }
}
__device__ __forceinline__ void phase2(const Args& a, LAS unsigned char* lds, int vcu, int G) {
    typedef GemmCore<4, 2, 2, 4, 4, false, false, 2, 1> GC;
    const int lane = threadIdx.x & 63, wave = __builtin_amdgcn_readfirstlane(threadIdx.x >> 6), wm = wave / 4, wn = wave % 4, h = lane >> 5, l31 = lane & 31;
    const bf16* H = (const bf16*)(a.ws + WS_H); const bf16* WT = (const bf16*)(a.ws + WS_WTIN);
    bf16* QA = (bf16*)(a.ws + WS_QA); bf16* KA = (bf16*)(a.ws + WS_KA); bf16* VAT = (bf16*)(a.ws + WS_VAT);
    bf16* QB = (bf16*)(a.ws + WS_QB); bf16* KB = (bf16*)(a.ws + WS_KB); bf16* VBT = (bf16*)(a.ws + WS_VBT); float* ksum = (float*)(a.ws + C_KSUM);
    constexpr int NPM = NTOK / 256, NPN = INC / 256;
    for (int u = vcu; u < NPM * NPN; u += G) {
        const int pm = u / NPN, pn = u % NPN;
        f32x16 acc[4][2]; zero_acc(acc);
        const bf16* Ab = H + (size_t)pm * 256 * D; const bf16* Wb = WT + (size_t)pn * 256 * D;
        GC::run(lds, [&](int r) { return Ab + (size_t)r * D; }, [&](int c) { return Wb + (size_t)c * D; }, D, D / 32, acc, nullptr);
        const int b = (pm * 256) / S, s0 = (pm * 256) % S + wm * 128;
#pragma unroll
        for (int cb = 0; cb < 2; ++cb) {
            const int col = pn * 256 + wn * 64 + cb * 32 + l31;
            int kind, hh, d;
            bf16* base; int nh; bool isKB = false;
            if (col < 512)       { kind = 0; hh = col >> 6; d = col & 63; base = QA; nh = 8; }
            else if (col < 640)  { kind = 1; hh = (col - 512) >> 6; d = col & 63; base = KA; nh = 2; }
            else if (col < 768)  { kind = 2; hh = (col - 640) >> 6; d = col & 63; base = VAT; nh = 2; }
            else if (col < 1280) { kind = 0; hh = (col - 768) >> 6; d = col & 63; base = QB; nh = 8; }
            else if (col < 1792) { kind = 1; hh = (col - 1280) >> 6; d = col & 63; base = KB; nh = 8; isKB = true; }
            else                 { kind = 2; hh = (col - 1792) >> 6; d = col & 63; base = VBT; nh = 8; }
            if (kind == 2) {
                bf16* vp = base + ((size_t)(b * nh + hh) * 64 + d) * S + s0;
#pragma unroll
                for (int rb = 0; rb < 4; ++rb)
#pragma unroll
                    for (int g4 = 0; g4 < 4; ++g4) { u32x2 w; w.x = cvt_pk(acc[rb][cb][4 * g4], acc[rb][cb][4 * g4 + 1]); w.y = cvt_pk(acc[rb][cb][4 * g4 + 2], acc[rb][cb][4 * g4 + 3]);
                        *(u32x2*)(vp + rb * 32 + 8 * g4 + 4 * h) = w; }
            } else {
                const float sc = (kind == 0) ? QSCALE : 1.f;
                bf16* qp = base + ((size_t)(b * nh + hh) * S + s0) * 64 + d;
                float csum = 0.f;
#pragma unroll
                for (int rb = 0; rb < 4; ++rb)
#pragma unroll
                    for (int r = 0; r < 16; ++r) { const float v = acc[rb][cb][r]; csum += v; qp[(size_t)(rb * 32 + roff(r, h)) * 64] = f2bf(v * sc); }
                if (isKB) { csum += __shfl_xor(csum, 32); if (h == 0) atomicAdd(&ksum[((size_t)(b * 8 + hh) * 8 + (s0 >> 8)) * 64 + d], csum); }
            }
        }
    }
}
constexpr int KT_STRIDE = 144, VT_STRIDE = 528;
constexpr int AT_K_OFF = 0, AT_V_OFF = 256 * KT_STRIDE  , AT_LUT_OFF = AT_V_OFF + 64 * VT_STRIDE  , AT_KS_OFF = AT_LUT_OFF + 10240, AT_END = AT_KS_OFF + 2048;
struct AttnSt { f32x16 o0, o1; float m, l; };
__device__ __forceinline__ void attn_tile(const LAS unsigned char* lds, int kt, int lut_idx, const bf16x8 (&bq)[4], AttnSt& st, int lane) {
    const int i = lane & 31, hh = lane >> 5;
    const int kap = (i & 0x13) | ((i & 4) << 1) | ((i & 8) >> 1);
    const LAS unsigned char* kp = lds + AT_K_OFF + (kt * 32 + kap) * KT_STRIDE + 16 * hh;
    f32x16 p;
#pragma unroll
    for (int r = 0; r < 16; ++r) p[r] = 0.f;
#pragma unroll
    for (int s = 0; s < 4; ++s) { const bf16x8 kf = *(const LAS bf16x8*)(kp + 32 * s); p = MFMA32(kf, bq[s], p); }
    const LAS float* lp = (const LAS float*)(lds + AT_LUT_OFF) + lut_idx;
    float tmax = NEGBIG;
#pragma unroll
    for (int r = 0; r < 16; ++r) { p[r] += lp[23 - (16 * (r >> 3) + (r & 7))]; tmax = fmaxf(tmax, p[r]); }
    tmax = fmaxf(tmax, __shfl_xor(tmax, 32));
    const float mn = fmaxf(st.m, tmax), alpha = exp2f(st.m - mn);
    float ps = 0.f;
#pragma unroll
    for (int r = 0; r < 16; ++r) { p[r] = exp2f(p[r] - mn); ps += p[r]; }
    st.l = st.l * alpha + ps; st.m = mn;
#pragma unroll
    for (int r = 0; r < 16; ++r) { st.o0[r] *= alpha; st.o1[r] *= alpha; }
    bf16x8 pb[2];
#pragma unroll
    for (int s = 0; s < 2; ++s) { u32x4 w; w.x = cvt_pk(p[8 * s], p[8 * s + 1]); w.y = cvt_pk(p[8 * s + 2], p[8 * s + 3]); w.z = cvt_pk(p[8 * s + 4], p[8 * s + 5]); w.w = cvt_pk(p[8 * s + 6], p[8 * s + 7]);
        pb[s] = __builtin_bit_cast(bf16x8, w); }
    const LAS unsigned char* vp = lds + AT_V_OFF + i * VT_STRIDE + (kt * 32 + 8 * hh) * 2;
#pragma unroll
    for (int s = 0; s < 2; ++s) {
        const bf16x8 v0 = *(const LAS bf16x8*)(vp + 32 * s), v1 = *(const LAS bf16x8*)(vp + 32 * VT_STRIDE + 32 * s);
        st.o0 = MFMA32(v0, pb[s], st.o0); st.o1 = MFMA32(v1, pb[s], st.o1);
    }
}
__device__ __forceinline__ void attn_stage(LAS unsigned char* lds, const bf16* kg, const bf16* vtg, int tid) {
#pragma unroll
    for (int i = 0; i < 4; ++i) { const int p = tid + NTHR * i, key = p >> 3, c = p & 7;
        *(LAS u32x4*)(lds + AT_K_OFF + key * KT_STRIDE + c * 16) = *(const u32x4*)(kg + (size_t)key * 64 + c * 8); }
#pragma unroll
    for (int i = 0; i < 4; ++i) { const int p = tid + NTHR * i, d = p >> 5, c = p & 31;
        *(LAS u32x4*)(lds + AT_V_OFF + d * VT_STRIDE + c * 16) = *(const u32x4*)(vtg + (size_t)d * S + c * 8); }
}
__device__ __forceinline__ void attn_init(AttnSt& st) {
#pragma unroll
    for (int r = 0; r < 16; ++r) { st.o0[r] = 0.f; st.o1[r] = 0.f; }
    st.m = NEGBIG; st.l = 0.f;
}
__device__ __forceinline__ void attn_loadq(const bf16* qrow, bf16x8 (&bq)[4], int lane) {
    const int hh = lane >> 5;
#pragma unroll
    for (int s = 0; s < 4; ++s) bq[s] = *(const bf16x8*)(qrow + 16 * s + 8 * hh);
}
__device__ __forceinline__ void attn_finish(AttnSt& st, bool has_sink, float sink_l2, const float* gain, bf16* attrow, float* ssq_tok, int lane) {
    const int hh = lane >> 5;
    float l = st.l + __shfl_xor(st.l, 32), inv;
    if (has_sink) { const float mn = fmaxf(st.m, sink_l2), al = exp2f(st.m - mn); l = l * al + exp2f(sink_l2 - mn); inv = al / l; } else inv = 1.f / l;
    float sq = 0.f;
#pragma unroll
    for (int db = 0; db < 2; ++db)
#pragma unroll
        for (int g4 = 0; g4 < 4; ++g4) { const int d0 = db * 32 + 8 * g4 + 4 * hh; const f32x4 gg = *(const f32x4*)(gain + d0);
            const f32x16& o = db ? st.o1 : st.o0;
            const float v0 = o[4 * g4] * inv, v1 = o[4 * g4 + 1] * inv, v2 = o[4 * g4 + 2] * inv, v3 = o[4 * g4 + 3] * inv;
            sq += (v0 * v0 + v1 * v1) + (v2 * v2 + v3 * v3);
            u32x2 w; w.x = cvt_pk(v0 * gg.x, v1 * gg.y); w.y = cvt_pk(v2 * gg.z, v3 * gg.w); *(u32x2*)(attrow + d0) = w; }
    sq += __shfl_xor(sq, 32);
    if (hh == 0) *ssq_tok = sq;
}
__device__ __forceinline__ void phase3(const Args& a, LAS unsigned char* lds, int vcu, int G) {
    const int tid = threadIdx.x, lane = tid & 63, wave = __builtin_amdgcn_readfirstlane(tid >> 6), l31 = lane & 31, hh2 = lane >> 5;
    const bf16* QA = (const bf16*)(a.ws + WS_QA); const bf16* KA = (const bf16*)(a.ws + WS_KA); const bf16* VAT = (const bf16*)(a.ws + WS_VAT);
    const bf16* QB = (const bf16*)(a.ws + WS_QB); const bf16* KB = (const bf16*)(a.ws + WS_KB); const bf16* VBT = (const bf16*)(a.ws + WS_VBT);
    const float* ksum = (const float*)(a.ws + C_KSUM); const float* lut = (const float*)(a.ws + WS_LUT);
    bf16* ATT = (bf16*)(a.ws + WS_ATT); float* ssq = (float*)(a.ws + WS_SSQ);
    LAS float* lutl = (LAS float*)(lds + AT_LUT_OFF); LAS float* ksl = (LAS float*)(lds + AT_KS_OFF);
    for (int uu = vcu; uu < 256; uu += G) {
        const int bh = uu >> 2, b = bh >> 3, hd = bh & 7;
        for (int half = 0; half < 2; ++half) {
            const int qb = half ? (uu & 3) : 7 - (uu & 3);
            __syncthreads();
            for (int i = tid; i < LUTN; i += NTHR) lutl[i] = lut[(8 + hd) * LUTN + i];
            if (tid < 512) ksl[tid] = ksum[((size_t)bh * 8) * 64 + tid];
            const bf16* kbase = KB + (size_t)bh * S * 64; const bf16* vbase = VBT + (size_t)bh * 64 * S;
            attn_stage(lds, kbase + (size_t)qb * 256 * 64, vbase + qb * 256, tid);
            const int q0 = qb * 256 + wave * 32, qpos = q0 + l31;
            bf16x8 bq[4]; attn_loadq(QB + ((size_t)bh * S + qpos) * 64, bq, lane);
            __syncthreads();
            unsigned sel = 0;
            {
                float g[7];
#pragma unroll
                for (int j = 0; j < 7; ++j) { float s = 0.f;
#pragma unroll
                    for (int sI = 0; sI < 4; ++sI)
#pragma unroll
                        for (int e = 0; e < 8; ++e) s += bf2f((bf16)bq[sI][e]) * ksl[j * 64 + 16 * sI + 8 * hh2 + e];
                    s += __shfl_xor(s, 32); g[j] = (j < qb) ? s : -INFINITY; }
#pragma unroll
                for (int r = 0; r < 3; ++r) if (r < qb) { int best = 0; float bv = -INFINITY;
#pragma unroll
                    for (int j = 6; j >= 0; --j) if (j < qb && !((sel >> j) & 1u) && g[j] >= bv) { bv = g[j]; best = j; }
                    sel |= 1u << best; }
            }
            AttnSt st; attn_init(st);
            for (int kt = 0; kt <= wave; ++kt) attn_tile(lds, kt, LUT_NEG + qpos - (qb * 256 + kt * 32) - 8 * hh2 - 23, bq, st, lane);
            for (int j = 0; j < qb; ++j) {
                __syncthreads();
                attn_stage(lds, kbase + (size_t)j * 256 * 64, vbase + j * 256, tid);
                __syncthreads();
                const bool mine = (sel >> j) & 1u;
                if (__ballot(mine) != 0ull) {
                    for (int kt = 0; kt < 8; ++kt) { const int li = mine ? (LUT_NEG + qpos - (j * 256 + kt * 32) - 8 * hh2 - 23) : 64;
                        attn_tile(lds, kt, li, bq, st, lane); }
                }
            }
            const int t = b * S + qpos;
            attn_finish(st, false, 0.f, a.out_norm_b + hd * 64, ATT + (size_t)t * D + 512 + hd * 64, ssq + t * 16 + 8 + hd, lane);
        }
    }
    for (int u = vcu; u < 256; u += G) {
        const int b = u >> 5, kv = (u >> 4) & 1, n = u & 15;
        __syncthreads();
        for (int i = tid; i < 4 * 512; i += NTHR) { const int g = i >> 9, p = i & 511; lutl[i] = lut[(kv * 4 + g) * LUTN + p]; }
        const int kb0 = (n - 1) * 128, kld = kb0 < 0 ? 0 : kb0;
        attn_stage(lds, KA + ((size_t)(b * 2 + kv) * S + kld) * 64, VAT + (size_t)(b * 2 + kv) * 64 * S + kld, tid);
        __syncthreads();
        for (int ti = 0; ti < 2; ++ti) {
            const int tk = wave * 2 + ti, g = tk >> 2, jq = tk & 3, hd = kv * 4 + g;
            const int qpos = n * 128 + jq * 32 + l31, t = b * S + qpos;
            bf16x8 bq[4]; attn_loadq(QA + ((size_t)(b * 8 + hd) * S + qpos) * 64, bq, lane);
            AttnSt st; attn_init(st);
            if (n > 0) { for (int kt = jq + 4; kt >= jq; --kt) attn_tile(lds, kt, g * 512 + 256 + qpos - (kb0 + kt * 32) - 8 * hh2 - 23, bq, st, lane); }
            else { for (int kt = jq; kt >= 0; --kt) attn_tile(lds, kt, g * 512 + 256 + qpos - (kt * 32) - 8 * hh2 - 23, bq, st, lane); }
            attn_finish(st, true, a.sinks[hd] * LOG2E, a.out_norm_a + hd * 64, ATT + (size_t)t * D + hd * 64, ssq + t * 16 + hd, lane);
        }
    }
}
__device__ __forceinline__ void phase4(const Args& a, LAS unsigned char* lds, int vcu, int G) {
    typedef GemmCore<4, 2, 2, 4, 4, false, false, 2, 1> GC;
    const int tid = threadIdx.x, lane = tid & 63, wave = __builtin_amdgcn_readfirstlane(tid >> 6), wm = wave / 4, wn = wave % 4, h = lane >> 5, l31 = lane & 31;
    const bf16* ATT = (const bf16*)(a.ws + WS_ATT); const float* ssq = (const float*)(a.ws + WS_SSQ);
    const float* mod = (const float*)(a.ws + C_MOD); float* X1 = (float*)(a.ws + WS_X1);
    LAS float* rsc = (LAS float*)(lds + GC::LDS_NEED);
    for (int u = vcu; u < 64 * 4; u += G) {
        const int pm = u >> 2, pn = u & 3;
        __syncthreads();
        if (tid < 256) { const int t = pm * 256 + tid; const f32x4 q0 = *(const f32x4*)(ssq + t * 16), q1 = *(const f32x4*)(ssq + t * 16 + 4), q2 = *(const f32x4*)(ssq + t * 16 + 8), q3 = *(const f32x4*)(ssq + t * 16 + 12);
            const float sa = ((q0.x + q0.y) + (q0.z + q0.w)) + ((q1.x + q1.y) + (q1.z + q1.w)), sb = ((q2.x + q2.y) + (q2.z + q2.w)) + ((q3.x + q3.y) + (q3.z + q3.w));
            const float ra = rsqrtf(sa * (1.f / 512.f) + EPS), rb = rsqrtf(sb * (1.f / 512.f) + EPS); rsc[tid] = ra / rb; rsc[256 + tid] = rb; }
        f32x16 acc[4][2]; zero_acc(acc);
        const bf16* Ab = ATT + (size_t)pm * 256 * D; const bf16* Wb = (const bf16*)(a.ws + WS_WTOUT) + (size_t)pn * 256 * D;
        GC::run_h(lds, [&](int r) { return Ab + (size_t)r * D; }, [&](int c) { return Wb + (size_t)c * D; }, D, 32, acc, nullptr,
            [&](int ks, f32x16 (&ac)[4][2]) { if (ks == 16) {
#pragma unroll
                for (int rb = 0; rb < 4; ++rb)
#pragma unroll
                    for (int g4 = 0; g4 < 4; ++g4) { const f32x4 f = *(const LAS f32x4*)(rsc + wm * 128 + rb * 32 + 8 * g4 + 4 * h);
#pragma unroll
                        for (int e = 0; e < 4; ++e) { ac[rb][0][4 * g4 + e] *= f[e]; ac[rb][1][4 * g4 + e] *= f[e]; } } } });
        const int b = (pm * 256) / S;
#pragma unroll
        for (int cb = 0; cb < 2; ++cb) { const int col = pn * 256 + wn * 64 + cb * 32 + l31; const float g1 = mod[b * 6 * D + 2 * D + col];
#pragma unroll
            for (int rb = 0; rb < 4; ++rb)
#pragma unroll
                for (int g4 = 0; g4 < 4; ++g4) { const int lr = wm * 128 + rb * 32 + 8 * g4 + 4 * h;
                    size_t o4 = (size_t)(pm * 256 + lr) * D + col; asm volatile("" : "+v"(o4));
                    const f32x4 rv = *(const LAS f32x4*)(rsc + 256 + lr);
#pragma unroll
                    for (int e = 0; e < 4; ++e) X1[o4 + (size_t)e * D] = a.x[o4 + (size_t)e * D] + g1 * acc[rb][cb][4 * g4 + e] * rv[e]; } }
    }
}
__device__ __forceinline__ void phase5(const Args& a, LAS unsigned char* lds, int vcu, int G, bool dry = false) {
    typedef GemmCore<2, 1, 1, 8, 4, false, false, 4, 1> GC;
    const int tid = threadIdx.x, lane = tid & 63, wave = __builtin_amdgcn_readfirstlane(tid >> 6), h = lane >> 5, l31 = lane & 31;
    const float* X1 = (const float*)(a.ws + WS_X1); const float* mod = (const float*)(a.ws + C_MOD); bf16* H2 = (bf16*)(a.ws + WS_H2);
    int* cnt = (int*)(a.ws + C_CNT); int* list = (int*)(a.ws + WS_LIST); float* ew = (float*)(a.ws + WS_EW);
    LAS float* lg = (LAS float*)(lds + 65536);
    for (int u = vcu; u < NTOK / 64; u += G) {
        const int t0 = u * 64, b = t0 / S;
        for (int i = 0; i < 8; ++i) { const int t = t0 + wave * 8 + i;
            norm_mod_row(X1 + (size_t)t * D, a.norm2_g, mod + b * 6 * D + 3 * D, mod + b * 6 * D + 4 * D, H2 + (size_t)t * D, lane, a.ws + WS_X8 + (size_t)t * D); }
        asm volatile("s_waitcnt vmcnt(0)" ::: "memory");
        __syncthreads();
        f32x16 acc[2][1]; zero_acc(acc);
        const bf16* Ab = H2 + (size_t)t0 * D;
        const bf16* WR = (const bf16*)(a.ws + WS_WTR);
        GC::run(lds, [&](int r) { return Ab + (size_t)r * D; }, [&](int c) { return WR + (size_t)c * D; }, D, D / 32, acc, nullptr);
#pragma unroll
        for (int rb = 0; rb < 2; ++rb)
#pragma unroll
            for (int r = 0; r < 16; ++r) lg[(rb * 32 + roff(r, h)) * 256 + wave * 32 + l31] = acc[rb][0][r];
        __syncthreads();
        for (int i = 0; i < 8; ++i) {
            const int row = wave * 8 + i, t = t0 + row;
            const f32x4 lv = *(const LAS f32x4*)(lg + row * 256 + lane * 4); const f32x4 eb = *(const f32x4*)(a.e_bias + lane * 4);
            float sc[4], sl[4];
#pragma unroll
            for (int j = 0; j < 4; ++j) { sc[j] = 1.f / (1.f + __expf(-lv[j])); sl[j] = sc[j] + eb[j]; }
            float m1 = fmaxf(sl[0], sl[1]), m2 = fminf(sl[0], sl[1]);
            { const float c1 = fmaxf(sl[2], sl[3]), c2 = fminf(sl[2], sl[3]); const float n1 = fmaxf(m1, c1), n2 = fmaxf(fminf(m1, c1), fmaxf(m2, c2)); m1 = n1; m2 = n2; }
#pragma unroll
            for (int o = 1; o < 8; o <<= 1) { const float c1 = __shfl_xor(m1, o), c2 = __shfl_xor(m2, o); const float n1 = fmaxf(m1, c1), n2 = fmaxf(fminf(m1, c1), fmaxf(m2, c2)); m1 = n1; m2 = n2; }
            const float gs = m1 + m2; const int grp = lane >> 3;
            int rank = 0;
#pragma unroll
            for (int g2 = 0; g2 < 8; ++g2) { const float og = __shfl(gs, g2 * 8); rank += (og > gs || (og == gs && g2 < grp)) ? 1 : 0; }
            const bool gsel = rank < 4;
#pragma unroll
            for (int j = 0; j < 4; ++j) if (!gsel) sl[j] = -INFINITY;
            int myidx = 0; float mysc = 0.f, wsum = 0.f;
            for (int r = 0; r < TOPK; ++r) {
                float bv = sl[0]; int bi = 0;
#pragma unroll
                for (int j = 1; j < 4; ++j) if (sl[j] > bv) { bv = sl[j]; bi = j; }
                bi += lane * 4;
#pragma unroll
                for (int o = 1; o < 64; o <<= 1) { const float ov = __shfl_xor(bv, o); const int oi = __shfl_xor(bi, o); if (ov > bv || (ov == bv && oi < bi)) { bv = ov; bi = oi; } }
                const int j = bi & 3; const bool own = (bi >> 2) == lane;
                const float scj = (j == 0) ? sc[0] : (j == 1) ? sc[1] : (j == 2) ? sc[2] : sc[3];
                const float scw = __shfl(scj, bi >> 2);
                if (own) { if (j == 0) sl[0] = -INFINITY; else if (j == 1) sl[1] = -INFINITY; else if (j == 2) sl[2] = -INFINITY; else sl[3] = -INFINITY; }
                wsum += scw;
                if (lane == r) { myidx = bi; mysc = scw; }
            }
            if (lane < TOPK && !dry) { const int slot = atomicAdd(&cnt[myidx], 1); list[(size_t)myidx * NTOK + slot] = t * 8 + lane; ew[t * 8 + lane] = mysc / wsum * 2.5f; }
        }
        __syncthreads();
    }
}
constexpr int MOE_H_OFF = 81920;
__device__ __forceinline__ void phase6_old(const Args& a, LAS unsigned char* lds, int vcu, int G, const XcdBarrier rbar, const bool use_rbar) {
    typedef GemmCore<2, 4, 2, 4, 8, false, true, 2> G1;
    typedef GemmCore<2, 4, 2, 4, 8, true, true, 2> G2;
    static_assert(G1::LDS_NEED <= MOE_H_OFF && MOE_H_OFF + 8 * 8192 <= LDS_CTL_OFF, "MoE LDS map");
    const int tid = threadIdx.x, lane = tid & 63, wave = __builtin_amdgcn_readfirstlane(tid >> 6), wm = wave / 4, wn = wave % 4, h = lane >> 5, l31 = lane & 31;
    const bf16* H2 = (const bf16*)(a.ws + WS_H2); const int* cnt = (const int*)(a.ws + C_CNT); const int* list = (const int*)(a.ws + WS_LIST); const float* ew = (const float*)(a.ws + WS_EW);
    bf16* YBUF = (bf16*)(a.ws + WS_YBUF); bf16* YSH = (bf16*)(a.ws + WS_YSH);
    LAS int* pf = (LAS int*)(lds + 0);
    __syncthreads();
    if (tid < NE) pf[tid + 1] = (cnt[tid] + 127) >> 7;
    if (tid == 0) pf[0] = 0;
    __syncthreads();
    if (tid == 0) { int s = 0; for (int e = 0; e < NE; ++e) { s += pf[e + 1]; pf[e + 1] = s; } }
    __syncthreads();
    const int R = pf[NE];
    const int NSH = NTOK / 128;
    LAS int* myu = (LAS int*)(lds + LDS_CTL_OFF + 256);
    const int total = NSH + R;
    int nmy = 0;
    for (int u = vcu; u < total; u += G) ++nmy;
    if (nmy > 16) nmy = 16;
    if (tid < nmy) { const int u = vcu + tid * G; int e, ci;
        if (u < NSH) { e = NE; ci = u; }
        else { const int ru = u - NSH; int lo = 0, hi = NE - 1; while (lo < hi) { const int mid = (lo + hi) >> 1; if (pf[mid + 1] > ru) hi = mid; else lo = mid + 1; } e = lo; ci = ru - pf[lo]; }
        myu[tid] = e; myu[16 + tid] = ci; }
    __syncthreads();
    LAS int* rowa = (LAS int*)(lds + LDS_CTL_OFF + 384);
    const int nrounds = (total + G - 1) / G;
    for (int iu = 0; iu < nrounds; ++iu) {
        if (use_rbar && iu > 0) xcd_barrier(rbar);
        if (iu >= nmy) continue;
        const int e = myu[iu], ci = myu[16 + iu];
        const int n = (e < NE) ? min(128, cnt[e] - ci * 128) : 128;
        const float* W1 = (e < NE) ? a.w1 + (size_t)e * D * ED : a.ws1; const float* W3 = (e < NE) ? a.w3 + (size_t)e * D * ED : a.ws3; const float* W2 = (e < NE) ? a.w2 + (size_t)e * ED * D : a.ws2;
        __syncthreads();
        if (tid < 128) rowa[tid] = (tid < n) ? ((e < NE) ? list[(size_t)e * NTOK + ci * 128 + tid] : ci * 128 + tid) : -1;
        __syncthreads();
        f32x16 acc[2][4]; zero_acc(acc);
        G1::run(lds, [&](int r) { const int aid = rowa[r]; const int tok = (e < NE) ? (aid >> 3) : aid; return (aid < 0) ? (const bf16*)nullptr : (H2 + (size_t)tok * D); },
                [&](int c) { const int w4 = c >> 7, within = c & 127; return (within < 64) ? (W1 + 64 * w4 + within) : (W3 + 64 * w4 + within - 64); }, ED, D / 32, acc, nullptr);
        {
#pragma unroll
            for (int rb = 0; rb < 2; ++rb) { const int row = wm * 64 + rb * 32 + l31;
#pragma unroll
                for (int cb = 0; cb < 2; ++cb)
#pragma unroll
                    for (int g4 = 0; g4 < 4; ++g4) { float hv[4];
#pragma unroll
                        for (int e4 = 0; e4 < 4; ++e4) { const float gt = acc[rb][cb][4 * g4 + e4], up = acc[rb][cb + 2][4 * g4 + e4]; hv[e4] = gt / (1.f + __expf(-gt)) * up; }
                        u32x2 w; w.x = cvt_pk(hv[0], hv[1]); w.y = cvt_pk(hv[2], hv[3]);
                        const int ks2 = 2 * wn + cb;
                        *(LAS u32x2*)(lds + MOE_H_OFF + ks2 * 8192 + row * 64 + ((g4 ^ ((row >> 2) & 3)) << 4) + 8 * h) = w; } }
        }
        __syncthreads();
        const int aid0 = rowa[wm * 64 + l31], aid1 = rowa[wm * 64 + 32 + l31];
        for (int nh = 0; nh < 2; ++nh) {
            zero_acc(acc);
            G2::run(lds, [&](int) { return (const bf16*)nullptr; }, [&](int c) { return W2 + nh * 512 + c; }, D, ED / 32, acc, lds + MOE_H_OFF);
#pragma unroll
            for (int rb = 0; rb < 2; ++rb) { const int aid = rb ? aid1 : aid0; if (aid < 0) continue;
                const float wgt = (e < NE) ? ew[aid] : 1.f; bf16* dst = ((e < NE) ? YBUF : YSH) + (size_t)aid * D + nh * 512 + wn * 128;
#pragma unroll
                for (int cb = 0; cb < 4; ++cb)
#pragma unroll
                    for (int g4 = 0; g4 < 4; ++g4) { u32x2 w; w.x = cvt_pk(acc[rb][cb][4 * g4] * wgt, acc[rb][cb][4 * g4 + 1] * wgt); w.y = cvt_pk(acc[rb][cb][4 * g4 + 2] * wgt, acc[rb][cb][4 * g4 + 3] * wgt);
                        *(u32x2*)(dst + cb * 32 + 8 * g4 + 4 * h) = w; } }
        }
    }
}
constexpr int MOE_TOK_OFF = 32768, MOE_AID_OFF = MOE_TOK_OFF + 4096, MOE_W_OFF = MOE_AID_OFF + 4096;
template <int NRB, int NCB>
__device__ __forceinline__ void moe_unit(LAS unsigned char* lds, const bf16* H2, const float* W1, const float* W3, const float* W2, bf16* hb, bf16* ybase, const int nrb) {
    constexpr int COLS = NCB * 32, HU = COLS / 2, TASKS = 4 * (COLS / 4), NG = NTHR / TASKS;
    constexpr int P1 = 256 / HU, T1 = P1 * 32, P2 = 1024 / COLS, T2 = P2 * 8, T = T1 + T2, SLOT = COLS * 64;
    static_assert(NG >= 2 && (NG & (NG - 1)) == 0 && T1 % 2 == 0, "moe_unit geometry");
    const int tid = threadIdx.x, lane = tid & 63, wave = __builtin_amdgcn_readfirstlane(tid >> 6), h = lane >> 5, l31 = lane & 31;
    const int grp = __builtin_amdgcn_readfirstlane(tid / TASKS), q = tid % TASKS, cg = q % (COLS / 4), kg = q / (COLS / 4), c0 = 4 * cg;
    const LAS int* r_tok = (const LAS int*)(lds + MOE_TOK_OFF); const LAS int* r_aid = (const LAS int*)(lds + MOE_AID_OFF); const LAS float* r_w = (const LAS float*)(lds + MOE_W_OFF);
    int xoff[NRB];
#pragma unroll
    for (int rb = 0; rb < NRB; ++rb) { const int row = (rb * 8 + wave) * 32 + l31; xoff[rb] = r_tok[row] * D + 16 * h; }
    const int hoff0 = (wave * 32 + l31) * ED;
    f32x16 acc[NRB][NCB]; zero_acc(acc);
    f32x4 wreg[8];
    bf16x8 xa[NRB][2], xb[NRB][2];
    const int wwo = c0 * 64 + ((kg ^ (cg & 3)) << 4);
    const int swz = (l31 >> 2) & 3, rs0 = l31 * 64 + (((2 * h) ^ swz) << 4), rs1 = l31 * 64 + (((2 * h + 1) ^ swz) << 4);
    auto issue_w = [&](int tt) {
        const float* p; int ld;
        if (tt < T1) { const int ps = tt >> 5, ks = tt & 31; ld = ED; p = ((c0 < HU) ? (W1 + ps * HU + c0) : (W3 + ps * HU + (c0 - HU))) + (size_t)(32 * ks + 8 * kg) * ED; }
        else { const int t2 = tt - T1, qs = t2 >> 3, ks = t2 & 7; ld = D; p = W2 + qs * COLS + c0 + (size_t)(32 * ks + 8 * kg) * D; }
#pragma unroll
        for (int i = 0; i < 8; ++i) wreg[i] = *(const f32x4*)(p + (size_t)i * ld);
    };
    auto write_w = [&](int tt) {
        LAS unsigned char* sb = lds + (tt & 1) * SLOT + wwo;
#pragma unroll
        for (int j = 0; j < 4; ++j) { u32x4 w; w.x = cvt_pk(wreg[0][j], wreg[1][j]); w.y = cvt_pk(wreg[2][j], wreg[3][j]); w.z = cvt_pk(wreg[4][j], wreg[5][j]); w.w = cvt_pk(wreg[6][j], wreg[7][j]);
            *(LAS u32x4*)(sb + j * 64) = w; }
    };
    auto load_x = [&](bf16x8 (&x)[NRB][2], int tt) {
#pragma unroll
        for (int rb = 0; rb < NRB; ++rb) if (rb < nrb) {
            const bf16* p = (tt < T1) ? (H2 + xoff[rb] + 32 * (tt & 31)) : (hb + hoff0 + rb * (256 * ED) + 16 * h + 32 * ((tt - T1) & 7));
            x[rb][0] = *(const bf16x8*)p; x[rb][1] = *(const bf16x8*)(p + 8); }
    };
    auto compute = [&](const bf16x8 (&x)[NRB][2], int tt) {
        const LAS unsigned char* base = lds + (tt & 1) * SLOT;
#pragma unroll
        for (int s = 0; s < 2; ++s) {
#pragma unroll
            for (int cb = 0; cb < NCB; ++cb) { const bf16x8 wf = *(const LAS bf16x8*)(base + cb * 2048 + (s ? rs1 : rs0));
#pragma unroll
                for (int rb = 0; rb < NRB; ++rb) if (rb < nrb) acc[rb][cb] = MFMA32(wf, x[rb][s], acc[rb][cb]); }
        }
    };
    auto epi1 = [&](int ps) {
#pragma unroll
        for (int rb = 0; rb < NRB; ++rb) if (rb < nrb) {
#pragma unroll
            for (int cb = 0; cb < NCB / 2; ++cb)
#pragma unroll
                for (int g4 = 0; g4 < 4; ++g4) { float hv[4];
#pragma unroll
                    for (int e4 = 0; e4 < 4; ++e4) { const float gt = acc[rb][cb][4 * g4 + e4], up = acc[rb][cb + NCB / 2][4 * g4 + e4]; hv[e4] = gt / (1.f + __expf(-gt)) * up; }
                    u32x2 w; w.x = cvt_pk(hv[0], hv[1]); w.y = cvt_pk(hv[2], hv[3]);
                    *(u32x2*)(hb + hoff0 + rb * (256 * ED) + ps * HU + cb * 32 + 8 * g4 + 4 * h) = w; } }
    };
    auto epi2 = [&](int qs) {
#pragma unroll
        for (int rb = 0; rb < NRB; ++rb) if (rb < nrb) { const int row = (rb * 8 + wave) * 32 + l31; const int aid = r_aid[row]; if (aid < 0) continue;
            bf16* dst = ybase + (size_t)aid * D + qs * COLS + 4 * h; const float wg = r_w[row];
#pragma unroll
            for (int cb = 0; cb < NCB; ++cb)
#pragma unroll
                for (int g4 = 0; g4 < 4; ++g4) { u32x2 w; w.x = cvt_pk(acc[rb][cb][4 * g4] * wg, acc[rb][cb][4 * g4 + 1] * wg); w.y = cvt_pk(acc[rb][cb][4 * g4 + 2] * wg, acc[rb][cb][4 * g4 + 3] * wg);
                    *(u32x2*)(dst + cb * 32 + 8 * g4) = w; } }
    };
    issue_w(grp);
    load_x(xa, 0);
    if (grp == 0) write_w(0);
    __syncthreads();
    int t = 0;
    auto two_steps = [&](bool last_of_stage1) {
        if ((t & (NG - 1)) == grp && t + NG < T) issue_w(t + NG);
        load_x(xb, t + 1);
        compute(xa, t);
        if (((t + 1) & (NG - 1)) == grp) write_w(t + 1);
        __syncthreads();
        const int t1 = t + 1;
        if ((t1 & (NG - 1)) == grp && t1 + NG < T) issue_w(t1 + NG);
        if (t1 + 1 < T && !last_of_stage1) load_x(xa, t1 + 1);
        compute(xb, t1);
        if (((t1 + 1) & (NG - 1)) == grp && t1 + 1 < T) write_w(t1 + 1);
        __syncthreads();
        t += 2;
    };
#pragma unroll 1
    for (int ps = 0; ps < P1; ++ps) {
#pragma unroll 1
        for (int k2 = 0; k2 < 16; ++k2) two_steps(ps == P1 - 1 && k2 == 15);
        epi1(ps); zero_acc(acc);
    }
    asm volatile("s_waitcnt vmcnt(0)" ::: "memory");
    load_x(xa, T1);
#pragma unroll 1
    for (int qs = 0; qs < P2; ++qs) {
#pragma unroll 1
        for (int k2 = 0; k2 < 4; ++k2) two_steps(false);
        epi2(qs); zero_acc(acc);
    }
}
__device__ __forceinline__ void phase6_v2(const Args& a, LAS unsigned char* lds, int vcu, int G) {
    const int tid = threadIdx.x;
    const bf16* H2 = (const bf16*)(a.ws + WS_H2); const int* cnt = (const int*)(a.ws + C_CNT); const int* list = (const int*)(a.ws + WS_LIST); const float* ew = (const float*)(a.ws + WS_EW);
    bf16* YBUF = (bf16*)(a.ws + WS_YBUF); bf16* YSH = (bf16*)(a.ws + WS_YSH); int* qhead = (int*)(a.ws + C_QHEAD);
    bf16* hb = (bf16*)(a.ws + WS_HB) + (size_t)(vcu & 255) * 768 * ED;
    LAS int* r_tok = (LAS int*)(lds + MOE_TOK_OFF); LAS int* r_aid = (LAS int*)(lds + MOE_AID_OFF); LAS float* r_w = (LAS float*)(lds + MOE_W_OFF);
    volatile LAS int* qslot = (volatile LAS int*)(lds + LDS_CTL_OFF + 256);
    int e = vcu;
    bool routed = e < NE;
    for (;;) {
        int n, r0 = 0, sh_c = 0;
        if (routed) n = cnt[e];
        else { __syncthreads(); if (tid == 0) *qslot = atomicAdd(qhead, 1); __syncthreads(); sh_c = *qslot; if (sh_c >= NTOK / 256) break; n = 256; }
        const float* W1 = routed ? a.w1 + (size_t)e * D * ED : a.ws1; const float* W3 = routed ? a.w3 + (size_t)e * D * ED : a.ws3; const float* W2 = routed ? a.w2 + (size_t)e * ED * D : a.ws2;
        for (; r0 < n; r0 += 768) {
            const int ns = min(768, n - r0);
            __syncthreads();
            for (int i = tid; i < 768; i += NTHR) { int tok = 0, aid = -1; float w = 0.f;
                if (i < ns) { if (routed) { aid = list[(size_t)e * NTOK + r0 + i]; tok = aid >> 3; w = ew[aid]; } else { tok = sh_c * 256 + i; aid = tok; w = 1.f; } }
                r_tok[i] = tok; r_aid[i] = aid; r_w[i] = w; }
            if (tid == 0) { __builtin_amdgcn_fence(__ATOMIC_ACQUIRE, "agent"); asm volatile("s_waitcnt vmcnt(0)" ::: "memory"); }
            __syncthreads();
            if (ns > 512) moe_unit<3, 2>(lds, H2, W1, W3, W2, hb, routed ? YBUF : YSH, 3);
            else moe_unit<2, 4>(lds, H2, W1, W3, W2, hb, routed ? YBUF : YSH, ns > 256 ? 2 : 1);
        }
        if (routed) { e += G; routed = e < NE; }
    }
}
constexpr int M3_TAB = 81920;
constexpr int M3_ROWS = 1536;
template <int PF>
__device__ __forceinline__ void phase6(const Args& a, LAS unsigned char* lds, int vcu, int G) {
    const int tid = threadIdx.x, lane = tid & 63, wave = __builtin_amdgcn_readfirstlane(tid >> 6), h = lane >> 5, l31 = lane & 31;
    const bf16* H2 = (const bf16*)(a.ws + WS_H2); const int* cnt = (const int*)(a.ws + C_CNT); const int* list = (const int*)(a.ws + WS_LIST); const float* ew = (const float*)(a.ws + WS_EW);
    bf16* YBUF = (bf16*)(a.ws + WS_YBUF); bf16* YSH = (bf16*)(a.ws + WS_YSH);
    {
        typedef GemmCore<2, 2, 1, 8, 4, false, true, 2, 1> S1;
        typedef GemmCore<2, 2, 1, 8, 4, true, true, 2, 1> S2;
        constexpr int HOFF = S1::LDS_NEED;
        static_assert(HOFF + 8 * 4096 <= LDS_CTL_OFF, "shared-expert LDS map");
        const bf16* W13 = (const bf16*)(a.ws + WS_WS13T); const bf16* W2T = (const bf16*)(a.ws + WS_WS2T);
        if (!(PF & 1)) for (int su = vcu; su < NTOK / 64; su += G) {
            const int t0 = su * 64;
            f32x16 acc[2][2]; zero_acc(acc);
            __syncthreads();
            S1::run(lds, [&](int r) { return H2 + (size_t)(t0 + r) * D; },
                    [&](int c) { const int w8 = c >> 6, within = c & 63; return W13 + (size_t)((within < 32) ? (32 * w8 + within) : (ED + 32 * w8 + within - 32)) * D; }, D, D / 32, acc, nullptr);
#pragma unroll
            for (int rb = 0; rb < 2; ++rb) { const int row = rb * 32 + l31;
#pragma unroll
                for (int g4 = 0; g4 < 4; ++g4) { float hv[4];
#pragma unroll
                    for (int e4 = 0; e4 < 4; ++e4) { const float gt = acc[rb][0][4 * g4 + e4], up = acc[rb][1][4 * g4 + e4]; hv[e4] = gt / (1.f + __expf(-gt)) * up; }
                    u32x2 w; w.x = cvt_pk(hv[0], hv[1]); w.y = cvt_pk(hv[2], hv[3]);
                    *(LAS u32x2*)(lds + HOFF + wave * 4096 + row * 64 + ((g4 ^ ((row >> 2) & 3)) << 4) + 8 * h) = w; } }
            __syncthreads();
            for (int nh = 0; nh < 2; ++nh) {
                zero_acc(acc);
                S2::run(lds, [&](int) { return (const bf16*)nullptr; }, [&](int c) { return W2T + (size_t)(nh * 512 + c) * ED; }, ED, ED / 32, acc, lds + HOFF);
#pragma unroll
                for (int rb = 0; rb < 2; ++rb) { bf16* dst = YSH + (size_t)(t0 + rb * 32 + l31) * D + nh * 512 + wave * 64 + 4 * h;
#pragma unroll
                    for (int cb = 0; cb < 2; ++cb)
#pragma unroll
                        for (int g4 = 0; g4 < 4; ++g4) { u32x2 w; w.x = cvt_pk(acc[rb][cb][4 * g4], acc[rb][cb][4 * g4 + 1]); w.y = cvt_pk(acc[rb][cb][4 * g4 + 2], acc[rb][cb][4 * g4 + 3]);
                            *(u32x2*)(dst + cb * 32 + 8 * g4) = w; } }
            }
        }
    }
    typedef GemmCore<2, 4, 8, 1, 2, false, true, 2, 0> GE;
    static_assert(GE::LDS_NEED <= M3_TAB && M3_TAB + 3 * M3_ROWS * 4 <= LDS_CTL_OFF, "expert LDS map");
    LAS int* r_tok = (LAS int*)(lds + M3_TAB); LAS int* r_aid = r_tok + M3_ROWS; LAS float* r_w = (LAS float*)(r_aid + M3_ROWS);
    bf16* hb = (bf16*)(a.ws + WS_HB) + (size_t)(vcu & 255) * M3_ROWS * ED;
    for (int e = vcu; e < NE; e += G) {
        const int n = cnt[e];
        const float* W1 = a.w1 + (size_t)e * D * ED; const float* W3 = a.w3 + (size_t)e * D * ED; const float* W2 = a.w2 + (size_t)e * ED * D;
        for (int sg0 = 0; sg0 < n; sg0 += M3_ROWS) {
            const int ns = (PF & 16) ? min(512, n - sg0) : min(M3_ROWS, n - sg0), nrg = (ns + 511) >> 9;
            __syncthreads();
            for (int i = tid; i < nrg * 512; i += NTHR) { int tok = 0, aid = -1; float w = 0.f;
                if (i < ns) { aid = list[(size_t)e * NTOK + sg0 + i]; tok = (PF & 8) ? ((e * 64 + i) & (NTOK - 1)) : (aid >> 3); w = ew[aid]; }
                r_tok[i] = tok; r_aid[i] = aid; r_w[i] = w; }
            __syncthreads();
            if (!(PF & 4)) for (int p = 0; p < 4; ++p)
                for (int rg = 0; rg < nrg; ++rg) {
                    f32x16 acc[2][4]; zero_acc(acc);
                    GE::run(lds, [&](int r) { return (r_aid[rg * 512 + r] < 0) ? (const bf16*)nullptr : (H2 + (size_t)r_tok[rg * 512 + r] * D); },
                            [&](int c) { return (c < 64) ? (W1 + 64 * p + c) : (W3 + 64 * p + c - 64); }, ED, D / 32, acc, nullptr);
#pragma unroll
                    for (int rb = 0; rb < 2; ++rb) { bf16* hrow = hb + (size_t)(rg * 512 + wave * 64 + rb * 32 + l31) * ED + 64 * p + 4 * h;
#pragma unroll
                        for (int cb = 0; cb < 2; ++cb)
#pragma unroll
                            for (int g4 = 0; g4 < 4; ++g4) { float hv[4];
#pragma unroll
                                for (int e4 = 0; e4 < 4; ++e4) { const float gt = acc[rb][cb][4 * g4 + e4], up = acc[rb][cb + 2][4 * g4 + e4]; hv[e4] = gt / (1.f + __expf(-gt)) * up; }
                                u32x2 w; w.x = cvt_pk(hv[0], hv[1]); w.y = cvt_pk(hv[2], hv[3]);
                                *(u32x2*)(hrow + cb * 32 + 8 * g4) = w; } }
                }
            asm volatile("s_waitcnt vmcnt(0)" ::: "memory");
            __syncthreads();
            if (tid == 0) { __builtin_amdgcn_fence(__ATOMIC_ACQUIRE, "agent"); asm volatile("s_waitcnt vmcnt(0)" ::: "memory"); }
            __syncthreads();
            if (!(PF & 2)) for (int qs = 0; qs < 8; ++qs)
                for (int rg = 0; rg < nrg; ++rg) {
                    f32x16 acc[2][4]; zero_acc(acc);
                    GE::run(lds, [&](int r) { return (r_aid[rg * 512 + r] < 0) ? (const bf16*)nullptr : (hb + (size_t)(rg * 512 + r) * ED); }, [&](int c) { return W2 + 128 * qs + c; }, D, ED / 32, acc, nullptr);
#pragma unroll
                    for (int rb = 0; rb < 2; ++rb) { const int row = rg * 512 + wave * 64 + rb * 32 + l31; const int aid = r_aid[row]; if (aid < 0) continue;
                        const float wg = r_w[row]; bf16* dst = YBUF + (size_t)aid * D + 128 * qs + 4 * h;
#pragma unroll
                        for (int cb = 0; cb < 4; ++cb)
#pragma unroll
                            for (int g4 = 0; g4 < 4; ++g4) { u32x2 w; w.x = cvt_pk(acc[rb][cb][4 * g4] * wg, acc[rb][cb][4 * g4 + 1] * wg); w.y = cvt_pk(acc[rb][cb][4 * g4 + 2] * wg, acc[rb][cb][4 * g4 + 3] * wg);
                                *(u32x2*)(dst + cb * 32 + 8 * g4) = w; } }
                }
        }
    }
}
constexpr int F8_TILE = 16384, F8_EXP_BYTES = 48 * F8_TILE;
constexpr float F8_S1 = 64.f, F8_S2 = 32.f;
template <int BMD, int SKIP = 0, int DBG = 0>
__device__ __forceinline__ void moe_chunk(const Args& a, LAS unsigned char* lds, int e, int ci) {
    constexpr int PDX = (BMD == 2) ? 1 : 4;
    typedef GemmCore<2, 4, 2, 4, 8, false, true, PDX, BMD, DBG> G1;
    typedef GemmCore<2, 4, 2, 4, 8, true, true, PDX, BMD> G2;
    static_assert(G1::LDS_NEED <= MOE_H_OFF && MOE_H_OFF + 8 * 8192 <= LDS_CTL_OFF, "MoE LDS map");
    const int tid = threadIdx.x, lane = tid & 63, wave = __builtin_amdgcn_readfirstlane(tid >> 6), wm = wave / 4, wn = wave % 4, h = lane >> 5, l31 = lane & 31;
    const bf16* H2 = (const bf16*)(a.ws + WS_H2); const int* cnt = (const int*)(a.ws + C_CNT); const int* list = (const int*)(a.ws + WS_LIST); const float* ew = (const float*)(a.ws + WS_EW);
    bf16* YBUF = (bf16*)(a.ws + WS_YBUF);
    LAS int* rowa = (LAS int*)(lds + LDS_CTL_OFF + 384);
    const int n = min(128, cnt[e] - ci * 128);
    const float* W1 = a.w1 + (size_t)e * D * ED; const float* W3 = a.w3 + (size_t)e * D * ED; const float* W2 = a.w2 + (size_t)e * ED * D;
    unsigned char* f8 = a.ws + WS_HB + (size_t)e * F8_EXP_BYTES;
    const float s1 = (BMD == 3) ? 1.f / F8_S1 : 1.f, s2 = (BMD == 3) ? 1.f / F8_S2 : 1.f;
    __syncthreads();
    if (tid < 128) rowa[tid] = (tid < n) ? list[(size_t)e * NTOK + ci * 128 + tid] : -1;
    __syncthreads();
    f32x16 acc[2][4]; zero_acc(acc);
    if (SKIP != 2) G1::run(lds, [&](int r) { const int aid = rowa[r]; return (aid < 0) ? (const bf16*)nullptr : (H2 + (size_t)(aid >> 3) * D); },
            [&](int c) { const int w4 = c >> 7, within = c & 127; return (within < 64) ? (W1 + 64 * w4 + within) : (W3 + 64 * w4 + within - 64); }, ED, D / 32, acc, nullptr, f8, F8_S1, (e * 5 + ci * 11) & 31);
#pragma unroll
    for (int rb = 0; rb < 2; ++rb) { const int row = wm * 64 + rb * 32 + l31;
#pragma unroll
        for (int cb = 0; cb < 2; ++cb)
#pragma unroll
            for (int g4 = 0; g4 < 4; ++g4) { float hv[4];
#pragma unroll
                for (int e4 = 0; e4 < 4; ++e4) { const float gt = acc[rb][cb][4 * g4 + e4] * s1, up = acc[rb][cb + 2][4 * g4 + e4] * s1; hv[e4] = gt / (1.f + __expf(-gt)) * up; }
                u32x2 w; w.x = cvt_pk(hv[0], hv[1]); w.y = cvt_pk(hv[2], hv[3]);
                *(LAS u32x2*)(lds + MOE_H_OFF + (2 * wn + cb) * 8192 + row * 64 + ((g4 ^ ((row >> 2) & 3)) << 4) + 8 * h) = w; } }
    __syncthreads();
    const int aid0 = rowa[wm * 64 + l31], aid1 = rowa[wm * 64 + 32 + l31];
    if (SKIP != 1) for (int nh = 0; nh < 2; ++nh) {
        zero_acc(acc);
        G2::run(lds, [&](int) { return (const bf16*)nullptr; }, [&](int c) { return W2 + nh * 512 + c; }, D, ED / 32, acc, lds + MOE_H_OFF, f8 + (size_t)(32 + nh * 8) * F8_TILE, F8_S2, (e * 3 + ci + nh * 4) & 7);
#pragma unroll
        for (int rb = 0; rb < 2; ++rb) {
            const int aid = rb ? aid1 : aid0; const float wgt = (aid < 0) ? 0.f : ew[aid] * s2;
            LAS unsigned char* yrow = lds + (wm * 32 + l31) * 1040 + (wn * 128 + 4 * h) * 2;
            __syncthreads();
#pragma unroll
            for (int cb = 0; cb < 4; ++cb)
#pragma unroll
                for (int g4 = 0; g4 < 4; ++g4) { u32x2 w; w.x = cvt_pk(acc[rb][cb][4 * g4] * wgt, acc[rb][cb][4 * g4 + 1] * wgt); w.y = cvt_pk(acc[rb][cb][4 * g4 + 2] * wgt, acc[rb][cb][4 * g4 + 3] * wgt);
                    *(LAS u32x2*)(yrow + (cb * 32 + 8 * g4) * 2) = w; }
            __syncthreads();
#pragma unroll
            for (int i = 0; i < 8; ++i) { const int lr = wave * 8 + i;
                const int ra = rowa[(lr >> 5) * 64 + rb * 32 + (lr & 31)];
                if (ra >= 0) *(u32x4*)(YBUF + (size_t)ra * D + nh * 512 + lane * 8) = *(const LAS u32x4*)(lds + lr * 1040 + lane * 16); }
        }
    }
}
__device__ __forceinline__ void moe_shared(const Args& a, LAS unsigned char* lds, int vcu, int G) {
    const int lane = threadIdx.x & 63, wave = __builtin_amdgcn_readfirstlane(threadIdx.x >> 6), h = lane >> 5, l31 = lane & 31;
    const bf16* H2 = (const bf16*)(a.ws + WS_H2); bf16* YSH = (bf16*)(a.ws + WS_YSH);
    typedef GemmCore<2, 2, 1, 8, 4, false, true, 4, 1> S1;
    typedef GemmCore<2, 2, 1, 8, 4, true, true, 4, 1> S2;
    constexpr int HOFF = S1::LDS_NEED;
    static_assert(HOFF + 8 * 4096 <= LDS_CTL_OFF, "shared-expert LDS map");
    const bf16* W13 = (const bf16*)(a.ws + WS_WS13T); const bf16* W2T = (const bf16*)(a.ws + WS_WS2T);
    for (int su = vcu; su < NTOK / 64; su += G) {
        const int t0 = su * 64;
        f32x16 acc[2][2]; zero_acc(acc);
        __syncthreads();
        S1::run(lds, [&](int r) { return H2 + (size_t)(t0 + r) * D; },
                [&](int c) { const int w8 = c >> 6, within = c & 63; return W13 + (size_t)((within < 32) ? (32 * w8 + within) : (ED + 32 * w8 + within - 32)) * D; }, D, D / 32, acc, nullptr);
#pragma unroll
        for (int rb = 0; rb < 2; ++rb) { const int row = rb * 32 + l31;
#pragma unroll
            for (int g4 = 0; g4 < 4; ++g4) { float hv[4];
#pragma unroll
                for (int e4 = 0; e4 < 4; ++e4) { const float gt = acc[rb][0][4 * g4 + e4], up = acc[rb][1][4 * g4 + e4]; hv[e4] = gt / (1.f + __expf(-gt)) * up; }
                u32x2 w; w.x = cvt_pk(hv[0], hv[1]); w.y = cvt_pk(hv[2], hv[3]);
                *(LAS u32x2*)(lds + HOFF + wave * 4096 + row * 64 + ((g4 ^ ((row >> 2) & 3)) << 4) + 8 * h) = w; } }
        __syncthreads();
        for (int nh = 0; nh < 2; ++nh) {
            zero_acc(acc);
            S2::run(lds, [&](int) { return (const bf16*)nullptr; }, [&](int c) { return W2T + (size_t)(nh * 512 + c) * ED; }, ED, ED / 32, acc, lds + HOFF);
#pragma unroll
            for (int rb = 0; rb < 2; ++rb) { bf16* dst = YSH + (size_t)(t0 + rb * 32 + l31) * D + nh * 512 + wave * 64 + 4 * h;
#pragma unroll
                for (int cb = 0; cb < 2; ++cb)
#pragma unroll
                    for (int g4 = 0; g4 < 4; ++g4) { u32x2 w; w.x = cvt_pk(acc[rb][cb][4 * g4], acc[rb][cb][4 * g4 + 1]); w.y = cvt_pk(acc[rb][cb][4 * g4 + 2], acc[rb][cb][4 * g4 + 3]);
                        *(u32x2*)(dst + cb * 32 + 8 * g4) = w; } }
        }
    }
}
template <int PARTS>
__device__ __forceinline__ void phase6_v6(const Args& a, LAS unsigned char* lds, int vcu, int G, const XcdBarrier bar) {
    const int tid = threadIdx.x;
    const int* cnt = (const int*)(a.ws + C_CNT);
    if (PARTS & 1) moe_shared(a, lds, vcu, G);
    if (PARTS & 2) for (int e = vcu; e < NE; e += G) if (cnt[e] > 0) moe_chunk<2>(a, lds, e, 0);
    xcd_barrier(bar);
    if (!(PARTS & 4)) return;
    LAS int* pf = (LAS int*)(lds + 0);
    __syncthreads();
    if (tid < NE) { const int c = (cnt[tid] + 127) >> 7; pf[tid + 1] = c > 0 ? c - 1 : 0; }
    if (tid == 0) pf[0] = 0;
    __syncthreads();
    if (tid == 0) { int s = 0; for (int e = 0; e < NE; ++e) { s += pf[e + 1]; pf[e + 1] = s; } }
    __syncthreads();
    const int total = pf[NE];
    LAS int* myu = (LAS int*)(lds + LDS_CTL_OFF + 256);
    int nmy = 0;
    for (int u = vcu; u < total; u += G) ++nmy;
    if (nmy > 16) nmy = 16;
    if (tid < nmy) { const int u = vcu + tid * G; int lo = 0, hi = NE - 1; while (lo < hi) { const int mid = (lo + hi) >> 1; if (pf[mid + 1] > u) hi = mid; else lo = mid + 1; }
        myu[tid] = lo; myu[16 + tid] = u - pf[lo] + 1; }
    __syncthreads();
    for (int iu = 0; iu < nmy; ++iu) { if (PARTS & 8) moe_chunk<3, 1, (PARTS >> 8)>(a, lds, myu[iu], myu[16 + iu]); else if (PARTS & 16) moe_chunk<3, 2>(a, lds, myu[iu], myu[16 + iu]); else moe_chunk<3>(a, lds, myu[iu], myu[16 + iu]); }
}
typedef long i64;
#define MFMA8(a, b, c) __builtin_amdgcn_mfma_f32_32x32x16_fp8_fp8((a), (b), (c), 0, 0, 0)
__device__ __forceinline__ i64 lo64(const u32x4& v) { return __builtin_bit_cast(i64, __builtin_shufflevector(v, v, 0, 1)); }
__device__ __forceinline__ i64 hi64(const u32x4& v) { return __builtin_bit_cast(i64, __builtin_shufflevector(v, v, 2, 3)); }
constexpr float F8_SH = 4.f;
__device__ __forceinline__ void moe_convert(const Args& a, LAS unsigned char* lds, int vcu, int G) {
    const int lane = threadIdx.x & 63, wave = __builtin_amdgcn_readfirstlane(threadIdx.x >> 6);
    LAS float* scr = (LAS float*)(lds + wave * 8448);
    const int NIT = (NE + 1) * 48 * 8;
    for (int it = vcu * NWAVE + wave; it < NIT; it += G * NWAVE) {
        const int g = it & 7, T = (it >> 3) % 48, e = it / (48 * 8);
        const float* W1 = (e < NE) ? a.w1 + (size_t)e * D * ED : a.ws1; const float* W3 = (e < NE) ? a.w3 + (size_t)e * D * ED : a.ws3; const float* W2 = (e < NE) ? a.w2 + (size_t)e * ED * D : a.ws2;
        const float* src; int ld; float sc;
        if (T < 32) { src = ((lane & 32) ? W3 : W1) + (size_t)(32 * T) * ED + 32 * g - (lane & 32); ld = ED; sc = F8_S1; }
        else { const int t2 = T - 32, nh = t2 >> 3, ks = t2 & 7; src = W2 + (size_t)(32 * ks) * D + nh * 512 + 64 * g; ld = D; sc = F8_S2; }
#pragma unroll 8
        for (int k = 0; k < 32; ++k) scr[k * 65 + lane] = src[(size_t)k * ld + lane];
        asm volatile("s_waitcnt lgkmcnt(0)" ::: "memory");
        unsigned o[8];
#pragma unroll
        for (int d = 0; d < 8; ++d) { int p = __builtin_amdgcn_cvt_pk_fp8_f32(scr[(4 * d) * 65 + lane] * sc, scr[(4 * d + 1) * 65 + lane] * sc, 0, false);
            p = __builtin_amdgcn_cvt_pk_fp8_f32(scr[(4 * d + 2) * 65 + lane] * sc, scr[(4 * d + 3) * 65 + lane] * sc, p, true); o[d] = (unsigned)p; }
        unsigned char* dst = ((e < NE) ? a.ws + WS_HB + (size_t)e * F8_EXP_BYTES : a.ws + WS_WS13T) + (size_t)T * F8_TILE + (size_t)(64 * g + lane) * 32;
        *(u32x4*)dst = (u32x4){o[0], o[1], o[2], o[3]}; *(u32x4*)(dst + 16) = (u32x4){o[4], o[5], o[6], o[7]};
        asm volatile("s_waitcnt lgkmcnt(0)" ::: "memory");
    }
}
constexpr int M8_H = 0, M8_HSTR = 272, M8_Y = 36864;
__device__ __forceinline__ void moe_chunk8(const Args& a, LAS unsigned char* lds, int e, int ci) {
    int tid = threadIdx.x; asm volatile("" : "+v"(tid));
    const int lane = tid & 63, wave = __builtin_amdgcn_readfirstlane(tid >> 6), h = lane >> 5, l31 = lane & 31;
    const int* cnt = (const int*)(a.ws + C_CNT); const int* list = (const int*)(a.ws + WS_LIST); const float* ew = (const float*)(a.ws + WS_EW);
    const bool routed = e < NE;
    bf16* YBUF = routed ? (bf16*)(a.ws + WS_YBUF) : (bf16*)(a.ws + WS_YSH); const unsigned char* X8 = a.ws + WS_X8;
    LAS int* rowa = (LAS int*)(lds + LDS_CTL_OFF + 384);
    const int n = routed ? min(128, cnt[e] - ci * 128) : 128;
#ifdef PROF_K
    unsigned long long* tsq = (unsigned long long*)(a.ws + C_TS); unsigned long long tq0 = __builtin_amdgcn_s_memrealtime();
#define SECT(i) do { if (blockIdx.x == 0 && threadIdx.x == 0) { const unsigned long long tq1 = __builtin_amdgcn_s_memrealtime(); tsq[21 + 2 * (i)] += tq1 - tq0; tq0 = tq1; } } while (0)
#else
#define SECT(i) do {} while (0)
#endif
    const unsigned char* f8 = (routed ? a.ws + WS_HB + (size_t)e * F8_EXP_BYTES : a.ws + WS_WS13T) + (size_t)(64 * wave + l31) * 32 + 16 * h;
    __syncthreads();
    if (tid < 128) rowa[tid] = (tid < n) ? (routed ? list[(size_t)e * NTOK + ci * 128 + tid] : ci * 128 + tid) : -1;
    __syncthreads();
    const int tsh = routed ? 3 : 0;
    {
        u32x4 xr[16];
#pragma unroll
        for (int i = 0; i < 16; ++i) { const int p = tid + NTHR * i, row = p >> 6, c = p & 63; const int ra = rowa[row];
            xr[i] = *(const u32x4*)(X8 + (size_t)((ra < 0) ? (p & (NTOK - 1)) : (ra >> tsh)) * D + c * 16); }
#pragma unroll
        for (int i = 0; i < 16; ++i) { const int p = tid + NTHR * i, row = p >> 6, c = p & 63; *(LAS u32x4*)(lds + row * 1040 + c * 16) = xr[i]; }
    }
    __syncthreads();
    SECT(0);
    f32x16 acc[4][2]; zero_acc(acc);
    u32x4 wb[8][2];
    const LAS unsigned char* xl = lds + l31 * 1040 + 16 * h;
    auto ld1 = [&](int d, int ks) { const unsigned char* p = f8 + (size_t)ks * F8_TILE; wb[d][0] = *(const u32x4*)p; wb[d][1] = *(const u32x4*)(p + 1024); };
#pragma unroll
    for (int d = 0; d < 8; ++d) ld1(d, d);
#pragma unroll 1
    for (int ks0 = 0; ks0 < 32; ks0 += 8) {
#pragma unroll
        for (int d = 0; d < 8; ++d) { const int ks = ks0 + d;
            u32x4 x[4];
#pragma unroll
            for (int rb = 0; rb < 4; ++rb) x[rb] = *(const LAS u32x4*)(xl + rb * 32 * 1040 + 32 * ks);
#pragma unroll
            for (int rb = 0; rb < 4; ++rb) { acc[rb][0] = MFMA8(lo64(wb[d][0]), lo64(x[rb]), acc[rb][0]); acc[rb][1] = MFMA8(lo64(wb[d][1]), lo64(x[rb]), acc[rb][1]); }
#pragma unroll
            for (int rb = 0; rb < 4; ++rb) { acc[rb][0] = MFMA8(hi64(wb[d][0]), hi64(x[rb]), acc[rb][0]); acc[rb][1] = MFMA8(hi64(wb[d][1]), hi64(x[rb]), acc[rb][1]); }
            ld1(d, min(ks + 8, 24 + d)); asm volatile("" ::: "memory"); }
    }
    asm volatile("s_waitcnt vmcnt(0)" ::: "memory");
    __syncthreads();
    SECT(1);
    {
        const float s1 = 1.f / F8_S1;
#pragma unroll
        for (int rb = 0; rb < 4; ++rb) { const int row = rb * 32 + l31;
#pragma unroll
            for (int g4 = 0; g4 < 4; ++g4) { float hv[4];
#pragma unroll
                for (int e4 = 0; e4 < 4; ++e4) { const float gt = acc[rb][0][4 * g4 + e4] * s1, up = acc[rb][1][4 * g4 + e4] * s1; hv[e4] = fminf(fmaxf(gt * __builtin_amdgcn_rcpf(1.f + __expf(-gt)) * up * F8_SH, -440.f), 440.f); }
                int p = __builtin_amdgcn_cvt_pk_fp8_f32(hv[0], hv[1], 0, false); p = __builtin_amdgcn_cvt_pk_fp8_f32(hv[2], hv[3], p, true);
                *(LAS int*)(lds + M8_H + row * M8_HSTR + 32 * wave + 8 * g4 + 4 * h) = p; } }
    }
    __syncthreads();
    SECT(2);
    const LAS unsigned char* hp = lds + M8_H + l31 * M8_HSTR + 16 * h;
    for (int nh = 0; nh < 2; ++nh) {
        zero_acc(acc);
        const unsigned char* p2 = f8 + (size_t)(32 + nh * 8) * F8_TILE;
#pragma unroll
        for (int d = 0; d < 8; ++d) { wb[d][0] = *(const u32x4*)(p2 + (size_t)d * F8_TILE); wb[d][1] = *(const u32x4*)(p2 + (size_t)d * F8_TILE + 1024); }
#pragma unroll
        for (int d = 0; d < 8; ++d) {
            u32x4 x[4];
#pragma unroll
            for (int rb = 0; rb < 4; ++rb) x[rb] = *(const LAS u32x4*)(hp + rb * 32 * M8_HSTR + 32 * d);
#pragma unroll
            for (int rb = 0; rb < 4; ++rb) { acc[rb][0] = MFMA8(lo64(wb[d][0]), lo64(x[rb]), acc[rb][0]); acc[rb][1] = MFMA8(lo64(wb[d][1]), lo64(x[rb]), acc[rb][1]); }
#pragma unroll
            for (int rb = 0; rb < 4; ++rb) { acc[rb][0] = MFMA8(hi64(wb[d][0]), hi64(x[rb]), acc[rb][0]); acc[rb][1] = MFMA8(hi64(wb[d][1]), hi64(x[rb]), acc[rb][1]); }
        }
        SECT(3);
        const float s2 = 1.f / (F8_S2 * F8_SH);
#pragma unroll
        for (int hf = 0; hf < 2; ++hf) {
            __syncthreads();
#pragma unroll
            for (int r2 = 0; r2 < 2; ++r2) { const int rb = hf * 2 + r2; const int aid = rowa[rb * 32 + l31]; const float wgt = (aid < 0) ? 0.f : (routed ? ew[aid] : 1.f) * s2;
                LAS unsigned char* yrow = lds + M8_Y + (r2 * 32 + l31) * 1040 + (wave * 64 + 4 * h) * 2;
#pragma unroll
                for (int cb = 0; cb < 2; ++cb)
#pragma unroll
                    for (int g4 = 0; g4 < 4; ++g4) { u32x2 w; w.x = cvt_pk(acc[rb][cb][4 * g4] * wgt, acc[rb][cb][4 * g4 + 1] * wgt); w.y = cvt_pk(acc[rb][cb][4 * g4 + 2] * wgt, acc[rb][cb][4 * g4 + 3] * wgt);
                        *(LAS u32x2*)(yrow + (cb * 32 + 8 * g4) * 2) = w; } }
            __syncthreads();
#pragma unroll 2
            for (int i = 0; i < 8; ++i) { const int lr = wave * 8 + i; const int ra = rowa[hf * 64 + lr];
                if (ra >= 0) *(u32x4*)(YBUF + (size_t)ra * D + nh * 512 + lane * 8) = *(const LAS u32x4*)(lds + M8_Y + lr * 1040 + lane * 16); }
        }
        SECT(4);
    }
}
template <int PARTS>
__device__ __forceinline__ void phase6_v7(const Args& a, LAS unsigned char* lds, int vcu, int G, const XcdBarrier bar) {
    const int tid = threadIdx.x;
    const int* cnt = (const int*)(a.ws + C_CNT);
    if (PARTS & 1) moe_convert(a, lds, vcu, G);
    __syncthreads();
    xcd_barrier(bar);
    if (!(PARTS & 4)) return;
    LAS int* pf = (LAS int*)(lds + 65536);
    __syncthreads();
    if (tid < NE) pf[tid + 1] = (cnt[tid] + 127) >> 7;
    if (tid == 0) pf[0] = 0;
    __syncthreads();
    if (tid == 0) { int s = 0; for (int e = 0; e < NE; ++e) { s += pf[e + 1]; pf[e + 1] = s; } }
    __syncthreads();
    constexpr int NSH = NTOK / 128;
    const int total = NSH + pf[NE];
    LAS int* myu = (LAS int*)(lds + LDS_CTL_OFF + 256);
    int nmy = 0;
    for (int u = vcu; u < total; u += G) ++nmy;
    if (nmy > 16) nmy = 16;
    if (tid < nmy) { const int u = vcu + tid * G;
        if (u < NSH) { myu[tid] = NE; myu[16 + tid] = u; }
        else { const int ru = u - NSH; int lo = 0, hi = NE - 1; while (lo < hi) { const int mid = (lo + hi) >> 1; if (pf[mid + 1] > ru) hi = mid; else lo = mid + 1; }
            myu[tid] = lo; myu[16 + tid] = ru - pf[lo]; } }
    __syncthreads();
    for (int iu = 0; iu < nmy; ++iu) moe_chunk8(a, lds, myu[iu], myu[16 + iu]);
}
__device__ __forceinline__ void phase7(const Args& a, int vcu, int G) {
    const int lane = threadIdx.x & 63, gw = vcu * NWAVE + (threadIdx.x >> 6), NGW = G * NWAVE;
#ifdef PROF_K
    const unsigned long long* ts = (const unsigned long long*)(a.ws + C_TS);
    const float prof_b1 = rintf(log2f(fmaxf((float)(ts[PROF_K + 1] - ts[PROF_K]) * 0.01f, 1.f)) * 4.f), prof_us2 = exp2f(rintf(log2f(fmaxf((float)(ts[PROF_K2 + 1] - ts[PROF_K2]) * 0.01f, 1.f)) * 4.f) * 0.25f);
    const float prof_scale = 1.f + prof_b1 * PROF_S;
#else
    const float prof_scale = 1.f;
#endif
    const float* X1 = (const float*)(a.ws + WS_X1); const float* mod = (const float*)(a.ws + C_MOD);
    const bf16* YBUF = (const bf16*)(a.ws + WS_YBUF); const bf16* YSH = (const bf16*)(a.ws + WS_YSH);
    for (int t = gw; t < NTOK; t += NGW) { const int b = t / S;
        f32x4 v[4]; float s = 0.f;
#pragma unroll
        for (int j = 0; j < 4; ++j) { const int c = j * 256 + lane * 4;
            u32x2 w = *(const u32x2*)(YSH + (size_t)t * D + c);
            float m0 = __uint_as_float(w.x << 16), m1 = __uint_as_float(w.x & 0xffff0000u), m2 = __uint_as_float(w.y << 16), m3 = __uint_as_float(w.y & 0xffff0000u);
#pragma unroll
            for (int r = 0; r < 8; ++r) { w = *(const u32x2*)(YBUF + ((size_t)t * 8 + r) * D + c);
                m0 += __uint_as_float(w.x << 16); m1 += __uint_as_float(w.x & 0xffff0000u); m2 += __uint_as_float(w.y << 16); m3 += __uint_as_float(w.y & 0xffff0000u); }
            const f32x4 xv = *(const f32x4*)(X1 + (size_t)t * D + c), g2 = *(const f32x4*)(mod + b * 6 * D + 5 * D + c);
            v[j].x = xv.x + g2.x * m0; v[j].y = xv.y + g2.y * m1; v[j].z = xv.z + g2.z * m2; v[j].w = xv.w + g2.w * m3;
            s += (v[j].x * v[j].x + v[j].y * v[j].y) + (v[j].z * v[j].z + v[j].w * v[j].w); }
        const float rstd = rsqrtf(wave_sum(s) * (1.f / D) + EPS);
#pragma unroll
        for (int j = 0; j < 4; ++j) { const int c = j * 256 + lane * 4; const f32x4 fg = *(const f32x4*)(a.final_g + c);
            f32x4 o; o.x = v[j].x * rstd * fg.x * prof_scale; o.y = v[j].y * rstd * fg.y * prof_scale; o.z = v[j].z * rstd * fg.z * prof_scale; o.w = v[j].w * rstd * fg.w * prof_scale;
#ifdef PROF_K
            if (t == 0 && c == 0) o.x = prof_us2;
#endif
            *(f32x4*)(a.out + (size_t)t * D + c) = o; }
    }
}
__global__ void __launch_bounds__(NTHR, 2) mega(Args a) {
    extern __shared__ __attribute__((aligned(16))) unsigned char lds_raw[];
    LAS unsigned char* lds = (LAS unsigned char*)lds_raw;
    const int tid = threadIdx.x, G = gridDim.x;
    const int bx = blockIdx.x, vcu = (G % 8 == 0) ? (bx % 8) * (G / 8) + bx / 8 : bx;
    volatile LAS unsigned* ctl = (volatile LAS unsigned*)(lds + LDS_CTL_OFF);
    if (tid < 64) ctl[tid] = 0u;
    __syncthreads();
    XcdBarrier bar = xcd_barrier_post((unsigned*)(a.ws + C_BAR) + a.ph_lo * XCD_BAR_WORDS, ctl);
    const int lo = a.ph_lo, hi = a.ph_hi;
#ifndef ONLY_PHASE
#define ONLY_PHASE -1
#endif
#define IN(k) (lo <= (k) && (k) < hi && (ONLY_PHASE < 0 || ONLY_PHASE == (k)))
#ifndef XBAR
#define XBAR 1
#endif
#ifdef PROF_K
#define STAMP(i) do { if (blockIdx.x == 0 && tid == 0) ((unsigned long long*)(a.ws + C_TS))[i] = __builtin_amdgcn_s_memrealtime(); } while (0)
#else
#define STAMP(i) do {} while (0)
#endif
#define SEAM(k) do { if (IN(k) && IN((k) + 1)) { STAMP(2 * (k) + 1); for (int xb = 0; xb < XBAR; ++xb) xcd_barrier(bar); STAMP(2 * (k) + 2); } } while (0)
    STAMP(0);
#ifndef REP_PHASE
#define REP_PHASE -1
#endif
#ifndef REP_N
#define REP_N 1
#endif
#define NREP(k) ((REP_PHASE == (k)) ? REP_N : 1)
    if (IN(0))
#pragma unroll 1
    for (int rep = 0; rep < NREP(0); ++rep) { phase0(a, lds, vcu, G); __syncthreads(); }
    SEAM(0);
    if (IN(1)) for (int rep = 0; rep < NREP(1); ++rep) phase1(a, vcu, G);
    SEAM(1);
    if (IN(2)) for (int rep = 0; rep < NREP(2); ++rep) phase2(a, lds, vcu, G);
    SEAM(2);
    if (IN(3)) for (int rep = 0; rep < NREP(3); ++rep) phase3(a, lds, vcu, G);
    SEAM(3);
    if (IN(4)) for (int rep = 0; rep < NREP(4); ++rep) phase4(a, lds, vcu, G);
    SEAM(4);
    if (IN(5)) for (int rep = 0; rep < NREP(5); ++rep) phase5(a, lds, vcu, G, rep > 0);
    SEAM(5);
#ifndef MOE_V2
#define MOE_V2 7
#endif
#ifdef PROBE_MOE
    if (IN(6)) { phase6_v7<PROBE_MOE>(a, lds, vcu, G, bar); xcd_barrier(bar); }
#endif
    if (IN(6)) for (int rep = 0; rep < NREP(6); ++rep) { if (MOE_V2 == 7) phase6_v7<7>(a, lds, vcu, G, bar); else if (MOE_V2 == 6) phase6_v6<7>(a, lds, vcu, G, bar); else if (MOE_V2 == 3) phase6<0>(a, lds, vcu, G); else if (MOE_V2 == 2) phase6_v2(a, lds, vcu, G); else phase6_old(a, lds, vcu, G, bar, false); }
    SEAM(6);
    if (IN(7)) for (int rep = 0; rep < NREP(7); ++rep) phase7(a, vcu, G);
#undef IN
#undef SEAM
}

#ifndef OPT_MASK
#define OPT_MASK 0xFF
#endif
static void launch_mega(const Args& base, int lo, int hi, int grid, hipStream_t stream) {
    Args a = base; a.ph_lo = lo; a.ph_hi = hi;
    hipLaunchKernelGGL(mega, dim3(grid), dim3(NTHR), LDS_BYTES, stream, a);
}
extern "C" void kernel_launch(void* const* d_in, const int* in_sizes, int n_in, void* d_out, int out_size, void* d_ws, size_t ws_size, hipStream_t stream) {
    static int grid = 0;
    if (grid == 0) {
        if (n_in != 21 || ws_size < WS_END) { fprintf(stderr, "kernel_launch: unexpected n_in %d or ws_size %zu\n", n_in, ws_size); grid = -1; return; }
        int dev = 0, cus = 0, per_cu = 0;
        if (hipGetDevice(&dev) != hipSuccess || hipDeviceGetAttribute(&cus, hipDeviceAttributeMultiprocessorCount, dev) != hipSuccess) { grid = -1; return; }
        if (hipFuncSetAttribute((const void*)mega, hipFuncAttributeMaxDynamicSharedMemorySize, LDS_BYTES) != hipSuccess) { fprintf(stderr, "kernel_launch: hipFuncSetAttribute failed\n"); grid = -1; return; }
        if (hipOccupancyMaxActiveBlocksPerMultiprocessor(&per_cu, (const void*)mega, NTHR, LDS_BYTES) != hipSuccess || per_cu < 1) { fprintf(stderr, "kernel_launch: occupancy query says %d blocks per CU\n", per_cu); (void)hipGetLastError(); grid = -1; return; }
        grid = cus;
    }
    if (grid < 0) return;
    unsigned char* ws = (unsigned char*)d_ws;
    Args a{};
    a.x = (const float*)d_in[0]; a.c = (const float*)d_in[1]; a.w_ada = (const float*)d_in[2]; a.b_ada = (const float*)d_in[3]; a.norm1_g = (const float*)d_in[4]; a.w_in = (const float*)d_in[5];
    a.sinks = (const float*)d_in[6]; a.rel_table = (const float*)d_in[7]; a.out_norm_a = (const float*)d_in[8]; a.out_norm_b = (const float*)d_in[9]; a.w_out = (const float*)d_in[10];
    a.norm2_g = (const float*)d_in[11]; a.w_router = (const float*)d_in[12]; a.e_bias = (const float*)d_in[13]; a.w1 = (const float*)d_in[14]; a.w3 = (const float*)d_in[15]; a.w2 = (const float*)d_in[16];
    a.ws1 = (const float*)d_in[17]; a.ws3 = (const float*)d_in[18]; a.ws2 = (const float*)d_in[19]; a.final_g = (const float*)d_in[20];
    a.out = (float*)d_out; a.ws = ws; a.ph_lo = 0; a.ph_hi = 8;
    (void)hipMemsetAsync(ws + WS_CTL, 0, CTL_BYTES, stream);
#if defined(P0_TIMING)
    for (int r = 0; r < P0_TIMING; ++r) launch_mega(a, 0, 1, grid, stream);
    launch_mega(a, 1, 8, grid, stream);
#elif OPT_MASK == 0xFF && !defined(SPLIT_LAUNCH)
    launch_mega(a, 0, 8, grid, stream);
#else
    float* mod = (float*)(ws + C_MOD); float* ksum = (float*)(ws + C_KSUM); float* ssq = (float*)(ws + WS_SSQ); int* cnt = (int*)(ws + C_CNT);
    float* lut = (float*)(ws + WS_LUT); bf16* H = (bf16*)(ws + WS_H);
    bf16* QA = (bf16*)(ws + WS_QA); bf16* KA = (bf16*)(ws + WS_KA); bf16* VAT = (bf16*)(ws + WS_VAT); bf16* QB = (bf16*)(ws + WS_QB); bf16* KB = (bf16*)(ws + WS_KB); bf16* VBT = (bf16*)(ws + WS_VBT);
    bf16* ATT = (bf16*)(ws + WS_ATT); float* X1 = (float*)(ws + WS_X1); bf16* H2 = (bf16*)(ws + WS_H2); float* EW = (float*)(ws + WS_EW); int* LIST = (int*)(ws + WS_LIST);
    bf16* YSH = (bf16*)(ws + WS_YSH); bf16* YBUF = (bf16*)(ws + WS_YBUF);
    if (OPT_MASK & 1) launch_mega(a, 0, 1, grid, stream); else { k_mod<<<24, 256, 0, stream>>>(a.c, a.w_ada, a.b_ada, mod); k_lut<<<(16 * LUTN + 255) / 256, 256, 0, stream>>>(a.rel_table, lut); }
    if (OPT_MASK & 2) launch_mega(a, 1, 2, grid, stream); else k_norm_mod<<<NTOK, 256, 0, stream>>>(a.x, a.norm1_g, mod, 0, D, H);
    if (OPT_MASK & 4) launch_mega(a, 2, 3, grid, stream); else k_inproj<<<dim3(INC / 256, NTOK), 256, 0, stream>>>(H, a.w_in, QA, KA, VAT, QB, KB, VBT, ksum);
    if (OPT_MASK & 8) launch_mega(a, 3, 4, grid, stream); else { k_swa<<<NTOK * 8 / 64, 64, 0, stream>>>(QA, KA, VAT, lut, a.sinks, a.out_norm_a, ATT, ssq); k_moba<<<NTOK * 8 / 64, 64, 0, stream>>>(QB, KB, VBT, ksum, lut, a.out_norm_b, ATT, ssq); }
    if (OPT_MASK & 16) launch_mega(a, 4, 5, grid, stream); else k_outproj<<<dim3(D / 256, NTOK), 256, 0, stream>>>(ATT, ssq, a.w_out, a.x, mod, X1);
    if (OPT_MASK & 32) launch_mega(a, 5, 6, grid, stream); else { k_norm_mod<<<NTOK, 256, 0, stream>>>(X1, a.norm2_g, mod, 3 * D, 4 * D, H2); k_router<<<NTOK, 256, 0, stream>>>(H2, a.w_router, a.e_bias, cnt, LIST, EW); }
    if (OPT_MASK & 64) launch_mega(a, 6, 7, grid, stream); else k_moe<<<dim3(NTOK / 8, NE + 1), 256, 0, stream>>>(H2, cnt, LIST, EW, a.w1, a.w3, a.w2, a.ws1, a.ws3, a.ws2, YBUF, YSH);
    if (OPT_MASK & 128) launch_mega(a, 7, 8, grid, stream); else k_final<<<NTOK, 256, 0, stream>>>(X1, YBUF, YSH, mod, a.final_g, (float*)d_out);
#endif
}
```

```cpp
#include <hip/hip_runtime.h>
#include <cstdio>
#include <cstdint>

constexpr int D = 1024, NB = 8, S = 2048, NTOK = NB * S;
constexpr int HD = 64, INC = 2304;
constexpr int NE = 256, TOPK = 8, ED = 256;
constexpr float EPS = 1e-6f;
constexpr float LOG2E = 1.4426950408889634f;
constexpr float QSCALE = 0.125f * LOG2E;
constexpr float NEGBIG = -1e30f;

typedef unsigned short bf16;
__device__ __forceinline__ float bf2f(bf16 v) { return __uint_as_float(((unsigned)v) << 16); }
__device__ __forceinline__ bf16 f2bf(float f) { unsigned u = __float_as_uint(f); return (bf16)((u + 0x7fffu + ((u >> 16) & 1u)) >> 16); }

constexpr size_t MiB = 1u << 20;
constexpr size_t WS_CTL   = 0;
constexpr size_t CTL_BYTES = 1 * MiB;
constexpr size_t C_MOD   = 64 * 1024;
constexpr size_t C_KSUM  = 320 * 1024;
constexpr size_t C_SSQA  = 512 * 1024;
constexpr size_t C_SSQB  = 576 * 1024;
constexpr size_t C_CNT   = 640 * 1024;
constexpr size_t C_QHEAD = 644 * 1024;
constexpr size_t C_TS    = 648 * 1024;
constexpr size_t WS_LUT  = 1 * MiB;
constexpr size_t WS_H    = 2 * MiB;
constexpr size_t WS_QA   = 34 * MiB;
constexpr size_t WS_KA   = 50 * MiB;
constexpr size_t WS_VAT  = 54 * MiB;
constexpr size_t WS_QB   = 58 * MiB;
constexpr size_t WS_KB   = 74 * MiB;
constexpr size_t WS_VBT  = 90 * MiB;
constexpr size_t WS_ATT  = 106 * MiB;
constexpr size_t WS_X1   = 138 * MiB;
constexpr size_t WS_H2   = 202 * MiB;
constexpr size_t WS_EW   = 234 * MiB;
constexpr size_t WS_SSQ  = 235 * MiB;
constexpr size_t WS_LIST = 236 * MiB;
constexpr size_t WS_YSH  = 256 * MiB;
constexpr size_t WS_YBUF = 288 * MiB;
constexpr size_t WS_WTIN = 640 * MiB;
constexpr size_t WS_WTOUT= 645 * MiB;
constexpr size_t WS_WTR  = 647 * MiB;
constexpr size_t WS_WS13T= 648 * MiB;
constexpr size_t WS_WS2T = 649 * MiB;
constexpr size_t WS_HB   = 650 * MiB;
constexpr size_t WS_X8   = 842 * MiB;
constexpr size_t WS_END  = 858 * MiB;

constexpr int LUT_NEG = 256;
constexpr int LUTN = 2560;

__device__ __forceinline__ int t5_bucket(int n) {
    if (n < 16) return n;
    const int thr[15] = {21, 27, 35, 46, 59, 77, 99, 128, 166, 216, 280, 363, 470, 609, 790};
    int b = 16;
#pragma unroll
    for (int i = 0; i < 15; ++i) b += (n >= thr[i]) ? 1 : 0;
    return b;
}

__global__ void k_mod(const float* c, const float* w_ada, const float* b_ada, float* mod) {
    int j = blockIdx.x * blockDim.x + threadIdx.x;
    if (j >= 6 * D) return;
    float acc[NB];
#pragma unroll
    for (int b = 0; b < NB; ++b) acc[b] = 0.f;
    for (int k = 0; k < D; ++k) {
        float w = w_ada[(size_t)k * 6 * D + j];
#pragma unroll
        for (int b = 0; b < NB; ++b) { float cv = c[b * D + k]; float sv = cv / (1.f + __expf(-cv)); acc[b] += sv * w; }
    }
#pragma unroll
    for (int b = 0; b < NB; ++b) mod[b * 6 * D + j] = acc[b] + b_ada[j];
}
__global__ void k_lut(const float* rel_table, float* lut) {
    int i = blockIdx.x * blockDim.x + threadIdx.x;
    if (i >= 16 * LUTN) return;
    int h = i / LUTN, p = i % LUTN, dist = p - LUT_NEG;
    float v = NEGBIG;
    bool ok = dist >= 0 && (h < 8 ? dist < 128 : dist < S);
    if (ok) v = rel_table[t5_bucket(dist) * 16 + h] * LOG2E;
    lut[i] = v;
}
__global__ void k_norm_mod(const float* x, const float* g, const float* mod, int sh_off, int sc_off, bf16* out) {
    int t = blockIdx.x, b = t / S, tid = threadIdx.x;
    __shared__ float red[256];
    float v[4]; float s = 0.f;
#pragma unroll
    for (int i = 0; i < 4; ++i) { v[i] = x[(size_t)t * D + tid + 256 * i]; s += v[i] * v[i]; }
    red[tid] = s; __syncthreads();
    for (int o = 128; o > 0; o >>= 1) { if (tid < o) red[tid] += red[tid + o]; __syncthreads(); }
    float rstd = rsqrtf(red[0] / D + EPS);
#pragma unroll
    for (int i = 0; i < 4; ++i) { int col = tid + 256 * i;
        float hv = v[i] * rstd * g[col] * (1.f + mod[b * 6 * D + sc_off + col]) + mod[b * 6 * D + sh_off + col];
        out[(size_t)t * D + col] = f2bf(hv); }
}
__global__ void k_inproj(const bf16* h, const float* w_in, bf16* QA, bf16* KA, bf16* VAT, bf16* QB, bf16* KB, bf16* VBT, float* ksum) {
    int col = blockIdx.x * blockDim.x + threadIdx.x;
    int t = blockIdx.y;
    if (col >= INC) return;
    float acc = 0.f;
    const bf16* hr = h + (size_t)t * D;
    for (int k = 0; k < D; ++k) acc += bf2f(hr[k]) * w_in[(size_t)k * INC + col];
    int b = t / S, s = t % S;
    if (col < 512) { int hh = col / 64, d = col % 64; QA[(((size_t)b * 8 + hh) * S + s) * 64 + d] = f2bf(acc * QSCALE); }
    else if (col < 640) { int c2 = col - 512, hh = c2 / 64, d = c2 % 64; KA[(((size_t)b * 2 + hh) * S + s) * 64 + d] = f2bf(acc); }
    else if (col < 768) { int c2 = col - 640, hh = c2 / 64, d = c2 % 64; VAT[(((size_t)b * 2 + hh) * 64 + d) * S + s] = f2bf(acc); }
    else if (col < 1280) { int c2 = col - 768, hh = c2 / 64, d = c2 % 64; QB[(((size_t)b * 8 + hh) * S + s) * 64 + d] = f2bf(acc * QSCALE); }
    else if (col < 1792) { int c2 = col - 1280, hh = c2 / 64, d = c2 % 64; bf16 kb = f2bf(acc); KB[(((size_t)b * 8 + hh) * S + s) * 64 + d] = kb;
        atomicAdd(&ksum[(((size_t)b * 8 + hh) * 8 + s / 256) * 64 + d], bf2f(kb)); }
    else { int c2 = col - 1792, hh = c2 / 64, d = c2 % 64; VBT[(((size_t)b * 8 + hh) * 64 + d) * S + s] = f2bf(acc); }
}
__global__ void __launch_bounds__(64) k_swa(const bf16* QA, const bf16* KA, const bf16* VAT, const float* lut, const float* sinks, const float* gain, bf16* att, float* ssq) {
    int idx = blockIdx.x * blockDim.x + threadIdx.x;
    if (idx >= NTOK * 8) return;
    int hh = idx % 8, t = idx / 8, b = t / S, s = t % S, kv = hh / 4;
    float q[64];
    const bf16* qp = QA + (((size_t)b * 8 + hh) * S + s) * 64;
#pragma unroll
    for (int d = 0; d < 64; ++d) q[d] = bf2f(qp[d]);
    const float* L = lut + hh * LUTN + LUT_NEG;
    int n = s / 128;
    int k0 = (n == 0) ? 0 : (n - 1) * 128, k1 = s;
    float m = NEGBIG, l = 0.f; float o[64];
#pragma unroll
    for (int d = 0; d < 64; ++d) o[d] = 0.f;
    for (int kp = k0; kp <= k1; ++kp) {
        const bf16* kr = KA + (((size_t)b * 2 + kv) * S + kp) * 64;
        float sc = 0.f;
#pragma unroll
        for (int d = 0; d < 64; ++d) sc += q[d] * bf2f(kr[d]);
        sc += L[s - kp];
        float mn = fmaxf(m, sc), a = exp2f(m - mn), p = exp2f(sc - mn);
        l = l * a + p;
#pragma unroll
        for (int d = 0; d < 64; ++d) o[d] = o[d] * a + p * bf2f(VAT[(((size_t)b * 2 + kv) * 64 + d) * S + kp]);
        m = mn;
    }
    float sk = sinks[hh] * LOG2E;
    float mn = fmaxf(m, sk), a = exp2f(m - mn);
    l = l * a + exp2f(sk - mn);
    float inv = a / l, sq = 0.f;
#pragma unroll
    for (int d = 0; d < 64; ++d) { float ov = o[d] * inv; sq += ov * ov; att[(size_t)t * D + hh * 64 + d] = f2bf(ov * gain[hh * 64 + d]); }
    ssq[t * 16 + hh] = sq;
}
__global__ void __launch_bounds__(64) k_moba(const bf16* QB, const bf16* KB, const bf16* VBT, const float* ksum, const float* lut, const float* gain, bf16* att, float* ssq) {
    int idx = blockIdx.x * blockDim.x + threadIdx.x;
    if (idx >= NTOK * 8) return;
    int hh = idx % 8, t = idx / 8, b = t / S, s = t % S;
    float q[64];
    const bf16* qp = QB + (((size_t)b * 8 + hh) * S + s) * 64;
#pragma unroll
    for (int d = 0; d < 64; ++d) q[d] = bf2f(qp[d]);
    const float* L = lut + (8 + hh) * LUTN + LUT_NEG;
    int qb = s / 256;
    float gate[8];
#pragma unroll
    for (int j = 0; j < 8; ++j) {
        float gsum = -INFINITY;
        if (j < qb) { gsum = 0.f; const float* km = ksum + (((size_t)b * 8 + hh) * 8 + j) * 64;
#pragma unroll
            for (int d = 0; d < 64; ++d) gsum += q[d] * km[d]; }
        gate[j] = gsum;
    }
    unsigned sel = 0; int nsel = qb < 3 ? qb : 3;
    for (int r = 0; r < nsel; ++r) { int best = -1; float bv = -INFINITY;
#pragma unroll
        for (int j = 0; j < 8; ++j) if (j < qb && !((sel >> j) & 1) && (best < 0 || gate[j] > bv)) { best = j; bv = gate[j]; }
        sel |= 1u << best; }
    sel |= 1u << qb;
    float m = NEGBIG, l = 0.f; float o[64];
#pragma unroll
    for (int d = 0; d < 64; ++d) o[d] = 0.f;
    for (int j = 0; j <= qb; ++j) {
        if (!((sel >> j) & 1)) continue;
        int kend = (j == qb) ? s : (j * 256 + 255);
        for (int kp = j * 256; kp <= kend; ++kp) {
            const bf16* kr = KB + (((size_t)b * 8 + hh) * S + kp) * 64;
            float sc = 0.f;
#pragma unroll
            for (int d = 0; d < 64; ++d) sc += q[d] * bf2f(kr[d]);
            sc += L[s - kp];
            float mn = fmaxf(m, sc), a = exp2f(m - mn), p = exp2f(sc - mn);
            l = l * a + p;
#pragma unroll
            for (int d = 0; d < 64; ++d) o[d] = o[d] * a + p * bf2f(VBT[(((size_t)b * 8 + hh) * 64 + d) * S + kp]);
            m = mn;
        }
    }
    float inv = 1.f / l, sq = 0.f;
#pragma unroll
    for (int d = 0; d < 64; ++d) { float ov = o[d] * inv; sq += ov * ov; att[(size_t)t * D + 512 + hh * 64 + d] = f2bf(ov * gain[hh * 64 + d]); }
    ssq[t * 16 + 8 + hh] = sq;
}
__global__ void k_outproj(const bf16* att, const float* ssq, const float* w_out, const float* x, const float* mod, float* x1) {
    int col = blockIdx.x * blockDim.x + threadIdx.x, t = blockIdx.y, b = t / S;
    float sa = 0.f, sb = 0.f; for (int i = 0; i < 8; ++i) { sa += ssq[t * 16 + i]; sb += ssq[t * 16 + 8 + i]; }
    float ra = rsqrtf(sa / 512.f + EPS), rb = rsqrtf(sb / 512.f + EPS);
    const bf16* ar = att + (size_t)t * D;
    float a0 = 0.f, a1 = 0.f;
    for (int k = 0; k < 512; ++k) a0 += bf2f(ar[k]) * w_out[(size_t)k * D + col];
    for (int k = 512; k < 1024; ++k) a1 += bf2f(ar[k]) * w_out[(size_t)k * D + col];
    float y = a0 * ra + a1 * rb;
    x1[(size_t)t * D + col] = x[(size_t)t * D + col] + mod[b * 6 * D + 2 * D + col] * y;
}
__global__ void k_router(const bf16* h2, const float* w_router, const float* e_bias, int* cnt, int* list, float* ew) {
    int t = blockIdx.x, e = threadIdx.x;
    __shared__ float sc[256], sel[256], gs[8]; __shared__ int chosen[8];
    const bf16* hr = h2 + (size_t)t * D;
    float acc = 0.f;
    for (int k = 0; k < D; ++k) acc += bf2f(hr[k]) * w_router[(size_t)k * NE + e];
    float s = 1.f / (1.f + __expf(-acc));
    sc[e] = s; sel[e] = s + e_bias[e];
    __syncthreads();
    if (e < 8) { float m1 = -INFINITY, m2 = -INFINITY;
        for (int i = 0; i < 32; ++i) { float v = sel[e * 32 + i]; if (v > m1) { m2 = m1; m1 = v; } else if (v > m2) m2 = v; }
        gs[e] = m1 + m2; }
    __syncthreads();
    if (e == 0) {
        unsigned gm = 0;
        for (int r = 0; r < 4; ++r) { int best = -1; float bv = 0.f;
            for (int g = 0; g < 8; ++g) if (!((gm >> g) & 1) && (best < 0 || gs[g] > bv)) { best = g; bv = gs[g]; }
            gm |= 1u << best; }
        float wsum = 0.f;
        for (int r = 0; r < 8; ++r) { int best = -1; float bv = 0.f;
            for (int i = 0; i < 256; ++i) { if (!((gm >> (i / 32)) & 1)) continue; bool used = false; for (int q = 0; q < r; ++q) used |= (chosen[q] == i);
                if (used) continue; if (best < 0 || sel[i] > bv) { best = i; bv = sel[i]; } }
            chosen[r] = best; wsum += sc[best]; }
        for (int r = 0; r < 8; ++r) { int ex = chosen[r]; int slot = atomicAdd(&cnt[ex], 1); list[(size_t)ex * NTOK + slot] = t * 8 + r; ew[t * 8 + r] = sc[ex] / wsum * 2.5f; }
    }
}
__global__ void k_moe(const bf16* h2, const int* cnt, const int* list, const float* ew, const float* w1, const float* w3, const float* w2,
                      const float* ws1, const float* ws3, const float* ws2, bf16* ybuf, bf16* ysh) {
    int e = blockIdx.y, g = blockIdx.x, tid = threadIdx.x;
    int n = (e < NE) ? cnt[e] : NTOK;
    if (g * 8 >= n) return;
    const float* W1 = (e < NE) ? w1 + (size_t)e * D * ED : ws1;
    const float* W3 = (e < NE) ? w3 + (size_t)e * D * ED : ws3;
    const float* W2 = (e < NE) ? w2 + (size_t)e * ED * D : ws2;
    __shared__ float xs[8][1024]; __shared__ float hs[8][256]; __shared__ int aid[8];
    if (tid < 8) { int i = g * 8 + tid; aid[tid] = (i < n) ? ((e < NE) ? list[(size_t)e * NTOK + i] : i) : -1; }
    __syncthreads();
    for (int r = 0; r < 8; ++r) { int a = aid[r]; int tok = (a < 0) ? 0 : ((e < NE) ? a / 8 : a);
        for (int k = tid; k < D; k += 256) xs[r][k] = (a < 0) ? 0.f : bf2f(h2[(size_t)tok * D + k]); }
    __syncthreads();
    float gg[8], uu[8];
#pragma unroll
    for (int r = 0; r < 8; ++r) { gg[r] = 0.f; uu[r] = 0.f; }
    for (int k = 0; k < D; ++k) { float a = W1[(size_t)k * ED + tid], b = W3[(size_t)k * ED + tid];
#pragma unroll
        for (int r = 0; r < 8; ++r) { gg[r] += xs[r][k] * a; uu[r] += xs[r][k] * b; } }
#pragma unroll
    for (int r = 0; r < 8; ++r) hs[r][tid] = gg[r] / (1.f + __expf(-gg[r])) * uu[r];
    __syncthreads();
    float y[8][4];
#pragma unroll
    for (int r = 0; r < 8; ++r) {
#pragma unroll
        for (int c = 0; c < 4; ++c) y[r][c] = 0.f; }
    for (int k = 0; k < ED; ++k) {
#pragma unroll
        for (int c = 0; c < 4; ++c) { float w = W2[(size_t)k * D + tid + 256 * c];
#pragma unroll
            for (int r = 0; r < 8; ++r) y[r][c] += hs[r][k] * w; } }
#pragma unroll
    for (int r = 0; r < 8; ++r) { int a = aid[r]; if (a < 0) continue;
        float wgt = (e < NE) ? ew[a] : 1.f; bf16* dst = (e < NE) ? ybuf + (size_t)a * D : ysh + (size_t)a * D;
#pragma unroll
        for (int c = 0; c < 4; ++c) dst[tid + 256 * c] = f2bf(y[r][c] * wgt); }
}
__global__ void k_final(const float* x1, const bf16* ybuf, const bf16* ysh, const float* mod, const float* fg, float* out) {
    int t = blockIdx.x, b = t / S, tid = threadIdx.x;
    __shared__ float red[256];
    float v[4]; float s = 0.f;
#pragma unroll
    for (int i = 0; i < 4; ++i) { int col = tid + 256 * i; float m = bf2f(ysh[(size_t)t * D + col]);
        for (int r = 0; r < 8; ++r) m += bf2f(ybuf[((size_t)t * 8 + r) * D + col]);
        v[i] = x1[(size_t)t * D + col] + mod[b * 6 * D + 5 * D + col] * m; s += v[i] * v[i]; }
    red[tid] = s; __syncthreads();
    for (int o = 128; o > 0; o >>= 1) { if (tid < o) red[tid] += red[tid + o]; __syncthreads(); }
    float rstd = rsqrtf(red[0] / D + EPS);
#pragma unroll
    for (int i = 0; i < 4; ++i) { int col = tid + 256 * i; out[(size_t)t * D + col] = v[i] * rstd * fg[col]; }
}

#define OPT_MASK 0xFF

#define LAS __attribute__((address_space(3)))
typedef short bf16x8 __attribute__((ext_vector_type(8)));
typedef float f32x16 __attribute__((ext_vector_type(16)));
typedef float f32x4 __attribute__((ext_vector_type(4)));
typedef unsigned u32x4 __attribute__((ext_vector_type(4)));
typedef unsigned u32x2 __attribute__((ext_vector_type(2)));

constexpr int NTHR = 512, NWAVE = 8;
constexpr int LDS_CTL_OFF = 147456;
constexpr int LDS_BYTES = LDS_CTL_OFF + 1024;
constexpr size_t C_BAR = 768 * 1024;

__device__ __forceinline__ unsigned cvt_pk(float lo, float hi) { unsigned r; asm("v_cvt_pk_bf16_f32 %0, %1, %2" : "=v"(r) : "v"(lo), "v"(hi)); return r; }
__device__ __forceinline__ float wave_sum(float v) {
#pragma unroll
    for (int o = 1; o < 64; o <<= 1) v += __shfl_xor(v, o);
    return v;
}
#define MFMA32(a, b, c) __builtin_amdgcn_mfma_f32_32x32x16_bf16((a), (b), (c), 0, 0, 0)

#define XB_TMO      128
#define XB_XCNT(j)  (256  + 64 * (j))
#define XB_XSUB(j)  (1280 + 64 * (j))
#define XB_XGEN(j)  (2304 + 64 * (j))
#define XB_TOP      3328
#define XB_TOPGEN   3392
#define XCD_BAR_WORDS 3456
#define XB_SPIN_CAP (1u << 22)
__device__ __forceinline__ unsigned xb_ld(unsigned* p)              { return __hip_atomic_load(p, __ATOMIC_RELAXED, __HIP_MEMORY_SCOPE_AGENT); }
__device__ __forceinline__ unsigned xb_add(unsigned* p, unsigned v) { return __hip_atomic_fetch_add(p, v, __ATOMIC_RELAXED, __HIP_MEMORY_SCOPE_AGENT); }
__device__ __forceinline__ unsigned xb_xcc_id() { return (unsigned)__builtin_amdgcn_s_getreg((3 << 11) | 20) & 0xFu; }
#define XB_SPIN(cond, bar) do { unsigned _sp = 0; while (cond) { __builtin_amdgcn_s_sleep(1); \
    if ((++_sp & 255u) == 0u) { if (xb_ld(&(bar)[XB_TMO])) break; if (_sp > XB_SPIN_CAP) { atomicAdd(&(bar)[XB_TMO], 1u); break; } } } } while (0)
struct XcdBarrier { unsigned* bar; unsigned x; volatile LAS unsigned* st; };
__device__ __forceinline__ XcdBarrier xcd_barrier_post(unsigned* bar, volatile LAS unsigned* st) {
    XcdBarrier b; b.bar = bar; b.x = xb_xcc_id(); b.st = st;
    if (threadIdx.x == 0) (void)xb_add(&bar[XB_XCNT(b.x)], 1u);
    return b;
}
__device__ __forceinline__ void xcd_barrier_complete(unsigned* bar, unsigned x, unsigned& nloc, unsigned& nx) {
    const unsigned G = gridDim.x * gridDim.y * gridDim.z;
    unsigned sum, cnt, mine, sp = 0u;
    for (;;) {
        sum = 0u; cnt = 0u; mine = 0u;
#pragma unroll
        for (unsigned j = 0; j < 16; ++j) { const unsigned c = xb_ld(&bar[XB_XCNT(j)]); sum += c; cnt += (c > 0u) ? 1u : 0u; mine = (j == x) ? c : mine; }
        if (sum == G) break;
        __builtin_amdgcn_s_sleep(1);
        if ((++sp & 255u) == 0u) { if (xb_ld(&bar[XB_TMO])) break; if (sp > XB_SPIN_CAP) { atomicAdd(&bar[XB_TMO], 1u); break; } }
    }
    nloc = mine > 0u ? mine : 1u; nx = cnt > 0u ? cnt : 1u;
}
__device__ __forceinline__ void xcd_barrier(const XcdBarrier& b) {
    asm volatile("s_waitcnt vmcnt(0)" ::: "memory");
    __syncthreads();
    if (threadIdx.x == 0) {
        unsigned* bar = b.bar;
        __builtin_amdgcn_s_waitcnt(0);
        unsigned nloc = b.st[0], nx = b.st[1];
        if (nloc == 0u) { xcd_barrier_complete(bar, b.x, nloc, nx); b.st[0] = nloc; b.st[1] = nx; }
        const unsigned old = xb_add(&bar[XB_XSUB(b.x)], 1u);
        const unsigned gen = old / nloc;
        if (old + 1u == (gen + 1u) * nloc) {
            __builtin_amdgcn_fence(__ATOMIC_RELEASE, "agent");
            asm volatile("s_waitcnt vmcnt(0)" ::: "memory");
            const unsigned og = xb_add(&bar[XB_TOP], 1u);
            const unsigned tg = og / nx;
            if (og + 1u == (tg + 1u) * nx) xb_add(&bar[XB_TOPGEN], 1u);
            else XB_SPIN(xb_ld(&bar[XB_TOPGEN]) == tg, bar);
            __builtin_amdgcn_fence(__ATOMIC_ACQUIRE, "agent");
            xb_add(&bar[XB_XGEN(b.x)], 1u);
            asm volatile("s_waitcnt vmcnt(0)" ::: "memory");
        } else {
            XB_SPIN(xb_ld(&bar[XB_XGEN(b.x)]) == gen, bar);
            __builtin_amdgcn_fence(__ATOMIC_ACQUIRE, "agent");
            asm volatile("s_waitcnt vmcnt(0)" ::: "memory");
        }
    }
    __syncthreads();
}

struct Args {
    const float *x, *c, *w_ada, *b_ada, *norm1_g, *w_in, *sinks, *rel_table, *out_norm_a, *out_norm_b, *w_out, *norm2_g, *w_router, *e_bias,
                *w1, *w3, *w2, *ws1, *ws3, *ws2, *final_g;
    float* out; unsigned char* ws; int ph_lo, ph_hi;
};

template <int RM, int RN, int WM, int WN, int KR, bool A_RES, bool SWAP, int PD = 2, int BMD = 0, int DBG = 0>
struct GemmCore {
    static constexpr bool BT = (BMD == 1), PUB = (BMD == 2), F8 = (BMD == 3);
    static constexpr int BM = 32 * RM * WM, BN = 32 * RN * WN;
    static constexpr int A_BYTES = BM * 64, B_BYTES = BN * 64, STAGE = (A_RES ? 0 : A_BYTES) + B_BYTES;
    static constexpr int NA = (BM * 4 + NTHR - 1) / NTHR;
    static constexpr int BTASKS = BT ? BN * 4 : F8 ? BN * 2 : (32 / KR) * (BN / 4), NBT = BTASKS / NTHR, NBR = (BT || F8) ? 1 : KR, F8TILE = BN * 32;
    static_assert(!PUB || KR == 8, "publishing needs 8 k-rows per task");
    static_assert(WM * WN == NWAVE && BTASKS % NTHR == 0 && (KR == 2 || KR == 4 || KR == 8), "GemmCore geometry");
    static constexpr int LDS_NEED = 2 * STAGE;

    template <class AF, class BF>
    static __device__ __forceinline__ void run(LAS unsigned char* lds, AF arow, BF bsrc, int ldb, int nk, f32x16 (&acc)[RM][RN], LAS unsigned char* ares, unsigned char* f8p = nullptr, float pscale = 1.f, int rot = 0) {
        run_h(lds, arow, bsrc, ldb, nk, acc, ares, [](int, f32x16 (&)[RM][RN]) {}, f8p, pscale, rot);
    }
    template <class AF, class BF, class HK>
    static __device__ __forceinline__ void run_h(LAS unsigned char* lds, AF arow, BF bsrc, int ldb, int nk, f32x16 (&acc)[RM][RN], LAS unsigned char* ares, HK hook, unsigned char* f8p = nullptr, float pscale = 1.f, int rot = 0) {
        int tid = threadIdx.x; asm volatile("" : "+v"(tid));
        const int lane = tid & 63, wave = __builtin_amdgcn_readfirstlane(tid >> 6);
        const int wm = wave / WN, wn = wave % WN, h = lane >> 5, l31 = lane & 31;
        const bf16* ap[NA]; int awo[NA]; bool aval[NA];
#pragma unroll
        for (int i = 0; i < NA; ++i) { const int p = tid + NTHR * i, row = (p >> 2) % BM, ch = p & 3; const bf16* rp = A_RES ? nullptr : arow(row);
            aval[i] = !A_RES && rp != nullptr && (NA * NTHR == BM * 4 || p < BM * 4); ap[i] = rp + ch * 8; awo[i] = row * 64 + ((ch ^ ((row >> 2) & 3)) << 4); }
        decltype(bsrc(0)) bp[NBT]; int bwo[NBT];
#pragma unroll
        for (int i = 0; i < NBT; ++i) { const int q = tid + NTHR * i;
            if constexpr (BT) { const int col = q >> 2, ch = q & 3; bp[i] = bsrc(col) + ch * 8; bwo[i] = col * 64 + ((ch ^ ((col >> 2) & 3)) << 4); }
            else if constexpr (F8) { bp[i] = nullptr; bwo[i] = 0; }
            else { const int cg = q % (BN / 4), kg = q / (BN / 4);
                bp[i] = bsrc(4 * cg) + (size_t)(KR * kg) * ldb;
                const int ch = (KR == 8) ? kg : (KR == 4) ? (kg >> 1) : (kg >> 2), hf = (KR == 8) ? 0 : (KR == 4) ? (kg & 1) * 8 : (kg & 3) * 4;
                bwo[i] = (4 * cg) * 64 + ((ch ^ (cg & 3)) << 4) + hf; } }
        const int swz = (l31 >> 2) & 3;
        const int xs0 = ((0 + h) ^ swz) << 4, xs1 = ((2 + h) ^ swz) << 4;
        const int aro = (wm * RM * 32 + l31) * 64, bro = (wn * RN * 32 + l31) * 64;
        constexpr int NSET = PD < 1 ? 1 : PD;
        u32x4 aregs[NSET][NA]; f32x4 bregs[NSET][NBT][NBR];
#pragma unroll
        for (int d = 0; d < NSET; ++d)
#pragma unroll
            for (int i = 0; i < NA; ++i) aregs[d][i] = (u32x4){0u, 0u, 0u, 0u};
        auto gload = [&](u32x4 (&areg)[NA], f32x4 (&breg)[NBT][NBR], int ks0) {
            const int ks = (ks0 + rot) & (nk - 1);
            if (!A_RES) {
#pragma unroll
                for (int i = 0; i < NA; ++i) if (aval[i]) areg[i] = *(const u32x4*)(ap[i] + (size_t)ks * 32);
            }
#pragma unroll
            for (int i = 0; i < NBT; ++i) {
                if (DBG & 8) continue;
                if constexpr (BT) breg[i][0] = *(const f32x4*)(bp[i] + (size_t)ks * 32);
                else if constexpr (F8) breg[i][0] = *(const f32x4*)(f8p + (size_t)ks * F8TILE + (size_t)(tid + NTHR * i) * 16);
                else {
#pragma unroll
                    for (int r = 0; r < KR; ++r) breg[i][r] = *(const f32x4*)(bp[i] + ((size_t)ks * 32 + r) * ldb); }
            }
        };
        constexpr int NSLOT = 2 * (RM <= RN ? RN : RM);
        constexpr int BITEMS = BT ? NBT : F8 ? NBT * 2 : NBT * 4, NITEM = (A_RES ? 0 : NA) + BITEMS;
        auto lwrite = [&](const u32x4 (&areg)[NA], const f32x4 (&breg)[NBT][NBR], int buf, int ks0, int slot) {
            const int ks = (ks0 + rot) & (nk - 1); (void)ks;
            LAS unsigned char* sb = lds + buf * STAGE;
            LAS unsigned char* bb = sb + (A_RES ? 0 : A_BYTES);
#pragma unroll
            for (int it = 0; it < NITEM; ++it) {
                if (slot >= 0 && (it % NSLOT) != slot) continue;
                if (!A_RES && it < NA) { const int i = it; if (NA * NTHR == BM * 4 || tid + NTHR * i < BM * 4) *(LAS u32x4*)(sb + awo[i]) = areg[i]; continue; }
                const int bi = it - (A_RES ? 0 : NA);
                if (DBG & 4) continue;
                if constexpr (BT) { *(LAS f32x4*)(bb + bwo[bi]) = breg[bi][0]; }
                else if constexpr (F8) {
                    const int i = bi >> 1, hf = bi & 1;
                    const int p = tid + NTHR * i, q = p >> 1, jp = p & 1, cg = q % (BN / 4), kg = q / (BN / 4), col = 4 * cg + 2 * jp + hf;
                    const u32x4 raw = __builtin_bit_cast(u32x4, breg[i][0]); unsigned o[4];
#pragma unroll
                    for (int d = 0; d < 2; ++d) { const auto lo = __builtin_amdgcn_cvt_pk_f32_fp8((int)raw[2 * hf + d], false), hi = __builtin_amdgcn_cvt_pk_f32_fp8((int)raw[2 * hf + d], true);
                        o[2 * d] = cvt_pk(lo[0], lo[1]); o[2 * d + 1] = cvt_pk(hi[0], hi[1]); }
                    *(LAS u32x4*)(bb + col * 64 + ((kg ^ (cg & 3)) << 4)) = (u32x4){o[0], o[1], o[2], o[3]};
                } else {
                    const int i = bi >> 2, j = bi & 3;
                    if (KR == 8) { u32x4 w; w.x = cvt_pk(breg[i][0][j], breg[i][1][j]); w.y = cvt_pk(breg[i][2][j], breg[i][3][j]); w.z = cvt_pk(breg[i][4][j], breg[i][5][j]); w.w = cvt_pk(breg[i][6][j], breg[i][7][j]);
                        *(LAS u32x4*)(bb + bwo[i] + j * 64) = w;
                        if constexpr (PUB) {
                            int p0 = __builtin_amdgcn_cvt_pk_fp8_f32(breg[i][0][j] * pscale, breg[i][1][j] * pscale, 0, false); p0 = __builtin_amdgcn_cvt_pk_fp8_f32(breg[i][2][j] * pscale, breg[i][3][j] * pscale, p0, true);
                            int p1 = __builtin_amdgcn_cvt_pk_fp8_f32(breg[i][4][j] * pscale, breg[i][5][j] * pscale, 0, false); p1 = __builtin_amdgcn_cvt_pk_fp8_f32(breg[i][6][j] * pscale, breg[i][7][j] * pscale, p1, true);
                            *(u32x2*)(f8p + (size_t)ks * F8TILE + (size_t)(tid + NTHR * i) * 32 + j * 8) = (u32x2){(unsigned)p0, (unsigned)p1}; } }
                    else if (KR == 4) { u32x2 w; w.x = cvt_pk(breg[i][0][j], breg[i][1][j]); w.y = cvt_pk(breg[i][2][j], breg[i][3][j]); *(LAS u32x2*)(bb + bwo[i] + j * 64) = w; }
                    else { *(LAS unsigned*)(bb + bwo[i] + j * 64) = cvt_pk(breg[i][0][j], breg[i][1][j]); }
                }
            }
        };
        auto step = [&](int ks0, int cur, const u32x4 (&aw)[NA], const f32x4 (&bw)[NBT][NBR], int wbuf, int wks, bool dowrite) {
            const int ks = (ks0 + rot) & (nk - 1);
            const LAS unsigned char* abase = A_RES ? (ares + ks * A_BYTES) : (lds + cur * STAGE);
            const LAS unsigned char* bbase = lds + cur * STAGE + (A_RES ? 0 : A_BYTES);
#pragma unroll
            for (int s = 0; s < 2; ++s) {
                const int xs = s ? xs1 : xs0;
                if constexpr (RM <= RN) {
                    bf16x8 af[RM];
                    if (!(DBG & 2)) {
#pragma unroll
                        for (int rb = 0; rb < RM; ++rb) af[rb] = *(const LAS bf16x8*)(abase + aro + rb * 2048 + xs); }
#pragma unroll
                    for (int cb = 0; cb < RN; ++cb) {
                        if (!(DBG & 2)) { const bf16x8 bfv = *(const LAS bf16x8*)(bbase + bro + cb * 2048 + xs);
#pragma unroll
                            for (int rb = 0; rb < RM; ++rb) { if (DBG & 1) { asm volatile("" :: "v"(bfv), "v"(af[rb])); } else acc[rb][cb] = SWAP ? MFMA32(bfv, af[rb], acc[rb][cb]) : MFMA32(af[rb], bfv, acc[rb][cb]); } }
                        if (dowrite) lwrite(aw, bw, wbuf, wks, s * RN + cb);
                    }
                } else {
                    bf16x8 bfv[RN];
                    if (!(DBG & 2)) {
#pragma unroll
                        for (int cb = 0; cb < RN; ++cb) bfv[cb] = *(const LAS bf16x8*)(bbase + bro + cb * 2048 + xs); }
#pragma unroll
                    for (int rb = 0; rb < RM; ++rb) {
                        if (!(DBG & 2)) { const bf16x8 af = *(const LAS bf16x8*)(abase + aro + rb * 2048 + xs);
#pragma unroll
                            for (int cb = 0; cb < RN; ++cb) acc[rb][cb] = SWAP ? MFMA32(bfv[cb], af, acc[rb][cb]) : MFMA32(af, bfv[cb], acc[rb][cb]); }
                        if (dowrite) lwrite(aw, bw, wbuf, wks, s * RM + rb);
                    }
                }
            }
        };
        if constexpr (PD >= 2) {
            static_assert(PD % 2 == 0, "PD even");
#pragma unroll
            for (int d = 0; d < PD; ++d) gload(aregs[d], bregs[d], d);
            lwrite(aregs[0], bregs[0], 0, 0, -1); __syncthreads();
#pragma unroll 1
            for (int ks0 = 0; ks0 < nk; ks0 += PD) {
#pragma unroll
                for (int d = 0; d < PD; ++d) {
                    const int ks = ks0 + d;
                    gload(aregs[d], bregs[d], min(ks + PD, nk - PD + d));
                    asm volatile("" ::: "memory");
                    if (d == 0) hook(ks, acc);
                    step(ks, d & 1, aregs[(d + 1) % PD], bregs[(d + 1) % PD], (d + 1) & 1, min(ks + 1, nk - 1), true);
                    __syncthreads();
                }
            }
            asm volatile("s_waitcnt vmcnt(0)" ::: "memory");
        } else {
            gload(aregs[0], bregs[0], 0); lwrite(aregs[0], bregs[0], 0, 0, -1); __syncthreads();
#pragma unroll 1
            for (int ks = 0; ks < nk; ++ks) {
                const int cur = ks & 1;
                if (ks + 1 < nk) gload(aregs[0], bregs[0], ks + 1);
                hook(ks, acc);
                step(ks, cur, aregs[0], bregs[0], 0, 0, false);
                if (ks + 1 < nk) lwrite(aregs[0], bregs[0], cur ^ 1, ks + 1, -1);
                __syncthreads();
            }
        }
    }
};
template <int RM, int RN> __device__ __forceinline__ void zero_acc(f32x16 (&acc)[RM][RN]) {
#pragma unroll
    for (int a = 0; a < RM; ++a)
#pragma unroll
        for (int b = 0; b < RN; ++b)
#pragma unroll
            for (int r = 0; r < 16; ++r) acc[a][b][r] = 0.f;
}
__device__ __forceinline__ int roff(int r, int h) { return (r & 3) + 8 * (r >> 2) + 4 * h; }

__device__ __forceinline__ void phase0(const Args& a, LAS unsigned char* lds, int vcu, int G) {
    const int tid = threadIdx.x, lane = tid & 63, wave = tid >> 6;
    float* mod = (float*)(a.ws + C_MOD); float* lut = (float*)(a.ws + WS_LUT);
    LAS float* sc = (LAS float*)lds;
    for (int i = tid; i < NB * D; i += NTHR) { float cv = a.c[i]; sc[i] = cv / (1.f + __expf(-cv)); }
    __syncthreads();
    LAS float* red = (LAS float*)(lds + 32768);
    for (int u = vcu; u < 192; u += G) {
        const int col = u * 32 + (lane & 31), rp = lane >> 5, k0 = wave * 128 + rp;
        float acc[NB];
#pragma unroll
        for (int b = 0; b < NB; ++b) acc[b] = 0.f;
#pragma unroll 16
        for (int i = 0; i < 64; ++i) { const float w = a.w_ada[(size_t)(k0 + 2 * i) * (6 * D) + col];
#pragma unroll
            for (int b = 0; b < NB; ++b) acc[b] += sc[b * D + k0 + 2 * i] * w; }
#pragma unroll
        for (int b = 0; b < NB; ++b) { acc[b] += __shfl_xor(acc[b], 32); if (rp == 0) red[(wave * NB + b) * 32 + lane] = acc[b]; }
        __syncthreads();
        if (tid < 256) { const int b = tid >> 5, c = tid & 31; float s = 0.f;
#pragma unroll
          for (int w = 0; w < NWAVE; ++w) s += red[(w * NB + b) * 32 + c];
          mod[b * 6 * D + u * 32 + c] = s + a.b_ada[u * 32 + c]; }
        __syncthreads();
    }
    {
        LAS float* scr = (LAS float*)(lds + 49152 + wave * 8448);
        constexpr int I_IN = 16 * (INC / 32), I_OUT = 16 * (D / 32), I_R = 16 * (NE / 32), I_S = 16 * (ED / 32), I_S2 = 4 * (D / 32), NIT = I_IN + I_OUT + I_R + 2 * I_S + I_S2;
        for (int it = vcu * NWAVE + wave; it < NIT; it += G * NWAVE) {
            const float* W; int N, KD = D, roff0 = 0; bf16* WT; int r = it;
            if (r < I_IN) { W = a.w_in; N = INC; WT = (bf16*)(a.ws + WS_WTIN); }
            else if ((r -= I_IN) < I_OUT) { W = a.w_out; N = D; WT = (bf16*)(a.ws + WS_WTOUT); }
            else if ((r -= I_OUT) < I_R) { W = a.w_router; N = NE; WT = (bf16*)(a.ws + WS_WTR); }
            else if ((r -= I_R) < I_S) { W = a.ws1; N = ED; WT = (bf16*)(a.ws + WS_WS13T); }
            else if ((r -= I_S) < I_S) { W = a.ws3; N = ED; WT = (bf16*)(a.ws + WS_WS13T); roff0 = ED; }
            else { r -= I_S; W = a.ws2; N = D; KD = ED; WT = (bf16*)(a.ws + WS_WS2T); }
            const int nblk = N / 32, kb = r / nblk, nb = r % nblk, k0 = 64 * kb, n0 = 32 * nb;
#pragma unroll 8
            for (int i = 0; i < 32; ++i) { const int kk = 2 * i + (lane >> 5); scr[kk * 33 + (lane & 31)] = W[(size_t)(k0 + kk) * N + n0 + (lane & 31)]; }
            asm volatile("s_waitcnt lgkmcnt(0)" ::: "memory");
            const int c = lane & 7;
#pragma unroll
            for (int j = 0; j < 4; ++j) { const int nn = (lane >> 3) + 8 * j; const LAS float* s = scr + (8 * c) * 33 + nn;
                u32x4 o; o.x = cvt_pk(s[0 * 33], s[1 * 33]); o.y = cvt_pk(s[2 * 33], s[3 * 33]); o.z = cvt_pk(s[4 * 33], s[5 * 33]); o.w = cvt_pk(s[6 * 33], s[7 * 33]);
                *(u32x4*)(WT + (size_t)(roff0 + n0 + nn) * KD + k0 + 8 * c) = o; }
            asm volatile("s_waitcnt lgkmcnt(0)" ::: "memory");
        }
    }
    for (int i = vcu * NTHR + tid; i < 16 * LUTN; i += G * NTHR) {
        const int hh = i / LUTN, p = i % LUTN, dist = p - LUT_NEG;
        float v = NEGBIG;
        const bool ok = dist >= 0 && (hh < 8 ? dist < 128 : dist < S);
        if (ok) v = a.rel_table[t5_bucket(dist) * 16 + hh] * LOG2E;
        lut[i] = v;
    }
}
__device__ __forceinline__ void norm_mod_row(const float* xr, const float* g, const float* sh, const float* scl, bf16* orow, int lane, unsigned char* o8 = nullptr) {
    f32x4 v[4]; float s = 0.f;
#pragma unroll
    for (int j = 0; j < 4; ++j) { v[j] = *(const f32x4*)(xr + j * 256 + lane * 4); s += (v[j].x * v[j].x + v[j].y * v[j].y) + (v[j].z * v[j].z + v[j].w * v[j].w); }
    const float rstd = rsqrtf(wave_sum(s) * (1.f / D) + EPS);
#pragma unroll
    for (int j = 0; j < 4; ++j) { const int c = j * 256 + lane * 4;
        const f32x4 gg = *(const f32x4*)(g + c), s1 = *(const f32x4*)(scl + c), s0 = *(const f32x4*)(sh + c);
        const float o0 = v[j].x * rstd * gg.x * (1.f + s1.x) + s0.x, o1 = v[j].y * rstd * gg.y * (1.f + s1.y) + s0.y;
        const float o2 = v[j].z * rstd * gg.z * (1.f + s1.z) + s0.z, o3 = v[j].w * rstd * gg.w * (1.f + s1.w) + s0.w;
        u32x2 w; w.x = cvt_pk(o0, o1); w.y = cvt_pk(o2, o3); *(u32x2*)(orow + c) = w;
        if (o8) { int p = __builtin_amdgcn_cvt_pk_fp8_f32(o0, o1, 0, false); p = __builtin_amdgcn_cvt_pk_fp8_f32(o2, o3, p, true); *(int*)(o8 + c) = p; } }
}
__device__ __forceinline__ void phase1(const Args& a, int vcu, int G) {
    const int lane = threadIdx.x & 63, gw = vcu * NWAVE + (threadIdx.x >> 6), NGW = G * NWAVE;
    const float* mod = (const float*)(a.ws + C_MOD); bf16* H = (bf16*)(a.ws + WS_H);
    for (int t = gw; t < NTOK; t += NGW) { const int b = t / S;
        norm_mod_row(a.x + (size_t)t * D, a.norm1_g, mod + b * 6 * D, mod + b * 6 * D + D, H + (size_t)t * D, lane); }
}
__device__ __forceinline__ void phase2(const Args& a, LAS unsigned char* lds, int vcu, int G) {
    typedef GemmCore<4, 2, 2, 4, 4, false, false, 2, 1> GC;
    const int lane = threadIdx.x & 63, wave = __builtin_amdgcn_readfirstlane(threadIdx.x >> 6), wm = wave / 4, wn = wave % 4, h = lane >> 5, l31 = lane & 31;
    const bf16* H = (const bf16*)(a.ws + WS_H); const bf16* WT = (const bf16*)(a.ws + WS_WTIN);
    bf16* QA = (bf16*)(a.ws + WS_QA); bf16* KA = (bf16*)(a.ws + WS_KA); bf16* VAT = (bf16*)(a.ws + WS_VAT);
    bf16* QB = (bf16*)(a.ws + WS_QB); bf16* KB = (bf16*)(a.ws + WS_KB); bf16* VBT = (bf16*)(a.ws + WS_VBT); float* ksum = (float*)(a.ws + C_KSUM);
    constexpr int NPM = NTOK / 256, NPN = INC / 256;
    for (int u = vcu; u < NPM * NPN; u += G) {
        const int pm = u / NPN, pn = u % NPN;
        f32x16 acc[4][2]; zero_acc(acc);
        const bf16* Ab = H + (size_t)pm * 256 * D; const bf16* Wb = WT + (size_t)pn * 256 * D;
        GC::run(lds, [&](int r) { return Ab + (size_t)r * D; }, [&](int c) { return Wb + (size_t)c * D; }, D, D / 32, acc, nullptr);
        const int b = (pm * 256) / S, s0 = (pm * 256) % S + wm * 128;
#pragma unroll
        for (int cb = 0; cb < 2; ++cb) {
            const int col = pn * 256 + wn * 64 + cb * 32 + l31;
            int kind, hh, d;
            bf16* base; int nh; bool isKB = false;
            if (col < 512)       { kind = 0; hh = col >> 6; d = col & 63; base = QA; nh = 8; }
            else if (col < 640)  { kind = 1; hh = (col - 512) >> 6; d = col & 63; base = KA; nh = 2; }
            else if (col < 768)  { kind = 2; hh = (col - 640) >> 6; d = col & 63; base = VAT; nh = 2; }
            else if (col < 1280) { kind = 0; hh = (col - 768) >> 6; d = col & 63; base = QB; nh = 8; }
            else if (col < 1792) { kind = 1; hh = (col - 1280) >> 6; d = col & 63; base = KB; nh = 8; isKB = true; }
            else                 { kind = 2; hh = (col - 1792) >> 6; d = col & 63; base = VBT; nh = 8; }
            if (kind == 2) {
                bf16* vp = base + ((size_t)(b * nh + hh) * 64 + d) * S + s0;
#pragma unroll
                for (int rb = 0; rb < 4; ++rb)
#pragma unroll
                    for (int g4 = 0; g4 < 4; ++g4) { u32x2 w; w.x = cvt_pk(acc[rb][cb][4 * g4], acc[rb][cb][4 * g4 + 1]); w.y = cvt_pk(acc[rb][cb][4 * g4 + 2], acc[rb][cb][4 * g4 + 3]);
                        *(u32x2*)(vp + rb * 32 + 8 * g4 + 4 * h) = w; }
            } else {
                const float sc = (kind == 0) ? QSCALE : 1.f;
                bf16* qp = base + ((size_t)(b * nh + hh) * S + s0) * 64 + d;
                float csum = 0.f;
#pragma unroll
                for (int rb = 0; rb < 4; ++rb)
#pragma unroll
                    for (int r = 0; r < 16; ++r) { const float v = acc[rb][cb][r]; csum += v; qp[(size_t)(rb * 32 + roff(r, h)) * 64] = f2bf(v * sc); }
                if (isKB) { csum += __shfl_xor(csum, 32); if (h == 0) atomicAdd(&ksum[((size_t)(b * 8 + hh) * 8 + (s0 >> 8)) * 64 + d], csum); }
            }
        }
    }
}
constexpr int KT_STRIDE = 144, VT_STRIDE = 528;
constexpr int AT_K_OFF = 0, AT_V_OFF = 256 * KT_STRIDE  , AT_LUT_OFF = AT_V_OFF + 64 * VT_STRIDE  , AT_KS_OFF = AT_LUT_OFF + 10240, AT_END = AT_KS_OFF + 2048;
struct AttnSt { f32x16 o0, o1; float m, l; };
__device__ __forceinline__ void attn_tile(const LAS unsigned char* lds, int kt, int lut_idx, const bf16x8 (&bq)[4], AttnSt& st, int lane) {
    const int i = lane & 31, hh = lane >> 5;
    const int kap = (i & 0x13) | ((i & 4) << 1) | ((i & 8) >> 1);
    const LAS unsigned char* kp = lds + AT_K_OFF + (kt * 32 + kap) * KT_STRIDE + 16 * hh;
    f32x16 p;
#pragma unroll
    for (int r = 0; r < 16; ++r) p[r] = 0.f;
#pragma unroll
    for (int s = 0; s < 4; ++s) { const bf16x8 kf = *(const LAS bf16x8*)(kp + 32 * s); p = MFMA32(kf, bq[s], p); }
    const LAS float* lp = (const LAS float*)(lds + AT_LUT_OFF) + lut_idx;
    float tmax = NEGBIG;
#pragma unroll
    for (int r = 0; r < 16; ++r) { p[r] += lp[23 - (16 * (r >> 3) + (r & 7))]; tmax = fmaxf(tmax, p[r]); }
    tmax = fmaxf(tmax, __shfl_xor(tmax, 32));
    const float mn = fmaxf(st.m, tmax), alpha = exp2f(st.m - mn);
    float ps = 0.f;
#pragma unroll
    for (int r = 0; r < 16; ++r) { p[r] = exp2f(p[r] - mn); ps += p[r]; }
    st.l = st.l * alpha + ps; st.m = mn;
#pragma unroll
    for (int r = 0; r < 16; ++r) { st.o0[r] *= alpha; st.o1[r] *= alpha; }
    bf16x8 pb[2];
#pragma unroll
    for (int s = 0; s < 2; ++s) { u32x4 w; w.x = cvt_pk(p[8 * s], p[8 * s + 1]); w.y = cvt_pk(p[8 * s + 2], p[8 * s + 3]); w.z = cvt_pk(p[8 * s + 4], p[8 * s + 5]); w.w = cvt_pk(p[8 * s + 6], p[8 * s + 7]);
        pb[s] = __builtin_bit_cast(bf16x8, w); }
    const LAS unsigned char* vp = lds + AT_V_OFF + i * VT_STRIDE + (kt * 32 + 8 * hh) * 2;
#pragma unroll
    for (int s = 0; s < 2; ++s) {
        const bf16x8 v0 = *(const LAS bf16x8*)(vp + 32 * s), v1 = *(const LAS bf16x8*)(vp + 32 * VT_STRIDE + 32 * s);
        st.o0 = MFMA32(v0, pb[s], st.o0); st.o1 = MFMA32(v1, pb[s], st.o1);
    }
}
__device__ __forceinline__ void attn_stage(LAS unsigned char* lds, const bf16* kg, const bf16* vtg, int tid) {
#pragma unroll
    for (int i = 0; i < 4; ++i) { const int p = tid + NTHR * i, key = p >> 3, c = p & 7;
        *(LAS u32x4*)(lds + AT_K_OFF + key * KT_STRIDE + c * 16) = *(const u32x4*)(kg + (size_t)key * 64 + c * 8); }
#pragma unroll
    for (int i = 0; i < 4; ++i) { const int p = tid + NTHR * i, d = p >> 5, c = p & 31;
        *(LAS u32x4*)(lds + AT_V_OFF + d * VT_STRIDE + c * 16) = *(const u32x4*)(vtg + (size_t)d * S + c * 8); }
}
__device__ __forceinline__ void attn_init(AttnSt& st) {
#pragma unroll
    for (int r = 0; r < 16; ++r) { st.o0[r] = 0.f; st.o1[r] = 0.f; }
    st.m = NEGBIG; st.l = 0.f;
}
__device__ __forceinline__ void attn_loadq(const bf16* qrow, bf16x8 (&bq)[4], int lane) {
    const int hh = lane >> 5;
#pragma unroll
    for (int s = 0; s < 4; ++s) bq[s] = *(const bf16x8*)(qrow + 16 * s + 8 * hh);
}
__device__ __forceinline__ void attn_finish(AttnSt& st, bool has_sink, float sink_l2, const float* gain, bf16* attrow, float* ssq_tok, int lane) {
    const int hh = lane >> 5;
    float l = st.l + __shfl_xor(st.l, 32), inv;
    if (has_sink) { const float mn = fmaxf(st.m, sink_l2), al = exp2f(st.m - mn); l = l * al + exp2f(sink_l2 - mn); inv = al / l; } else inv = 1.f / l;
    float sq = 0.f;
#pragma unroll
    for (int db = 0; db < 2; ++db)
#pragma unroll
        for (int g4 = 0; g4 < 4; ++g4) { const int d0 = db * 32 + 8 * g4 + 4 * hh; const f32x4 gg = *(const f32x4*)(gain + d0);
            const f32x16& o = db ? st.o1 : st.o0;
            const float v0 = o[4 * g4] * inv, v1 = o[4 * g4 + 1] * inv, v2 = o[4 * g4 + 2] * inv, v3 = o[4 * g4 + 3] * inv;
            sq += (v0 * v0 + v1 * v1) + (v2 * v2 + v3 * v3);
            u32x2 w; w.x = cvt_pk(v0 * gg.x, v1 * gg.y); w.y = cvt_pk(v2 * gg.z, v3 * gg.w); *(u32x2*)(attrow + d0) = w; }
    sq += __shfl_xor(sq, 32);
    if (hh == 0) *ssq_tok = sq;
}
__device__ __forceinline__ void phase3(const Args& a, LAS unsigned char* lds, int vcu, int G) {
    const int tid = threadIdx.x, lane = tid & 63, wave = __builtin_amdgcn_readfirstlane(tid >> 6), l31 = lane & 31, hh2 = lane >> 5;
    const bf16* QA = (const bf16*)(a.ws + WS_QA); const bf16* KA = (const bf16*)(a.ws + WS_KA); const bf16* VAT = (const bf16*)(a.ws + WS_VAT);
    const bf16* QB = (const bf16*)(a.ws + WS_QB); const bf16* KB = (const bf16*)(a.ws + WS_KB); const bf16* VBT = (const bf16*)(a.ws + WS_VBT);
    const float* ksum = (const float*)(a.ws + C_KSUM); const float* lut = (const float*)(a.ws + WS_LUT);
    bf16* ATT = (bf16*)(a.ws + WS_ATT); float* ssq = (float*)(a.ws + WS_SSQ);
    LAS float* lutl = (LAS float*)(lds + AT_LUT_OFF); LAS float* ksl = (LAS float*)(lds + AT_KS_OFF);
    for (int uu = vcu; uu < 256; uu += G) {
        const int bh = uu >> 2, b = bh >> 3, hd = bh & 7;
        for (int half = 0; half < 2; ++half) {
            const int qb = half ? (uu & 3) : 7 - (uu & 3);
            __syncthreads();
            for (int i = tid; i < LUTN; i += NTHR) lutl[i] = lut[(8 + hd) * LUTN + i];
            if (tid < 512) ksl[tid] = ksum[((size_t)bh * 8) * 64 + tid];
            const bf16* kbase = KB + (size_t)bh * S * 64; const bf16* vbase = VBT + (size_t)bh * 64 * S;
            attn_stage(lds, kbase + (size_t)qb * 256 * 64, vbase + qb * 256, tid);
            const int q0 = qb * 256 + wave * 32, qpos = q0 + l31;
            bf16x8 bq[4]; attn_loadq(QB + ((size_t)bh * S + qpos) * 64, bq, lane);
            __syncthreads();
            unsigned sel = 0;
            {
                float g[7];
#pragma unroll
                for (int j = 0; j < 7; ++j) { float s = 0.f;
#pragma unroll
                    for (int sI = 0; sI < 4; ++sI)
#pragma unroll
                        for (int e = 0; e < 8; ++e) s += bf2f((bf16)bq[sI][e]) * ksl[j * 64 + 16 * sI + 8 * hh2 + e];
                    s += __shfl_xor(s, 32); g[j] = (j < qb) ? s : -INFINITY; }
#pragma unroll
                for (int r = 0; r < 3; ++r) if (r < qb) { int best = 0; float bv = -INFINITY;
#pragma unroll
                    for (int j = 6; j >= 0; --j) if (j < qb && !((sel >> j) & 1u) && g[j] >= bv) { bv = g[j]; best = j; }
                    sel |= 1u << best; }
            }
            AttnSt st; attn_init(st);
            for (int kt = 0; kt <= wave; ++kt) attn_tile(lds, kt, LUT_NEG + qpos - (qb * 256 + kt * 32) - 8 * hh2 - 23, bq, st, lane);
            for (int j = 0; j < qb; ++j) {
                __syncthreads();
                attn_stage(lds, kbase + (size_t)j * 256 * 64, vbase + j * 256, tid);
                __syncthreads();
                const bool mine = (sel >> j) & 1u;
                if (__ballot(mine) != 0ull) {
                    for (int kt = 0; kt < 8; ++kt) { const int li = mine ? (LUT_NEG + qpos - (j * 256 + kt * 32) - 8 * hh2 - 23) : 64;
                        attn_tile(lds, kt, li, bq, st, lane); }
                }
            }
            const int t = b * S + qpos;
            attn_finish(st, false, 0.f, a.out_norm_b + hd * 64, ATT + (size_t)t * D + 512 + hd * 64, ssq + t * 16 + 8 + hd, lane);
        }
    }
    for (int u = vcu; u < 256; u += G) {
        const int b = u >> 5, kv = (u >> 4) & 1, n = u & 15;
        __syncthreads();
        for (int i = tid; i < 4 * 512; i += NTHR) { const int g = i >> 9, p = i & 511; lutl[i] = lut[(kv * 4 + g) * LUTN + p]; }
        const int kb0 = (n - 1) * 128, kld = kb0 < 0 ? 0 : kb0;
        attn_stage(lds, KA + ((size_t)(b * 2 + kv) * S + kld) * 64, VAT + (size_t)(b * 2 + kv) * 64 * S + kld, tid);
        __syncthreads();
        for (int ti = 0; ti < 2; ++ti) {
            const int tk = wave * 2 + ti, g = tk >> 2, jq = tk & 3, hd = kv * 4 + g;
            const int qpos = n * 128 + jq * 32 + l31, t = b * S + qpos;
            bf16x8 bq[4]; attn_loadq(QA + ((size_t)(b * 8 + hd) * S + qpos) * 64, bq, lane);
            AttnSt st; attn_init(st);
            if (n > 0) { for (int kt = jq + 4; kt >= jq; --kt) attn_tile(lds, kt, g * 512 + 256 + qpos - (kb0 + kt * 32) - 8 * hh2 - 23, bq, st, lane); }
            else { for (int kt = jq; kt >= 0; --kt) attn_tile(lds, kt, g * 512 + 256 + qpos - (kt * 32) - 8 * hh2 - 23, bq, st, lane); }
            attn_finish(st, true, a.sinks[hd] * LOG2E, a.out_norm_a + hd * 64, ATT + (size_t)t * D + hd * 64, ssq + t * 16 + hd, lane);
        }
    }
}
__device__ __forceinline__ void phase4(const Args& a, LAS unsigned char* lds, int vcu, int G) {
    typedef GemmCore<4, 2, 2, 4, 4, false, false, 2, 1> GC;
    const int tid = threadIdx.x, lane = tid & 63, wave = __builtin_amdgcn_readfirstlane(tid >> 6), wm = wave / 4, wn = wave % 4, h = lane >> 5, l31 = lane & 31;
    const bf16* ATT = (const bf16*)(a.ws + WS_ATT); const float* ssq = (const float*)(a.ws + WS_SSQ);
    const float* mod = (const float*)(a.ws + C_MOD); float* X1 = (float*)(a.ws + WS_X1);
    LAS float* rsc = (LAS float*)(lds + GC::LDS_NEED);
    for (int u = vcu; u < 64 * 4; u += G) {
        const int pm = u >> 2, pn = u & 3;
        __syncthreads();
        if (tid < 256) { const int t = pm * 256 + tid; const f32x4 q0 = *(const f32x4*)(ssq + t * 16), q1 = *(const f32x4*)(ssq + t * 16 + 4), q2 = *(const f32x4*)(ssq + t * 16 + 8), q3 = *(const f32x4*)(ssq + t * 16 + 12);
            const float sa = ((q0.x + q0.y) + (q0.z + q0.w)) + ((q1.x + q1.y) + (q1.z + q1.w)), sb = ((q2.x + q2.y) + (q2.z + q2.w)) + ((q3.x + q3.y) + (q3.z + q3.w));
            const float ra = rsqrtf(sa * (1.f / 512.f) + EPS), rb = rsqrtf(sb * (1.f / 512.f) + EPS); rsc[tid] = ra / rb; rsc[256 + tid] = rb; }
        f32x16 acc[4][2]; zero_acc(acc);
        const bf16* Ab = ATT + (size_t)pm * 256 * D; const bf16* Wb = (const bf16*)(a.ws + WS_WTOUT) + (size_t)pn * 256 * D;
        GC::run_h(lds, [&](int r) { return Ab + (size_t)r * D; }, [&](int c) { return Wb + (size_t)c * D; }, D, 32, acc, nullptr,
            [&](int ks, f32x16 (&ac)[4][2]) { if (ks == 16) {
#pragma unroll
                for (int rb = 0; rb < 4; ++rb)
#pragma unroll
                    for (int g4 = 0; g4 < 4; ++g4) { const f32x4 f = *(const LAS f32x4*)(rsc + wm * 128 + rb * 32 + 8 * g4 + 4 * h);
#pragma unroll
                        for (int e = 0; e < 4; ++e) { ac[rb][0][4 * g4 + e] *= f[e]; ac[rb][1][4 * g4 + e] *= f[e]; } } } });
        const int b = (pm * 256) / S;
#pragma unroll
        for (int cb = 0; cb < 2; ++cb) { const int col = pn * 256 + wn * 64 + cb * 32 + l31; const float g1 = mod[b * 6 * D + 2 * D + col];
#pragma unroll
            for (int rb = 0; rb < 4; ++rb)
#pragma unroll
                for (int g4 = 0; g4 < 4; ++g4) { const int lr = wm * 128 + rb * 32 + 8 * g4 + 4 * h;
                    size_t o4 = (size_t)(pm * 256 + lr) * D + col; asm volatile("" : "+v"(o4));
                    const f32x4 rv = *(const LAS f32x4*)(rsc + 256 + lr);
#pragma unroll
                    for (int e = 0; e < 4; ++e) X1[o4 + (size_t)e * D] = a.x[o4 + (size_t)e * D] + g1 * acc[rb][cb][4 * g4 + e] * rv[e]; } }
    }
}
__device__ __forceinline__ void phase5(const Args& a, LAS unsigned char* lds, int vcu, int G, bool dry = false) {
    typedef GemmCore<2, 1, 1, 8, 4, false, false, 4, 1> GC;
    const int tid = threadIdx.x, lane = tid & 63, wave = __builtin_amdgcn_readfirstlane(tid >> 6), h = lane >> 5, l31 = lane & 31;
    const float* X1 = (const float*)(a.ws + WS_X1); const float* mod = (const float*)(a.ws + C_MOD); bf16* H2 = (bf16*)(a.ws + WS_H2);
    int* cnt = (int*)(a.ws + C_CNT); int* list = (int*)(a.ws + WS_LIST); float* ew = (float*)(a.ws + WS_EW);
    LAS float* lg = (LAS float*)(lds + 65536);
    for (int u = vcu; u < NTOK / 64; u += G) {
        const int t0 = u * 64, b = t0 / S;
        for (int i = 0; i < 8; ++i) { const int t = t0 + wave * 8 + i;
            norm_mod_row(X1 + (size_t)t * D, a.norm2_g, mod + b * 6 * D + 3 * D, mod + b * 6 * D + 4 * D, H2 + (size_t)t * D, lane, a.ws + WS_X8 + (size_t)t * D); }
        asm volatile("s_waitcnt vmcnt(0)" ::: "memory");
        __syncthreads();
        f32x16 acc[2][1]; zero_acc(acc);
        const bf16* Ab = H2 + (size_t)t0 * D;
        const bf16* WR = (const bf16*)(a.ws + WS_WTR);
        GC::run(lds, [&](int r) { return Ab + (size_t)r * D; }, [&](int c) { return WR + (size_t)c * D; }, D, D / 32, acc, nullptr);
#pragma unroll
        for (int rb = 0; rb < 2; ++rb)
#pragma unroll
            for (int r = 0; r < 16; ++r) lg[(rb * 32 + roff(r, h)) * 256 + wave * 32 + l31] = acc[rb][0][r];
        __syncthreads();
        for (int i = 0; i < 8; ++i) {
            const int row = wave * 8 + i, t = t0 + row;
            const f32x4 lv = *(const LAS f32x4*)(lg + row * 256 + lane * 4); const f32x4 eb = *(const f32x4*)(a.e_bias + lane * 4);
            float sc[4], sl[4];
#pragma unroll
            for (int j = 0; j < 4; ++j) { sc[j] = 1.f / (1.f + __expf(-lv[j])); sl[j] = sc[j] + eb[j]; }
            float m1 = fmaxf(sl[0], sl[1]), m2 = fminf(sl[0], sl[1]);
            { const float c1 = fmaxf(sl[2], sl[3]), c2 = fminf(sl[2], sl[3]); const float n1 = fmaxf(m1, c1), n2 = fmaxf(fminf(m1, c1), fmaxf(m2, c2)); m1 = n1; m2 = n2; }
#pragma unroll
            for (int o = 1; o < 8; o <<= 1) { const float c1 = __shfl_xor(m1, o), c2 = __shfl_xor(m2, o); const float n1 = fmaxf(m1, c1), n2 = fmaxf(fminf(m1, c1), fmaxf(m2, c2)); m1 = n1; m2 = n2; }
            const float gs = m1 + m2; const int grp = lane >> 3;
            int rank = 0;
#pragma unroll
            for (int g2 = 0; g2 < 8; ++g2) { const float og = __shfl(gs, g2 * 8); rank += (og > gs || (og == gs && g2 < grp)) ? 1 : 0; }
            const bool gsel = rank < 4;
#pragma unroll
            for (int j = 0; j < 4; ++j) if (!gsel) sl[j] = -INFINITY;
            int myidx = 0; float mysc = 0.f, wsum = 0.f;
            for (int r = 0; r < TOPK; ++r) {
                float bv = sl[0]; int bi = 0;
#pragma unroll
                for (int j = 1; j < 4; ++j) if (sl[j] > bv) { bv = sl[j]; bi = j; }
                bi += lane * 4;
#pragma unroll
                for (int o = 1; o < 64; o <<= 1) { const float ov = __shfl_xor(bv, o); const int oi = __shfl_xor(bi, o); if (ov > bv || (ov == bv && oi < bi)) { bv = ov; bi = oi; } }
                const int j = bi & 3; const bool own = (bi >> 2) == lane;
                const float scj = (j == 0) ? sc[0] : (j == 1) ? sc[1] : (j == 2) ? sc[2] : sc[3];
                const float scw = __shfl(scj, bi >> 2);
                if (own) { if (j == 0) sl[0] = -INFINITY; else if (j == 1) sl[1] = -INFINITY; else if (j == 2) sl[2] = -INFINITY; else sl[3] = -INFINITY; }
                wsum += scw;
                if (lane == r) { myidx = bi; mysc = scw; }
            }
            if (lane < TOPK && !dry) { const int slot = atomicAdd(&cnt[myidx], 1); list[(size_t)myidx * NTOK + slot] = t * 8 + lane; ew[t * 8 + lane] = mysc / wsum * 2.5f; }
        }
        __syncthreads();
    }
}
constexpr int MOE_H_OFF = 81920;
__device__ __forceinline__ void phase6_old(const Args& a, LAS unsigned char* lds, int vcu, int G, const XcdBarrier rbar, const bool use_rbar) {
    typedef GemmCore<2, 4, 2, 4, 8, false, true, 2> G1;
    typedef GemmCore<2, 4, 2, 4, 8, true, true, 2> G2;
    static_assert(G1::LDS_NEED <= MOE_H_OFF && MOE_H_OFF + 8 * 8192 <= LDS_CTL_OFF, "MoE LDS map");
    const int tid = threadIdx.x, lane = tid & 63, wave = __builtin_amdgcn_readfirstlane(tid >> 6), wm = wave / 4, wn = wave % 4, h = lane >> 5, l31 = lane & 31;
    const bf16* H2 = (const bf16*)(a.ws + WS_H2); const int* cnt = (const int*)(a.ws + C_CNT); const int* list = (const int*)(a.ws + WS_LIST); const float* ew = (const float*)(a.ws + WS_EW);
    bf16* YBUF = (bf16*)(a.ws + WS_YBUF); bf16* YSH = (bf16*)(a.ws + WS_YSH);
    LAS int* pf = (LAS int*)(lds + 0);
    __syncthreads();
    if (tid < NE) pf[tid + 1] = (cnt[tid] + 127) >> 7;
    if (tid == 0) pf[0] = 0;
    __syncthreads();
    if (tid == 0) { int s = 0; for (int e = 0; e < NE; ++e) { s += pf[e + 1]; pf[e + 1] = s; } }
    __syncthreads();
    const int R = pf[NE];
    const int NSH = NTOK / 128;
    LAS int* myu = (LAS int*)(lds + LDS_CTL_OFF + 256);
    const int total = NSH + R;
    int nmy = 0;
    for (int u = vcu; u < total; u += G) ++nmy;
    if (nmy > 16) nmy = 16;
    if (tid < nmy) { const int u = vcu + tid * G; int e, ci;
        if (u < NSH) { e = NE; ci = u; }
        else { const int ru = u - NSH; int lo = 0, hi = NE - 1; while (lo < hi) { const int mid = (lo + hi) >> 1; if (pf[mid + 1] > ru) hi = mid; else lo = mid + 1; } e = lo; ci = ru - pf[lo]; }
        myu[tid] = e; myu[16 + tid] = ci; }
    __syncthreads();
    LAS int* rowa = (LAS int*)(lds + LDS_CTL_OFF + 384);
    const int nrounds = (total + G - 1) / G;
    for (int iu = 0; iu < nrounds; ++iu) {
        if (use_rbar && iu > 0) xcd_barrier(rbar);
        if (iu >= nmy) continue;
        const int e = myu[iu], ci = myu[16 + iu];
        const int n = (e < NE) ? min(128, cnt[e] - ci * 128) : 128;
        const float* W1 = (e < NE) ? a.w1 + (size_t)e * D * ED : a.ws1; const float* W3 = (e < NE) ? a.w3 + (size_t)e * D * ED : a.ws3; const float* W2 = (e < NE) ? a.w2 + (size_t)e * ED * D : a.ws2;
        __syncthreads();
        if (tid < 128) rowa[tid] = (tid < n) ? ((e < NE) ? list[(size_t)e * NTOK + ci * 128 + tid] : ci * 128 + tid) : -1;
        __syncthreads();
        f32x16 acc[2][4]; zero_acc(acc);
        G1::run(lds, [&](int r) { const int aid = rowa[r]; const int tok = (e < NE) ? (aid >> 3) : aid; return (aid < 0) ? (const bf16*)nullptr : (H2 + (size_t)tok * D); },
                [&](int c) { const int w4 = c >> 7, within = c & 127; return (within < 64) ? (W1 + 64 * w4 + within) : (W3 + 64 * w4 + within - 64); }, ED, D / 32, acc, nullptr);
        {
#pragma unroll
            for (int rb = 0; rb < 2; ++rb) { const int row = wm * 64 + rb * 32 + l31;
#pragma unroll
                for (int cb = 0; cb < 2; ++cb)
#pragma unroll
                    for (int g4 = 0; g4 < 4; ++g4) { float hv[4];
#pragma unroll
                        for (int e4 = 0; e4 < 4; ++e4) { const float gt = acc[rb][cb][4 * g4 + e4], up = acc[rb][cb + 2][4 * g4 + e4]; hv[e4] = gt / (1.f + __expf(-gt)) * up; }
                        u32x2 w; w.x = cvt_pk(hv[0], hv[1]); w.y = cvt_pk(hv[2], hv[3]);
                        const int ks2 = 2 * wn + cb;
                        *(LAS u32x2*)(lds + MOE_H_OFF + ks2 * 8192 + row * 64 + ((g4 ^ ((row >> 2) & 3)) << 4) + 8 * h) = w; } }
        }
        __syncthreads();
        const int aid0 = rowa[wm * 64 + l31], aid1 = rowa[wm * 64 + 32 + l31];
        for (int nh = 0; nh < 2; ++nh) {
            zero_acc(acc);
            G2::run(lds, [&](int) { return (const bf16*)nullptr; }, [&](int c) { return W2 + nh * 512 + c; }, D, ED / 32, acc, lds + MOE_H_OFF);
#pragma unroll
            for (int rb = 0; rb < 2; ++rb) { const int aid = rb ? aid1 : aid0; if (aid < 0) continue;
                const float wgt = (e < NE) ? ew[aid] : 1.f; bf16* dst = ((e < NE) ? YBUF : YSH) + (size_t)aid * D + nh * 512 + wn * 128;
#pragma unroll
                for (int cb = 0; cb < 4; ++cb)
#pragma unroll
                    for (int g4 = 0; g4 < 4; ++g4) { u32x2 w; w.x = cvt_pk(acc[rb][cb][4 * g4] * wgt, acc[rb][cb][4 * g4 + 1] * wgt); w.y = cvt_pk(acc[rb][cb][4 * g4 + 2] * wgt, acc[rb][cb][4 * g4 + 3] * wgt);
                        *(u32x2*)(dst + cb * 32 + 8 * g4 + 4 * h) = w; } }
        }
    }
}
constexpr int MOE_TOK_OFF = 32768, MOE_AID_OFF = MOE_TOK_OFF + 4096, MOE_W_OFF = MOE_AID_OFF + 4096;
template <int NRB, int NCB>
__device__ __forceinline__ void moe_unit(LAS unsigned char* lds, const bf16* H2, const float* W1, const float* W3, const float* W2, bf16* hb, bf16* ybase, const int nrb) {
    constexpr int COLS = NCB * 32, HU = COLS / 2, TASKS = 4 * (COLS / 4), NG = NTHR / TASKS;
    constexpr int P1 = 256 / HU, T1 = P1 * 32, P2 = 1024 / COLS, T2 = P2 * 8, T = T1 + T2, SLOT = COLS * 64;
    static_assert(NG >= 2 && (NG & (NG - 1)) == 0 && T1 % 2 == 0, "moe_unit geometry");
    const int tid = threadIdx.x, lane = tid & 63, wave = __builtin_amdgcn_readfirstlane(tid >> 6), h = lane >> 5, l31 = lane & 31;
    const int grp = __builtin_amdgcn_readfirstlane(tid / TASKS), q = tid % TASKS, cg = q % (COLS / 4), kg = q / (COLS / 4), c0 = 4 * cg;
    const LAS int* r_tok = (const LAS int*)(lds + MOE_TOK_OFF); const LAS int* r_aid = (const LAS int*)(lds + MOE_AID_OFF); const LAS float* r_w = (const LAS float*)(lds + MOE_W_OFF);
    int xoff[NRB];
#pragma unroll
    for (int rb = 0; rb < NRB; ++rb) { const int row = (rb * 8 + wave) * 32 + l31; xoff[rb] = r_tok[row] * D + 16 * h; }
    const int hoff0 = (wave * 32 + l31) * ED;
    f32x16 acc[NRB][NCB]; zero_acc(acc);
    f32x4 wreg[8];
    bf16x8 xa[NRB][2], xb[NRB][2];
    const int wwo = c0 * 64 + ((kg ^ (cg & 3)) << 4);
    const int swz = (l31 >> 2) & 3, rs0 = l31 * 64 + (((2 * h) ^ swz) << 4), rs1 = l31 * 64 + (((2 * h + 1) ^ swz) << 4);
    auto issue_w = [&](int tt) {
        const float* p; int ld;
        if (tt < T1) { const int ps = tt >> 5, ks = tt & 31; ld = ED; p = ((c0 < HU) ? (W1 + ps * HU + c0) : (W3 + ps * HU + (c0 - HU))) + (size_t)(32 * ks + 8 * kg) * ED; }
        else { const int t2 = tt - T1, qs = t2 >> 3, ks = t2 & 7; ld = D; p = W2 + qs * COLS + c0 + (size_t)(32 * ks + 8 * kg) * D; }
#pragma unroll
        for (int i = 0; i < 8; ++i) wreg[i] = *(const f32x4*)(p + (size_t)i * ld);
    };
    auto write_w = [&](int tt) {
        LAS unsigned char* sb = lds + (tt & 1) * SLOT + wwo;
#pragma unroll
        for (int j = 0; j < 4; ++j) { u32x4 w; w.x = cvt_pk(wreg[0][j], wreg[1][j]); w.y = cvt_pk(wreg[2][j], wreg[3][j]); w.z = cvt_pk(wreg[4][j], wreg[5][j]); w.w = cvt_pk(wreg[6][j], wreg[7][j]);
            *(LAS u32x4*)(sb + j * 64) = w; }
    };
    auto load_x = [&](bf16x8 (&x)[NRB][2], int tt) {
#pragma unroll
        for (int rb = 0; rb < NRB; ++rb) if (rb < nrb) {
            const bf16* p = (tt < T1) ? (H2 + xoff[rb] + 32 * (tt & 31)) : (hb + hoff0 + rb * (256 * ED) + 16 * h + 32 * ((tt - T1) & 7));
            x[rb][0] = *(const bf16x8*)p; x[rb][1] = *(const bf16x8*)(p + 8); }
    };
    auto compute = [&](const bf16x8 (&x)[NRB][2], int tt) {
        const LAS unsigned char* base = lds + (tt & 1) * SLOT;
#pragma unroll
        for (int s = 0; s < 2; ++s) {
#pragma unroll
            for (int cb = 0; cb < NCB; ++cb) { const bf16x8 wf = *(const LAS bf16x8*)(base + cb * 2048 + (s ? rs1 : rs0));
#pragma unroll
                for (int rb = 0; rb < NRB; ++rb) if (rb < nrb) acc[rb][cb] = MFMA32(wf, x[rb][s], acc[rb][cb]); }
        }
    };
    auto epi1 = [&](int ps) {
#pragma unroll
        for (int rb = 0; rb < NRB; ++rb) if (rb < nrb) {
#pragma unroll
            for (int cb = 0; cb < NCB / 2; ++cb)
#pragma unroll
                for (int g4 = 0; g4 < 4; ++g4) { float hv[4];
#pragma unroll
                    for (int e4 = 0; e4 < 4; ++e4) { const float gt = acc[rb][cb][4 * g4 + e4], up = acc[rb][cb + NCB / 2][4 * g4 + e4]; hv[e4] = gt / (1.f + __expf(-gt)) * up; }
                    u32x2 w; w.x = cvt_pk(hv[0], hv[1]); w.y = cvt_pk(hv[2], hv[3]);
                    *(u32x2*)(hb + hoff0 + rb * (256 * ED) + ps * HU + cb * 32 + 8 * g4 + 4 * h) = w; } }
    };
    auto epi2 = [&](int qs) {
#pragma unroll
        for (int rb = 0; rb < NRB; ++rb) if (rb < nrb) { const int row = (rb * 8 + wave) * 32 + l31; const int aid = r_aid[row]; if (aid < 0) continue;
            bf16* dst = ybase + (size_t)aid * D + qs * COLS + 4 * h; const float wg = r_w[row];
#pragma unroll
            for (int cb = 0; cb < NCB; ++cb)
#pragma unroll
                for (int g4 = 0; g4 < 4; ++g4) { u32x2 w; w.x = cvt_pk(acc[rb][cb][4 * g4] * wg, acc[rb][cb][4 * g4 + 1] * wg); w.y = cvt_pk(acc[rb][cb][4 * g4 + 2] * wg, acc[rb][cb][4 * g4 + 3] * wg);
                    *(u32x2*)(dst + cb * 32 + 8 * g4) = w; } }
    };
    issue_w(grp);
    load_x(xa, 0);
    if (grp == 0) write_w(0);
    __syncthreads();
    int t = 0;
    auto two_steps = [&](bool last_of_stage1) {
        if ((t & (NG - 1)) == grp && t + NG < T) issue_w(t + NG);
        load_x(xb, t + 1);
        compute(xa, t);
        if (((t + 1) & (NG - 1)) == grp) write_w(t + 1);
        __syncthreads();
        const int t1 = t + 1;
        if ((t1 & (NG - 1)) == grp && t1 + NG < T) issue_w(t1 + NG);
        if (t1 + 1 < T && !last_of_stage1) load_x(xa, t1 + 1);
        compute(xb, t1);
        if (((t1 + 1) & (NG - 1)) == grp && t1 + 1 < T) write_w(t1 + 1);
        __syncthreads();
        t += 2;
    };
#pragma unroll 1
    for (int ps = 0; ps < P1; ++ps) {
#pragma unroll 1
        for (int k2 = 0; k2 < 16; ++k2) two_steps(ps == P1 - 1 && k2 == 15);
        epi1(ps); zero_acc(acc);
    }
    asm volatile("s_waitcnt vmcnt(0)" ::: "memory");
    load_x(xa, T1);
#pragma unroll 1
    for (int qs = 0; qs < P2; ++qs) {
#pragma unroll 1
        for (int k2 = 0; k2 < 4; ++k2) two_steps(false);
        epi2(qs); zero_acc(acc);
    }
}
__device__ __forceinline__ void phase6_v2(const Args& a, LAS unsigned char* lds, int vcu, int G) {
    const int tid = threadIdx.x;
    const bf16* H2 = (const bf16*)(a.ws + WS_H2); const int* cnt = (const int*)(a.ws + C_CNT); const int* list = (const int*)(a.ws + WS_LIST); const float* ew = (const float*)(a.ws + WS_EW);
    bf16* YBUF = (bf16*)(a.ws + WS_YBUF); bf16* YSH = (bf16*)(a.ws + WS_YSH); int* qhead = (int*)(a.ws + C_QHEAD);
    bf16* hb = (bf16*)(a.ws + WS_HB) + (size_t)(vcu & 255) * 768 * ED;
    LAS int* r_tok = (LAS int*)(lds + MOE_TOK_OFF); LAS int* r_aid = (LAS int*)(lds + MOE_AID_OFF); LAS float* r_w = (LAS float*)(lds + MOE_W_OFF);
    volatile LAS int* qslot = (volatile LAS int*)(lds + LDS_CTL_OFF + 256);
    int e = vcu;
    bool routed = e < NE;
    for (;;) {
        int n, r0 = 0, sh_c = 0;
        if (routed) n = cnt[e];
        else { __syncthreads(); if (tid == 0) *qslot = atomicAdd(qhead, 1); __syncthreads(); sh_c = *qslot; if (sh_c >= NTOK / 256) break; n = 256; }
        const float* W1 = routed ? a.w1 + (size_t)e * D * ED : a.ws1; const float* W3 = routed ? a.w3 + (size_t)e * D * ED : a.ws3; const float* W2 = routed ? a.w2 + (size_t)e * ED * D : a.ws2;
        for (; r0 < n; r0 += 768) {
            const int ns = min(768, n - r0);
            __syncthreads();
            for (int i = tid; i < 768; i += NTHR) { int tok = 0, aid = -1; float w = 0.f;
                if (i < ns) { if (routed) { aid = list[(size_t)e * NTOK + r0 + i]; tok = aid >> 3; w = ew[aid]; } else { tok = sh_c * 256 + i; aid = tok; w = 1.f; } }
                r_tok[i] = tok; r_aid[i] = aid; r_w[i] = w; }
            if (tid == 0) { __builtin_amdgcn_fence(__ATOMIC_ACQUIRE, "agent"); asm volatile("s_waitcnt vmcnt(0)" ::: "memory"); }
            __syncthreads();
            if (ns > 512) moe_unit<3, 2>(lds, H2, W1, W3, W2, hb, routed ? YBUF : YSH, 3);
            else moe_unit<2, 4>(lds, H2, W1, W3, W2, hb, routed ? YBUF : YSH, ns > 256 ? 2 : 1);
        }
        if (routed) { e += G; routed = e < NE; }
    }
}
constexpr int M3_TAB = 81920;
constexpr int M3_ROWS = 1536;
template <int PF>
__device__ __forceinline__ void phase6(const Args& a, LAS unsigned char* lds, int vcu, int G) {
    const int tid = threadIdx.x, lane = tid & 63, wave = __builtin_amdgcn_readfirstlane(tid >> 6), h = lane >> 5, l31 = lane & 31;
    const bf16* H2 = (const bf16*)(a.ws + WS_H2); const int* cnt = (const int*)(a.ws + C_CNT); const int* list = (const int*)(a.ws + WS_LIST); const float* ew = (const float*)(a.ws + WS_EW);
    bf16* YBUF = (bf16*)(a.ws + WS_YBUF); bf16* YSH = (bf16*)(a.ws + WS_YSH);
    {
        typedef GemmCore<2, 2, 1, 8, 4, false, true, 2, 1> S1;
        typedef GemmCore<2, 2, 1, 8, 4, true, true, 2, 1> S2;
        constexpr int HOFF = S1::LDS_NEED;
        static_assert(HOFF + 8 * 4096 <= LDS_CTL_OFF, "shared-expert LDS map");
        const bf16* W13 = (const bf16*)(a.ws + WS_WS13T); const bf16* W2T = (const bf16*)(a.ws + WS_WS2T);
        if (!(PF & 1)) for (int su = vcu; su < NTOK / 64; su += G) {
            const int t0 = su * 64;
            f32x16 acc[2][2]; zero_acc(acc);
            __syncthreads();
            S1::run(lds, [&](int r) { return H2 + (size_t)(t0 + r) * D; },
                    [&](int c) { const int w8 = c >> 6, within = c & 63; return W13 + (size_t)((within < 32) ? (32 * w8 + within) : (ED + 32 * w8 + within - 32)) * D; }, D, D / 32, acc, nullptr);
#pragma unroll
            for (int rb = 0; rb < 2; ++rb) { const int row = rb * 32 + l31;
#pragma unroll
                for (int g4 = 0; g4 < 4; ++g4) { float hv[4];
#pragma unroll
                    for (int e4 = 0; e4 < 4; ++e4) { const float gt = acc[rb][0][4 * g4 + e4], up = acc[rb][1][4 * g4 + e4]; hv[e4] = gt / (1.f + __expf(-gt)) * up; }
                    u32x2 w; w.x = cvt_pk(hv[0], hv[1]); w.y = cvt_pk(hv[2], hv[3]);
                    *(LAS u32x2*)(lds + HOFF + wave * 4096 + row * 64 + ((g4 ^ ((row >> 2) & 3)) << 4) + 8 * h) = w; } }
            __syncthreads();
            for (int nh = 0; nh < 2; ++nh) {
                zero_acc(acc);
                S2::run(lds, [&](int) { return (const bf16*)nullptr; }, [&](int c) { return W2T + (size_t)(nh * 512 + c) * ED; }, ED, ED / 32, acc, lds + HOFF);
#pragma unroll
                for (int rb = 0; rb < 2; ++rb) { bf16* dst = YSH + (size_t)(t0 + rb * 32 + l31) * D + nh * 512 + wave * 64 + 4 * h;
#pragma unroll
                    for (int cb = 0; cb < 2; ++cb)
#pragma unroll
                        for (int g4 = 0; g4 < 4; ++g4) { u32x2 w; w.x = cvt_pk(acc[rb][cb][4 * g4], acc[rb][cb][4 * g4 + 1]); w.y = cvt_pk(acc[rb][cb][4 * g4 + 2], acc[rb][cb][4 * g4 + 3]);
                            *(u32x2*)(dst + cb * 32 + 8 * g4) = w; } }
            }
        }
    }
    typedef GemmCore<2, 4, 8, 1, 2, false, true, 2, 0> GE;
    static_assert(GE::LDS_NEED <= M3_TAB && M3_TAB + 3 * M3_ROWS * 4 <= LDS_CTL_OFF, "expert LDS map");
    LAS int* r_tok = (LAS int*)(lds + M3_TAB); LAS int* r_aid = r_tok + M3_ROWS; LAS float* r_w = (LAS float*)(r_aid + M3_ROWS);
    bf16* hb = (bf16*)(a.ws + WS_HB) + (size_t)(vcu & 255) * M3_ROWS * ED;
    for (int e = vcu; e < NE; e += G) {
        const int n = cnt[e];
        const float* W1 = a.w1 + (size_t)e * D * ED; const float* W3 = a.w3 + (size_t)e * D * ED; const float* W2 = a.w2 + (size_t)e * ED * D;
        for (int sg0 = 0; sg0 < n; sg0 += M3_ROWS) {
            const int ns = (PF & 16) ? min(512, n - sg0) : min(M3_ROWS, n - sg0), nrg = (ns + 511) >> 9;
            __syncthreads();
            for (int i = tid; i < nrg * 512; i += NTHR) { int tok = 0, aid = -1; float w = 0.f;
                if (i < ns) { aid = list[(size_t)e * NTOK + sg0 + i]; tok = (PF & 8) ? ((e * 64 + i) & (NTOK - 1)) : (aid >> 3); w = ew[aid]; }
                r_tok[i] = tok; r_aid[i] = aid; r_w[i] = w; }
            __syncthreads();
            if (!(PF & 4)) for (int p = 0; p < 4; ++p)
                for (int rg = 0; rg < nrg; ++rg) {
                    f32x16 acc[2][4]; zero_acc(acc);
                    GE::run(lds, [&](int r) { return (r_aid[rg * 512 + r] < 0) ? (const bf16*)nullptr : (H2 + (size_t)r_tok[rg * 512 + r] * D); },
                            [&](int c) { return (c < 64) ? (W1 + 64 * p + c) : (W3 + 64 * p + c - 64); }, ED, D / 32, acc, nullptr);
#pragma unroll
                    for (int rb = 0; rb < 2; ++rb) { bf16* hrow = hb + (size_t)(rg * 512 + wave * 64 + rb * 32 + l31) * ED + 64 * p + 4 * h;
#pragma unroll
                        for (int cb = 0; cb < 2; ++cb)
#pragma unroll
                            for (int g4 = 0; g4 < 4; ++g4) { float hv[4];
#pragma unroll
                                for (int e4 = 0; e4 < 4; ++e4) { const float gt = acc[rb][cb][4 * g4 + e4], up = acc[rb][cb + 2][4 * g4 + e4]; hv[e4] = gt / (1.f + __expf(-gt)) * up; }
                                u32x2 w; w.x = cvt_pk(hv[0], hv[1]); w.y = cvt_pk(hv[2], hv[3]);
                                *(u32x2*)(hrow + cb * 32 + 8 * g4) = w; } }
                }
            asm volatile("s_waitcnt vmcnt(0)" ::: "memory");
            __syncthreads();
            if (tid == 0) { __builtin_amdgcn_fence(__ATOMIC_ACQUIRE, "agent"); asm volatile("s_waitcnt vmcnt(0)" ::: "memory"); }
            __syncthreads();
            if (!(PF & 2)) for (int qs = 0; qs < 8; ++qs)
                for (int rg = 0; rg < nrg; ++rg) {
                    f32x16 acc[2][4]; zero_acc(acc);
                    GE::run(lds, [&](int r) { return (r_aid[rg * 512 + r] < 0) ? (const bf16*)nullptr : (hb + (size_t)(rg * 512 + r) * ED); }, [&](int c) { return W2 + 128 * qs + c; }, D, ED / 32, acc, nullptr);
#pragma unroll
                    for (int rb = 0; rb < 2; ++rb) { const int row = rg * 512 + wave * 64 + rb * 32 + l31; const int aid = r_aid[row]; if (aid < 0) continue;
                        const float wg = r_w[row]; bf16* dst = YBUF + (size_t)aid * D + 128 * qs + 4 * h;
#pragma unroll
                        for (int cb = 0; cb < 4; ++cb)
#pragma unroll
                            for (int g4 = 0; g4 < 4; ++g4) { u32x2 w; w.x = cvt_pk(acc[rb][cb][4 * g4] * wg, acc[rb][cb][4 * g4 + 1] * wg); w.y = cvt_pk(acc[rb][cb][4 * g4 + 2] * wg, acc[rb][cb][4 * g4 + 3] * wg);
                                *(u32x2*)(dst + cb * 32 + 8 * g4) = w; } }
                }
        }
    }
}
constexpr int F8_TILE = 16384, F8_EXP_BYTES = 48 * F8_TILE;
constexpr float F8_S1 = 64.f, F8_S2 = 32.f;
template <int BMD, int SKIP = 0, int DBG = 0>
__device__ __forceinline__ void moe_chunk(const Args& a, LAS unsigned char* lds, int e, int ci) {
    constexpr int PDX = (BMD == 2) ? 1 : 4;
    typedef GemmCore<2, 4, 2, 4, 8, false, true, PDX, BMD, DBG> G1;
    typedef GemmCore<2, 4, 2, 4, 8, true, true, PDX, BMD> G2;
    static_assert(G1::LDS_NEED <= MOE_H_OFF && MOE_H_OFF + 8 * 8192 <= LDS_CTL_OFF, "MoE LDS map");
    const int tid = threadIdx.x, lane = tid & 63, wave = __builtin_amdgcn_readfirstlane(tid >> 6), wm = wave / 4, wn = wave % 4, h = lane >> 5, l31 = lane & 31;
    const bf16* H2 = (const bf16*)(a.ws + WS_H2); const int* cnt = (const int*)(a.ws + C_CNT); const int* list = (const int*)(a.ws + WS_LIST); const float* ew = (const float*)(a.ws + WS_EW);
    bf16* YBUF = (bf16*)(a.ws + WS_YBUF);
    LAS int* rowa = (LAS int*)(lds + LDS_CTL_OFF + 384);
    const int n = min(128, cnt[e] - ci * 128);
    const float* W1 = a.w1 + (size_t)e * D * ED; const float* W3 = a.w3 + (size_t)e * D * ED; const float* W2 = a.w2 + (size_t)e * ED * D;
    unsigned char* f8 = a.ws + WS_HB + (size_t)e * F8_EXP_BYTES;
    const float s1 = (BMD == 3) ? 1.f / F8_S1 : 1.f, s2 = (BMD == 3) ? 1.f / F8_S2 : 1.f;
    __syncthreads();
    if (tid < 128) rowa[tid] = (tid < n) ? list[(size_t)e * NTOK + ci * 128 + tid] : -1;
    __syncthreads();
    f32x16 acc[2][4]; zero_acc(acc);
    if (SKIP != 2) G1::run(lds, [&](int r) { const int aid = rowa[r]; return (aid < 0) ? (const bf16*)nullptr : (H2 + (size_t)(aid >> 3) * D); },
            [&](int c) { const int w4 = c >> 7, within = c & 127; return (within < 64) ? (W1 + 64 * w4 + within) : (W3 + 64 * w4 + within - 64); }, ED, D / 32, acc, nullptr, f8, F8_S1, (e * 5 + ci * 11) & 31);
#pragma unroll
    for (int rb = 0; rb < 2; ++rb) { const int row = wm * 64 + rb * 32 + l31;
#pragma unroll
        for (int cb = 0; cb < 2; ++cb)
#pragma unroll
            for (int g4 = 0; g4 < 4; ++g4) { float hv[4];
#pragma unroll
                for (int e4 = 0; e4 < 4; ++e4) { const float gt = acc[rb][cb][4 * g4 + e4] * s1, up = acc[rb][cb + 2][4 * g4 + e4] * s1; hv[e4] = gt / (1.f + __expf(-gt)) * up; }
                u32x2 w; w.x = cvt_pk(hv[0], hv[1]); w.y = cvt_pk(hv[2], hv[3]);
                *(LAS u32x2*)(lds + MOE_H_OFF + (2 * wn + cb) * 8192 + row * 64 + ((g4 ^ ((row >> 2) & 3)) << 4) + 8 * h) = w; } }
    __syncthreads();
    const int aid0 = rowa[wm * 64 + l31], aid1 = rowa[wm * 64 + 32 + l31];
    if (SKIP != 1) for (int nh = 0; nh < 2; ++nh) {
        zero_acc(acc);
        G2::run(lds, [&](int) { return (const bf16*)nullptr; }, [&](int c) { return W2 + nh * 512 + c; }, D, ED / 32, acc, lds + MOE_H_OFF, f8 + (size_t)(32 + nh * 8) * F8_TILE, F8_S2, (e * 3 + ci + nh * 4) & 7);
#pragma unroll
        for (int rb = 0; rb < 2; ++rb) {
            const int aid = rb ? aid1 : aid0; const float wgt = (aid < 0) ? 0.f : ew[aid] * s2;
            LAS unsigned char* yrow = lds + (wm * 32 + l31) * 1040 + (wn * 128 + 4 * h) * 2;
            __syncthreads();
#pragma unroll
            for (int cb = 0; cb < 4; ++cb)
#pragma unroll
                for (int g4 = 0; g4 < 4; ++g4) { u32x2 w; w.x = cvt_pk(acc[rb][cb][4 * g4] * wgt, acc[rb][cb][4 * g4 + 1] * wgt); w.y = cvt_pk(acc[rb][cb][4 * g4 + 2] * wgt, acc[rb][cb][4 * g4 + 3] * wgt);
                    *(LAS u32x2*)(yrow + (cb * 32 + 8 * g4) * 2) = w; }
            __syncthreads();
#pragma unroll
            for (int i = 0; i < 8; ++i) { const int lr = wave * 8 + i;
                const int ra = rowa[(lr >> 5) * 64 + rb * 32 + (lr & 31)];
                if (ra >= 0) *(u32x4*)(YBUF + (size_t)ra * D + nh * 512 + lane * 8) = *(const LAS u32x4*)(lds + lr * 1040 + lane * 16); }
        }
    }
}
__device__ __forceinline__ void moe_shared(const Args& a, LAS unsigned char* lds, int vcu, int G) {
    const int lane = threadIdx.x & 63, wave = __builtin_amdgcn_readfirstlane(threadIdx.x >> 6), h = lane >> 5, l31 = lane & 31;
    const bf16* H2 = (const bf16*)(a.ws + WS_H2); bf16* YSH = (bf16*)(a.ws + WS_YSH);
    typedef GemmCore<2, 2, 1, 8, 4, false, true, 4, 1> S1;
    typedef GemmCore<2, 2, 1, 8, 4, true, true, 4, 1> S2;
    constexpr int HOFF = S1::LDS_NEED;
    static_assert(HOFF + 8 * 4096 <= LDS_CTL_OFF, "shared-expert LDS map");
    const bf16* W13 = (const bf16*)(a.ws + WS_WS13T); const bf16* W2T = (const bf16*)(a.ws + WS_WS2T);
    for (int su = vcu; su < NTOK / 64; su += G) {
        const int t0 = su * 64;
        f32x16 acc[2][2]; zero_acc(acc);
        __syncthreads();
        S1::run(lds, [&](int r) { return H2 + (size_t)(t0 + r) * D; },
                [&](int c) { const int w8 = c >> 6, within = c & 63; return W13 + (size_t)((within < 32) ? (32 * w8 + within) : (ED + 32 * w8 + within - 32)) * D; }, D, D / 32, acc, nullptr);
#pragma unroll
        for (int rb = 0; rb < 2; ++rb) { const int row = rb * 32 + l31;
#pragma unroll
            for (int g4 = 0; g4 < 4; ++g4) { float hv[4];
#pragma unroll
                for (int e4 = 0; e4 < 4; ++e4) { const float gt = acc[rb][0][4 * g4 + e4], up = acc[rb][1][4 * g4 + e4]; hv[e4] = gt / (1.f + __expf(-gt)) * up; }
                u32x2 w; w.x = cvt_pk(hv[0], hv[1]); w.y = cvt_pk(hv[2], hv[3]);
                *(LAS u32x2*)(lds + HOFF + wave * 4096 + row * 64 + ((g4 ^ ((row >> 2) & 3)) << 4) + 8 * h) = w; } }
        __syncthreads();
        for (int nh = 0; nh < 2; ++nh) {
            zero_acc(acc);
            S2::run(lds, [&](int) { return (const bf16*)nullptr; }, [&](int c) { return W2T + (size_t)(nh * 512 + c) * ED; }, ED, ED / 32, acc, lds + HOFF);
#pragma unroll
            for (int rb = 0; rb < 2; ++rb) { bf16* dst = YSH + (size_t)(t0 + rb * 32 + l31) * D + nh * 512 + wave * 64 + 4 * h;
#pragma unroll
                for (int cb = 0; cb < 2; ++cb)
#pragma unroll
                    for (int g4 = 0; g4 < 4; ++g4) { u32x2 w; w.x = cvt_pk(acc[rb][cb][4 * g4], acc[rb][cb][4 * g4 + 1]); w.y = cvt_pk(acc[rb][cb][4 * g4 + 2], acc[rb][cb][4 * g4 + 3]);
                        *(u32x2*)(dst + cb * 32 + 8 * g4) = w; } }
        }
    }
}
template <int PARTS>
__device__ __forceinline__ void phase6_v6(const Args& a, LAS unsigned char* lds, int vcu, int G, const XcdBarrier bar) {
    const int tid = threadIdx.x;
    const int* cnt = (const int*)(a.ws + C_CNT);
    if (PARTS & 1) moe_shared(a, lds, vcu, G);
    if (PARTS & 2) for (int e = vcu; e < NE; e += G) if (cnt[e] > 0) moe_chunk<2>(a, lds, e, 0);
    xcd_barrier(bar);
    if (!(PARTS & 4)) return;
    LAS int* pf = (LAS int*)(lds + 0);
    __syncthreads();
    if (tid < NE) { const int c = (cnt[tid] + 127) >> 7; pf[tid + 1] = c > 0 ? c - 1 : 0; }
    if (tid == 0) pf[0] = 0;
    __syncthreads();
    if (tid == 0) { int s = 0; for (int e = 0; e < NE; ++e) { s += pf[e + 1]; pf[e + 1] = s; } }
    __syncthreads();
    const int total = pf[NE];
    LAS int* myu = (LAS int*)(lds + LDS_CTL_OFF + 256);
    int nmy = 0;
    for (int u = vcu; u < total; u += G) ++nmy;
    if (nmy > 16) nmy = 16;
    if (tid < nmy) { const int u = vcu + tid * G; int lo = 0, hi = NE - 1; while (lo < hi) { const int mid = (lo + hi) >> 1; if (pf[mid + 1] > u) hi = mid; else lo = mid + 1; }
        myu[tid] = lo; myu[16 + tid] = u - pf[lo] + 1; }
    __syncthreads();
    for (int iu = 0; iu < nmy; ++iu) { if (PARTS & 8) moe_chunk<3, 1, (PARTS >> 8)>(a, lds, myu[iu], myu[16 + iu]); else if (PARTS & 16) moe_chunk<3, 2>(a, lds, myu[iu], myu[16 + iu]); else moe_chunk<3>(a, lds, myu[iu], myu[16 + iu]); }
}
typedef long i64;
#define MFMA8(a, b, c) __builtin_amdgcn_mfma_f32_32x32x16_fp8_fp8((a), (b), (c), 0, 0, 0)
__device__ __forceinline__ i64 lo64(const u32x4& v) { return __builtin_bit_cast(i64, __builtin_shufflevector(v, v, 0, 1)); }
__device__ __forceinline__ i64 hi64(const u32x4& v) { return __builtin_bit_cast(i64, __builtin_shufflevector(v, v, 2, 3)); }
constexpr float F8_SH = 4.f;
__device__ __forceinline__ void moe_convert(const Args& a, LAS unsigned char* lds, int vcu, int G) {
    const int lane = threadIdx.x & 63, wave = __builtin_amdgcn_readfirstlane(threadIdx.x >> 6);
    LAS float* scr = (LAS float*)(lds + wave * 8448);
    const int NIT = (NE + 1) * 48 * 8;
    for (int it = vcu * NWAVE + wave; it < NIT; it += G * NWAVE) {
        const int g = it & 7, T = (it >> 3) % 48, e = it / (48 * 8);
        const float* W1 = (e < NE) ? a.w1 + (size_t)e * D * ED : a.ws1; const float* W3 = (e < NE) ? a.w3 + (size_t)e * D * ED : a.ws3; const float* W2 = (e < NE) ? a.w2 + (size_t)e * ED * D : a.ws2;
        const float* src; int ld; float sc;
        if (T < 32) { src = ((lane & 32) ? W3 : W1) + (size_t)(32 * T) * ED + 32 * g - (lane & 32); ld = ED; sc = F8_S1; }
        else { const int t2 = T - 32, nh = t2 >> 3, ks = t2 & 7; src = W2 + (size_t)(32 * ks) * D + nh * 512 + 64 * g; ld = D; sc = F8_S2; }
#pragma unroll 8
        for (int k = 0; k < 32; ++k) scr[k * 65 + lane] = src[(size_t)k * ld + lane];
        asm volatile("s_waitcnt lgkmcnt(0)" ::: "memory");
        unsigned o[8];
#pragma unroll
        for (int d = 0; d < 8; ++d) { int p = __builtin_amdgcn_cvt_pk_fp8_f32(scr[(4 * d) * 65 + lane] * sc, scr[(4 * d + 1) * 65 + lane] * sc, 0, false);
            p = __builtin_amdgcn_cvt_pk_fp8_f32(scr[(4 * d + 2) * 65 + lane] * sc, scr[(4 * d + 3) * 65 + lane] * sc, p, true); o[d] = (unsigned)p; }
        unsigned char* dst = ((e < NE) ? a.ws + WS_HB + (size_t)e * F8_EXP_BYTES : a.ws + WS_WS13T) + (size_t)T * F8_TILE + (size_t)(64 * g + lane) * 32;
        *(u32x4*)dst = (u32x4){o[0], o[1], o[2], o[3]}; *(u32x4*)(dst + 16) = (u32x4){o[4], o[5], o[6], o[7]};
        asm volatile("s_waitcnt lgkmcnt(0)" ::: "memory");
    }
}
constexpr int M8_H = 0, M8_HSTR = 272, M8_Y = 36864;
__device__ __forceinline__ void moe_chunk8(const Args& a, LAS unsigned char* lds, int e, int ci) {
    int tid = threadIdx.x; asm volatile("" : "+v"(tid));
    const int lane = tid & 63, wave = __builtin_amdgcn_readfirstlane(tid >> 6), h = lane >> 5, l31 = lane & 31;
    const int* cnt = (const int*)(a.ws + C_CNT); const int* list = (const int*)(a.ws + WS_LIST); const float* ew = (const float*)(a.ws + WS_EW);
    const bool routed = e < NE;
    bf16* YBUF = routed ? (bf16*)(a.ws + WS_YBUF) : (bf16*)(a.ws + WS_YSH); const unsigned char* X8 = a.ws + WS_X8;
    LAS int* rowa = (LAS int*)(lds + LDS_CTL_OFF + 384);
    const int n = routed ? min(128, cnt[e] - ci * 128) : 128;
#ifdef PROF_K
    unsigned long long* tsq = (unsigned long long*)(a.ws + C_TS); unsigned long long tq0 = __builtin_amdgcn_s_memrealtime();
#define SECT(i) do { if (blockIdx.x == 0 && threadIdx.x == 0) { const unsigned long long tq1 = __builtin_amdgcn_s_memrealtime(); tsq[21 + 2 * (i)] += tq1 - tq0; tq0 = tq1; } } while (0)
#else
#define SECT(i) do {} while (0)
#endif
    const unsigned char* f8 = (routed ? a.ws + WS_HB + (size_t)e * F8_EXP_BYTES : a.ws + WS_WS13T) + (size_t)(64 * wave + l31) * 32 + 16 * h;
    __syncthreads();
    if (tid < 128) rowa[tid] = (tid < n) ? (routed ? list[(size_t)e * NTOK + ci * 128 + tid] : ci * 128 + tid) : -1;
    __syncthreads();
    const int tsh = routed ? 3 : 0;
    {
        u32x4 xr[16];
#pragma unroll
        for (int i = 0; i < 16; ++i) { const int p = tid + NTHR * i, row = p >> 6, c = p & 63; const int ra = rowa[row];
            xr[i] = *(const u32x4*)(X8 + (size_t)((ra < 0) ? (p & (NTOK - 1)) : (ra >> tsh)) * D + c * 16); }
#pragma unroll
        for (int i = 0; i < 16; ++i) { const int p = tid + NTHR * i, row = p >> 6, c = p & 63; *(LAS u32x4*)(lds + row * 1040 + c * 16) = xr[i]; }
    }
    __syncthreads();
    SECT(0);
    f32x16 acc[4][2]; zero_acc(acc);
    typedef int i32x8 __attribute__((ext_vector_type(8)));
#define MFMAX(a8, b8, c) __builtin_amdgcn_mfma_scale_f32_32x32x64_f8f6f4((a8), (b8), (c), 0, 0, 0, 0x7f7f7f7f, 0, 0x7f7f7f7f)
    u32x4 wb[4][2][2];
    const unsigned char* f8h = f8 - 16 * h + (size_t)h * F8_TILE;
    const LAS unsigned char* xl = lds + l31 * 1040 + 32 * h;
    auto ld1 = [&](int d, int KS) { const unsigned char* p = f8h + (size_t)(2 * KS) * F8_TILE;
        wb[d][0][0] = *(const u32x4*)p; wb[d][0][1] = *(const u32x4*)(p + 16); wb[d][1][0] = *(const u32x4*)(p + 1024); wb[d][1][1] = *(const u32x4*)(p + 1040); };
    auto mk8 = [&](const u32x4 lo, const u32x4 hi) { return (i32x8){(int)lo.x, (int)lo.y, (int)lo.z, (int)lo.w, (int)hi.x, (int)hi.y, (int)hi.z, (int)hi.w}; };
#pragma unroll
    for (int d = 0; d < 4; ++d) ld1(d, d);
#pragma unroll 1
    for (int ks0 = 0; ks0 < 16; ks0 += 4) {
#pragma unroll
        for (int d = 0; d < 4; ++d) { const int KS = ks0 + d;
            const i32x8 b0 = mk8(wb[d][0][0], wb[d][0][1]), b1 = mk8(wb[d][1][0], wb[d][1][1]);
#pragma unroll
            for (int rb = 0; rb < 4; ++rb) { const i32x8 x = mk8(*(const LAS u32x4*)(xl + rb * 32 * 1040 + 64 * KS), *(const LAS u32x4*)(xl + rb * 32 * 1040 + 64 * KS + 16));
                acc[rb][0] = MFMAX(b0, x, acc[rb][0]); acc[rb][1] = MFMAX(b1, x, acc[rb][1]); }
            ld1(d, min(KS + 4, 12 + d)); asm volatile("" ::: "memory"); }
    }
    asm volatile("s_waitcnt vmcnt(0)" ::: "memory");
    __syncthreads();
    SECT(1);
    {
        const float s1 = 1.f / F8_S1;
#pragma unroll
        for (int rb = 0; rb < 4; ++rb) { const int row = rb * 32 + l31;
#pragma unroll
            for (int g4 = 0; g4 < 4; ++g4) { float hv[4];
#pragma unroll
                for (int e4 = 0; e4 < 4; ++e4) { const float gt = acc[rb][0][4 * g4 + e4] * s1, up = acc[rb][1][4 * g4 + e4] * s1; hv[e4] = fminf(fmaxf(gt * __builtin_amdgcn_rcpf(1.f + __expf(-gt)) * up * F8_SH, -440.f), 440.f); }
                int p = __builtin_amdgcn_cvt_pk_fp8_f32(hv[0], hv[1], 0, false); p = __builtin_amdgcn_cvt_pk_fp8_f32(hv[2], hv[3], p, true);
                *(LAS int*)(lds + M8_H + row * M8_HSTR + 32 * wave + 8 * g4 + 4 * h) = p; } }
    }
    __syncthreads();
    SECT(2);
    const LAS unsigned char* hp = lds + M8_H + l31 * M8_HSTR + 32 * h;
    for (int nh = 0; nh < 2; ++nh) {
        zero_acc(acc);
        const unsigned char* p2 = f8h + (size_t)(32 + nh * 8) * F8_TILE;
#pragma unroll
        for (int d = 0; d < 4; ++d) { const unsigned char* p = p2 + (size_t)(2 * d) * F8_TILE;
            wb[d][0][0] = *(const u32x4*)p; wb[d][0][1] = *(const u32x4*)(p + 16); wb[d][1][0] = *(const u32x4*)(p + 1024); wb[d][1][1] = *(const u32x4*)(p + 1040); }
#pragma unroll
        for (int d = 0; d < 4; ++d) {
            const i32x8 b0 = mk8(wb[d][0][0], wb[d][0][1]), b1 = mk8(wb[d][1][0], wb[d][1][1]);
#pragma unroll
            for (int rb = 0; rb < 4; ++rb) { const i32x8 x = mk8(*(const LAS u32x4*)(hp + rb * 32 * M8_HSTR + 64 * d), *(const LAS u32x4*)(hp + rb * 32 * M8_HSTR + 64 * d + 16));
                acc[rb][0] = MFMAX(b0, x, acc[rb][0]); acc[rb][1] = MFMAX(b1, x, acc[rb][1]); }
        }
        SECT(3);
        const float s2 = 1.f / (F8_S2 * F8_SH);
#pragma unroll
        for (int hf = 0; hf < 2; ++hf) {
            __syncthreads();
#pragma unroll
            for (int r2 = 0; r2 < 2; ++r2) { const int rb = hf * 2 + r2; const int aid = rowa[rb * 32 + l31]; const float wgt = (aid < 0) ? 0.f : (routed ? ew[aid] : 1.f) * s2;
                LAS unsigned char* yrow = lds + M8_Y + (r2 * 32 + l31) * 1040 + (wave * 64 + 4 * h) * 2;
#pragma unroll
                for (int cb = 0; cb < 2; ++cb)
#pragma unroll
                    for (int g4 = 0; g4 < 4; ++g4) { u32x2 w; w.x = cvt_pk(acc[rb][cb][4 * g4] * wgt, acc[rb][cb][4 * g4 + 1] * wgt); w.y = cvt_pk(acc[rb][cb][4 * g4 + 2] * wgt, acc[rb][cb][4 * g4 + 3] * wgt);
                        *(LAS u32x2*)(yrow + (cb * 32 + 8 * g4) * 2) = w; } }
            __syncthreads();
#pragma unroll 2
            for (int i = 0; i < 8; ++i) { const int lr = wave * 8 + i; const int ra = rowa[hf * 64 + lr];
                if (ra >= 0) *(u32x4*)(YBUF + (size_t)ra * D + nh * 512 + lane * 8) = *(const LAS u32x4*)(lds + M8_Y + lr * 1040 + lane * 16); }
        }
        SECT(4);
    }
}
template <int PARTS>
__device__ __forceinline__ void phase6_v7(const Args& a, LAS unsigned char* lds, int vcu, int G, const XcdBarrier bar) {
    const int tid = threadIdx.x;
    const int* cnt = (const int*)(a.ws + C_CNT);
    if (PARTS & 1) moe_convert(a, lds, vcu, G);
    __syncthreads();
    xcd_barrier(bar);
    if (!(PARTS & 4)) return;
    LAS int* pf = (LAS int*)(lds + 65536);
    __syncthreads();
    if (tid < NE) pf[tid + 1] = (cnt[tid] + 127) >> 7;
    if (tid == 0) pf[0] = 0;
    __syncthreads();
    if (tid == 0) { int s = 0; for (int e = 0; e < NE; ++e) { s += pf[e + 1]; pf[e + 1] = s; } }
    __syncthreads();
    constexpr int NSH = NTOK / 128;
    const int total = NSH + pf[NE];
    LAS int* myu = (LAS int*)(lds + LDS_CTL_OFF + 256);
    int nmy = 0;
    for (int u = vcu; u < total; u += G) ++nmy;
    if (nmy > 16) nmy = 16;
    if (tid < nmy) { const int u = vcu + tid * G;
        if (u < NSH) { myu[tid] = NE; myu[16 + tid] = u; }
        else { const int ru = u - NSH; int lo = 0, hi = NE - 1; while (lo < hi) { const int mid = (lo + hi) >> 1; if (pf[mid + 1] > ru) hi = mid; else lo = mid + 1; }
            myu[tid] = lo; myu[16 + tid] = ru - pf[lo]; } }
    __syncthreads();
    for (int iu = 0; iu < nmy; ++iu) moe_chunk8(a, lds, myu[iu], myu[16 + iu]);
}
__device__ __forceinline__ void phase7(const Args& a, int vcu, int G) {
    const int lane = threadIdx.x & 63, gw = vcu * NWAVE + (threadIdx.x >> 6), NGW = G * NWAVE;
#ifdef PROF_K
    const unsigned long long* ts = (const unsigned long long*)(a.ws + C_TS);
    const float prof_b1 = rintf(log2f(fmaxf((float)(ts[PROF_K + 1] - ts[PROF_K]) * 0.01f, 1.f)) * 4.f), prof_us2 = exp2f(rintf(log2f(fmaxf((float)(ts[PROF_K2 + 1] - ts[PROF_K2]) * 0.01f, 1.f)) * 4.f) * 0.25f);
    const float prof_scale = 1.f + prof_b1 * PROF_S;
#else
    const float prof_scale = 1.f;
#endif
    const float* X1 = (const float*)(a.ws + WS_X1); const float* mod = (const float*)(a.ws + C_MOD);
    const bf16* YBUF = (const bf16*)(a.ws + WS_YBUF); const bf16* YSH = (const bf16*)(a.ws + WS_YSH);
    for (int t = gw; t < NTOK; t += NGW) { const int b = t / S;
        f32x4 v[4]; float s = 0.f;
#pragma unroll
        for (int j = 0; j < 4; ++j) { const int c = j * 256 + lane * 4;
            u32x2 w = *(const u32x2*)(YSH + (size_t)t * D + c);
            float m0 = __uint_as_float(w.x << 16), m1 = __uint_as_float(w.x & 0xffff0000u), m2 = __uint_as_float(w.y << 16), m3 = __uint_as_float(w.y & 0xffff0000u);
#pragma unroll
            for (int r = 0; r < 8; ++r) { w = *(const u32x2*)(YBUF + ((size_t)t * 8 + r) * D + c);
                m0 += __uint_as_float(w.x << 16); m1 += __uint_as_float(w.x & 0xffff0000u); m2 += __uint_as_float(w.y << 16); m3 += __uint_as_float(w.y & 0xffff0000u); }
            const f32x4 xv = *(const f32x4*)(X1 + (size_t)t * D + c), g2 = *(const f32x4*)(mod + b * 6 * D + 5 * D + c);
            v[j].x = xv.x + g2.x * m0; v[j].y = xv.y + g2.y * m1; v[j].z = xv.z + g2.z * m2; v[j].w = xv.w + g2.w * m3;
            s += (v[j].x * v[j].x + v[j].y * v[j].y) + (v[j].z * v[j].z + v[j].w * v[j].w); }
        const float rstd = rsqrtf(wave_sum(s) * (1.f / D) + EPS);
#pragma unroll
        for (int j = 0; j < 4; ++j) { const int c = j * 256 + lane * 4; const f32x4 fg = *(const f32x4*)(a.final_g + c);
            f32x4 o; o.x = v[j].x * rstd * fg.x * prof_scale; o.y = v[j].y * rstd * fg.y * prof_scale; o.z = v[j].z * rstd * fg.z * prof_scale; o.w = v[j].w * rstd * fg.w * prof_scale;
#ifdef PROF_K
            if (t == 0 && c == 0) o.x = prof_us2;
#endif
            *(f32x4*)(a.out + (size_t)t * D + c) = o; }
    }
}
__global__ void __launch_bounds__(NTHR, 2) mega(Args a) {
    extern __shared__ __attribute__((aligned(16))) unsigned char lds_raw[];
    LAS unsigned char* lds = (LAS unsigned char*)lds_raw;
    const int tid = threadIdx.x, G = gridDim.x;
    const int bx = blockIdx.x, vcu = (G % 8 == 0) ? (bx % 8) * (G / 8) + bx / 8 : bx;
    volatile LAS unsigned* ctl = (volatile LAS unsigned*)(lds + LDS_CTL_OFF);
    if (tid < 64) ctl[tid] = 0u;
    __syncthreads();
    XcdBarrier bar = xcd_barrier_post((unsigned*)(a.ws + C_BAR) + a.ph_lo * XCD_BAR_WORDS, ctl);
    const int lo = a.ph_lo, hi = a.ph_hi;
#ifndef ONLY_PHASE
#define ONLY_PHASE -1
#endif
#define IN(k) (lo <= (k) && (k) < hi && (ONLY_PHASE < 0 || ONLY_PHASE == (k)))
#ifndef XBAR
#define XBAR 1
#endif
#ifdef PROF_K
#define STAMP(i) do { if (blockIdx.x == 0 && tid == 0) ((unsigned long long*)(a.ws + C_TS))[i] = __builtin_amdgcn_s_memrealtime(); } while (0)
#else
#define STAMP(i) do {} while (0)
#endif
#define SEAM(k) do { if (IN(k) && IN((k) + 1)) { STAMP(2 * (k) + 1); for (int xb = 0; xb < XBAR; ++xb) xcd_barrier(bar); STAMP(2 * (k) + 2); } } while (0)
    STAMP(0);
#ifndef REP_PHASE
#define REP_PHASE -1
#endif
#ifndef REP_N
#define REP_N 1
#endif
#define NREP(k) ((REP_PHASE == (k)) ? REP_N : 1)
    if (IN(0))
#pragma unroll 1
    for (int rep = 0; rep < NREP(0); ++rep) { phase0(a, lds, vcu, G); __syncthreads(); }
    SEAM(0);
    if (IN(1)) for (int rep = 0; rep < NREP(1); ++rep) phase1(a, vcu, G);
    SEAM(1);
    if (IN(2)) for (int rep = 0; rep < NREP(2); ++rep) phase2(a, lds, vcu, G);
    SEAM(2);
    if (IN(3)) for (int rep = 0; rep < NREP(3); ++rep) phase3(a, lds, vcu, G);
    SEAM(3);
    if (IN(4)) for (int rep = 0; rep < NREP(4); ++rep) phase4(a, lds, vcu, G);
    SEAM(4);
    if (IN(5)) for (int rep = 0; rep < NREP(5); ++rep) phase5(a, lds, vcu, G, rep > 0);
    SEAM(5);
#ifndef MOE_V2
#define MOE_V2 7
#endif
#ifdef PROBE_MOE
    if (IN(6)) { phase6_v7<PROBE_MOE>(a, lds, vcu, G, bar); xcd_barrier(bar); }
#endif
    if (IN(6)) for (int rep = 0; rep < NREP(6); ++rep) { if (MOE_V2 == 7) phase6_v7<7>(a, lds, vcu, G, bar); else if (MOE_V2 == 6) phase6_v6<7>(a, lds, vcu, G, bar); else if (MOE_V2 == 3) phase6<0>(a, lds, vcu, G); else if (MOE_V2 == 2) phase6_v2(a, lds, vcu, G); else phase6_old(a, lds, vcu, G, bar, false); }
    SEAM(6);
    if (IN(7)) for (int rep = 0; rep < NREP(7); ++rep) phase7(a, vcu, G);
#undef IN
#undef SEAM
}

#ifndef OPT_MASK
#define OPT_MASK 0xFF
#endif
static void launch_mega(const Args& base, int lo, int hi, int grid, hipStream_t stream) {
    Args a = base; a.ph_lo = lo; a.ph_hi = hi;
    hipLaunchKernelGGL(mega, dim3(grid), dim3(NTHR), LDS_BYTES, stream, a);
}
extern "C" void kernel_launch(void* const* d_in, const int* in_sizes, int n_in, void* d_out, int out_size, void* d_ws, size_t ws_size, hipStream_t stream) {
    static int grid = 0;
    if (grid == 0) {
        if (n_in != 21 || ws_size < WS_END) { fprintf(stderr, "kernel_launch: unexpected n_in %d or ws_size %zu\n", n_in, ws_size); grid = -1; return; }
        int dev = 0, cus = 0, per_cu = 0;
        if (hipGetDevice(&dev) != hipSuccess || hipDeviceGetAttribute(&cus, hipDeviceAttributeMultiprocessorCount, dev) != hipSuccess) { grid = -1; return; }
        if (hipFuncSetAttribute((const void*)mega, hipFuncAttributeMaxDynamicSharedMemorySize, LDS_BYTES) != hipSuccess) { fprintf(stderr, "kernel_launch: hipFuncSetAttribute failed\n"); grid = -1; return; }
        if (hipOccupancyMaxActiveBlocksPerMultiprocessor(&per_cu, (const void*)mega, NTHR, LDS_BYTES) != hipSuccess || per_cu < 1) { fprintf(stderr, "kernel_launch: occupancy query says %d blocks per CU\n", per_cu); (void)hipGetLastError(); grid = -1; return; }
        grid = cus;
    }
    if (grid < 0) return;
    unsigned char* ws = (unsigned char*)d_ws;
    Args a{};
    a.x = (const float*)d_in[0]; a.c = (const float*)d_in[1]; a.w_ada = (const float*)d_in[2]; a.b_ada = (const float*)d_in[3]; a.norm1_g = (const float*)d_in[4]; a.w_in = (const float*)d_in[5];
    a.sinks = (const float*)d_in[6]; a.rel_table = (const float*)d_in[7]; a.out_norm_a = (const float*)d_in[8]; a.out_norm_b = (const float*)d_in[9]; a.w_out = (const float*)d_in[10];
    a.norm2_g = (const float*)d_in[11]; a.w_router = (const float*)d_in[12]; a.e_bias = (const float*)d_in[13]; a.w1 = (const float*)d_in[14]; a.w3 = (const float*)d_in[15]; a.w2 = (const float*)d_in[16];
    a.ws1 = (const float*)d_in[17]; a.ws3 = (const float*)d_in[18]; a.ws2 = (const float*)d_in[19]; a.final_g = (const float*)d_in[20];
    a.out = (float*)d_out; a.ws = ws; a.ph_lo = 0; a.ph_hi = 8;
    (void)hipMemsetAsync(ws + WS_CTL, 0, CTL_BYTES, stream);
#if defined(P0_TIMING)
    for (int r = 0; r < P0_TIMING; ++r) launch_mega(a, 0, 1, grid, stream);
    launch_mega(a, 1, 8, grid, stream);
#elif OPT_MASK == 0xFF && !defined(SPLIT_LAUNCH)
    launch_mega(a, 0, 8, grid, stream);
#else
    float* mod = (float*)(ws + C_MOD); float* ksum = (float*)(ws + C_KSUM); float* ssq = (float*)(ws + WS_SSQ); int* cnt = (int*)(ws + C_CNT);
    float* lut = (float*)(ws + WS_LUT); bf16* H = (bf16*)(ws + WS_H);
    bf16* QA = (bf16*)(ws + WS_QA); bf16* KA = (bf16*)(ws + WS_KA); bf16* VAT = (bf16*)(ws + WS_VAT); bf16* QB = (bf16*)(ws + WS_QB); bf16* KB = (bf16*)(ws + WS_KB); bf16* VBT = (bf16*)(ws + WS_VBT);
    bf16* ATT = (bf16*)(ws + WS_ATT); float* X1 = (float*)(ws + WS_X1); bf16* H2 = (bf16*)(ws + WS_H2); float* EW = (float*)(ws + WS_EW); int* LIST = (int*)(ws + WS_LIST);
    bf16* YSH = (bf16*)(ws + WS_YSH); bf16* YBUF = (bf16*)(ws + WS_YBUF);
    if (OPT_MASK & 1) launch_mega(a, 0, 1, grid, stream); else { k_mod<<<24, 256, 0, stream>>>(a.c, a.w_ada, a.b_ada, mod); k_lut<<<(16 * LUTN + 255) / 256, 256, 0, stream>>>(a.rel_table, lut); }
    if (OPT_MASK & 2) launch_mega(a, 1, 2, grid, stream); else k_norm_mod<<<NTOK, 256, 0, stream>>>(a.x, a.norm1_g, mod, 0, D, H);
    if (OPT_MASK & 4) launch_mega(a, 2, 3, grid, stream); else k_inproj<<<dim3(INC / 256, NTOK), 256, 0, stream>>>(H, a.w_in, QA, KA, VAT, QB, KB, VBT, ksum);
    if (OPT_MASK & 8) launch_mega(a, 3, 4, grid, stream); else { k_swa<<<NTOK * 8 / 64, 64, 0, stream>>>(QA, KA, VAT, lut, a.sinks, a.out_norm_a, ATT, ssq); k_moba<<<NTOK * 8 / 64, 64, 0, stream>>>(QB, KB, VBT, ksum, lut, a.out_norm_b, ATT, ssq); }
    if (OPT_MASK & 16) launch_mega(a, 4, 5, grid, stream); else k_outproj<<<dim3(D / 256, NTOK), 256, 0, stream>>>(ATT, ssq, a.w_out, a.x, mod, X1);
    if (OPT_MASK & 32) launch_mega(a, 5, 6, grid, stream); else { k_norm_mod<<<NTOK, 256, 0, stream>>>(X1, a.norm2_g, mod, 3 * D, 4 * D, H2); k_router<<<NTOK, 256, 0, stream>>>(H2, a.w_router, a.e_bias, cnt, LIST, EW); }
    if (OPT_MASK & 64) launch_mega(a, 6, 7, grid, stream); else k_moe<<<dim3(NTOK / 8, NE + 1), 256, 0, stream>>>(H2, cnt, LIST, EW, a.w1, a.w3, a.w2, a.ws1, a.ws3, a.ws2, YBUF, YSH);
    if (OPT_MASK & 128) launch_mega(a, 7, 8, grid, stream); else k_final<<<NTOK, 256, 0, stream>>>(X1, YBUF, YSH, mod, a.final_g, (float*)d_out);
#endif
}
```

```cpp
#include <hip/hip_runtime.h>
#include <cstdio>
#include <cstdint>

constexpr int D = 1024, NB = 8, S = 2048, NTOK = NB * S;
constexpr int HD = 64, INC = 2304;
constexpr int NE = 256, TOPK = 8, ED = 256;
constexpr float EPS = 1e-6f;
constexpr float LOG2E = 1.4426950408889634f;
constexpr float QSCALE = 0.125f * LOG2E;
constexpr float NEGBIG = -1e30f;

typedef unsigned short bf16;
__device__ __forceinline__ float bf2f(bf16 v) { return __uint_as_float(((unsigned)v) << 16); }
__device__ __forceinline__ bf16 f2bf(float f) { unsigned u = __float_as_uint(f); return (bf16)((u + 0x7fffu + ((u >> 16) & 1u)) >> 16); }

constexpr size_t MiB = 1u << 20;
constexpr size_t WS_CTL   = 0;
constexpr size_t CTL_BYTES = 1 * MiB;
constexpr size_t C_MOD   = 64 * 1024;
constexpr size_t C_KSUM  = 320 * 1024;
constexpr size_t C_SSQA  = 512 * 1024;
constexpr size_t C_SSQB  = 576 * 1024;
constexpr size_t C_CNT   = 640 * 1024;
constexpr size_t C_QHEAD = 644 * 1024;
constexpr size_t C_TS    = 648 * 1024;
constexpr size_t WS_LUT  = 1 * MiB;
constexpr size_t WS_H    = 2 * MiB;
constexpr size_t WS_QA   = 34 * MiB;
constexpr size_t WS_KA   = 50 * MiB;
constexpr size_t WS_VAT  = 54 * MiB;
constexpr size_t WS_QB   = 58 * MiB;
constexpr size_t WS_KB   = 74 * MiB;
constexpr size_t WS_VBT  = 90 * MiB;
constexpr size_t WS_ATT  = 106 * MiB;
constexpr size_t WS_X1   = 138 * MiB;
constexpr size_t WS_H2   = 202 * MiB;
constexpr size_t WS_EW   = 234 * MiB;
constexpr size_t WS_SSQ  = 235 * MiB;
constexpr size_t WS_LIST = 236 * MiB;
constexpr size_t WS_YSH  = 256 * MiB;
constexpr size_t WS_YBUF = 288 * MiB;
constexpr size_t WS_WTIN = 640 * MiB;
constexpr size_t WS_WTOUT= 645 * MiB;
constexpr size_t WS_WTR  = 647 * MiB;
constexpr size_t WS_WS13T= 648 * MiB;
constexpr size_t WS_WS2T = 649 * MiB;
constexpr size_t WS_HB   = 650 * MiB;
constexpr size_t WS_X8   = 842 * MiB;
constexpr size_t WS_END  = 858 * MiB;

constexpr int LUT_NEG = 256;
constexpr int LUTN = 2560;

__device__ __forceinline__ int t5_bucket(int n) {
    if (n < 16) return n;
    const int thr[15] = {21, 27, 35, 46, 59, 77, 99, 128, 166, 216, 280, 363, 470, 609, 790};
    int b = 16;
#pragma unroll
    for (int i = 0; i < 15; ++i) b += (n >= thr[i]) ? 1 : 0;
    return b;
}

__global__ void k_mod(const float* c, const float* w_ada, const float* b_ada, float* mod) {
    int j = blockIdx.x * blockDim.x + threadIdx.x;
    if (j >= 6 * D) return;
    float acc[NB];
#pragma unroll
    for (int b = 0; b < NB; ++b) acc[b] = 0.f;
    for (int k = 0; k < D; ++k) {
        float w = w_ada[(size_t)k * 6 * D + j];
#pragma unroll
        for (int b = 0; b < NB; ++b) { float cv = c[b * D + k]; float sv = cv / (1.f + __expf(-cv)); acc[b] += sv * w; }
    }
#pragma unroll
    for (int b = 0; b < NB; ++b) mod[b * 6 * D + j] = acc[b] + b_ada[j];
}
__global__ void k_lut(const float* rel_table, float* lut) {
    int i = blockIdx.x * blockDim.x + threadIdx.x;
    if (i >= 16 * LUTN) return;
    int h = i / LUTN, p = i % LUTN, dist = p - LUT_NEG;
    float v = NEGBIG;
    bool ok = dist >= 0 && (h < 8 ? dist < 128 : dist < S);
    if (ok) v = rel_table[t5_bucket(dist) * 16 + h] * LOG2E;
    lut[i] = v;
}
__global__ void k_norm_mod(const float* x, const float* g, const float* mod, int sh_off, int sc_off, bf16* out) {
    int t = blockIdx.x, b = t / S, tid = threadIdx.x;
    __shared__ float red[256];
    float v[4]; float s = 0.f;
#pragma unroll
    for (int i = 0; i < 4; ++i) { v[i] = x[(size_t)t * D + tid + 256 * i]; s += v[i] * v[i]; }
    red[tid] = s; __syncthreads();
    for (int o = 128; o > 0; o >>= 1) { if (tid < o) red[tid] += red[tid + o]; __syncthreads(); }
    float rstd = rsqrtf(red[0] / D + EPS);
#pragma unroll
    for (int i = 0; i < 4; ++i) { int col = tid + 256 * i;
        float hv = v[i] * rstd * g[col] * (1.f + mod[b * 6 * D + sc_off + col]) + mod[b * 6 * D + sh_off + col];
        out[(size_t)t * D + col] = f2bf(hv); }
}
__global__ void k_inproj(const bf16* h, const float* w_in, bf16* QA, bf16* KA, bf16* VAT, bf16* QB, bf16* KB, bf16* VBT, float* ksum) {
    int col = blockIdx.x * blockDim.x + threadIdx.x;
    int t = blockIdx.y;
    if (col >= INC) return;
    float acc = 0.f;
    const bf16* hr = h + (size_t)t * D;
    for (int k = 0; k < D; ++k) acc += bf2f(hr[k]) * w_in[(size_t)k * INC + col];
    int b = t / S, s = t % S;
    if (col < 512) { int hh = col / 64, d = col % 64; QA[(((size_t)b * 8 + hh) * S + s) * 64 + d] = f2bf(acc * QSCALE); }
    else if (col < 640) { int c2 = col - 512, hh = c2 / 64, d = c2 % 64; KA[(((size_t)b * 2 + hh) * S + s) * 64 + d] = f2bf(acc); }
    else if (col < 768) { int c2 = col - 640, hh = c2 / 64, d = c2 % 64; VAT[(((size_t)b * 2 + hh) * 64 + d) * S + s] = f2bf(acc); }
    else if (col < 1280) { int c2 = col - 768, hh = c2 / 64, d = c2 % 64; QB[(((size_t)b * 8 + hh) * S + s) * 64 + d] = f2bf(acc * QSCALE); }
    else if (col < 1792) { int c2 = col - 1280, hh = c2 / 64, d = c2 % 64; bf16 kb = f2bf(acc); KB[(((size_t)b * 8 + hh) * S + s) * 64 + d] = kb;
        atomicAdd(&ksum[(((size_t)b * 8 + hh) * 8 + s / 256) * 64 + d], bf2f(kb)); }
    else { int c2 = col - 1792, hh = c2 / 64, d = c2 % 64; VBT[(((size_t)b * 8 + hh) * 64 + d) * S + s] = f2bf(acc); }
}
__global__ void __launch_bounds__(64) k_swa(const bf16* QA, const bf16* KA, const bf16* VAT, const float* lut, const float* sinks, const float* gain, bf16* att, float* ssq) {
    int idx = blockIdx.x * blockDim.x + threadIdx.x;
    if (idx >= NTOK * 8) return;
    int hh = idx % 8, t = idx / 8, b = t / S, s = t % S, kv = hh / 4;
    float q[64];
    const bf16* qp = QA + (((size_t)b * 8 + hh) * S + s) * 64;
#pragma unroll
    for (int d = 0; d < 64; ++d) q[d] = bf2f(qp[d]);
    const float* L = lut + hh * LUTN + LUT_NEG;
    int n = s / 128;
    int k0 = (n == 0) ? 0 : (n - 1) * 128, k1 = s;
    float m = NEGBIG, l = 0.f; float o[64];
#pragma unroll
    for (int d = 0; d < 64; ++d) o[d] = 0.f;
    for (int kp = k0; kp <= k1; ++kp) {
        const bf16* kr = KA + (((size_t)b * 2 + kv) * S + kp) * 64;
        float sc = 0.f;
#pragma unroll
        for (int d = 0; d < 64; ++d) sc += q[d] * bf2f(kr[d]);
        sc += L[s - kp];
        float mn = fmaxf(m, sc), a = exp2f(m - mn), p = exp2f(sc - mn);
        l = l * a + p;
#pragma unroll
        for (int d = 0; d < 64; ++d) o[d] = o[d] * a + p * bf2f(VAT[(((size_t)b * 2 + kv) * 64 + d) * S + kp]);
        m = mn;
    }
    float sk = sinks[hh] * LOG2E;
    float mn = fmaxf(m, sk), a = exp2f(m - mn);
    l = l * a + exp2f(sk - mn);
    float inv = a / l, sq = 0.f;
#pragma unroll
    for (int d = 0; d < 64; ++d) { float ov = o[d] * inv; sq += ov * ov; att[(size_t)t * D + hh * 64 + d] = f2bf(ov * gain[hh * 64 + d]); }
    ssq[t * 16 + hh] = sq;
}
__global__ void __launch_bounds__(64) k_moba(const bf16* QB, const bf16* KB, const bf16* VBT, const float* ksum, const float* lut, const float* gain, bf16* att, float* ssq) {
    int idx = blockIdx.x * blockDim.x + threadIdx.x;
    if (idx >= NTOK * 8) return;
    int hh = idx % 8, t = idx / 8, b = t / S, s = t % S;
    float q[64];
    const bf16* qp = QB + (((size_t)b * 8 + hh) * S + s) * 64;
#pragma unroll
    for (int d = 0; d < 64; ++d) q[d] = bf2f(qp[d]);
    const float* L = lut + (8 + hh) * LUTN + LUT_NEG;
    int qb = s / 256;
    float gate[8];
#pragma unroll
    for (int j = 0; j < 8; ++j) {
        float gsum = -INFINITY;
        if (j < qb) { gsum = 0.f; const float* km = ksum + (((size_t)b * 8 + hh) * 8 + j) * 64;
#pragma unroll
            for (int d = 0; d < 64; ++d) gsum += q[d] * km[d]; }
        gate[j] = gsum;
    }
    unsigned sel = 0; int nsel = qb < 3 ? qb : 3;
    for (int r = 0; r < nsel; ++r) { int best = -1; float bv = -INFINITY;
#pragma unroll
        for (int j = 0; j < 8; ++j) if (j < qb && !((sel >> j) & 1) && (best < 0 || gate[j] > bv)) { best = j; bv = gate[j]; }
        sel |= 1u << best; }
    sel |= 1u << qb;
    float m = NEGBIG, l = 0.f; float o[64];
#pragma unroll
    for (int d = 0; d < 64; ++d) o[d] = 0.f;
    for (int j = 0; j <= qb; ++j) {
        if (!((sel >> j) & 1)) continue;
        int kend = (j == qb) ? s : (j * 256 + 255);
        for (int kp = j * 256; kp <= kend; ++kp) {
            const bf16* kr = KB + (((size_t)b * 8 + hh) * S + kp) * 64;
            float sc = 0.f;
#pragma unroll
            for (int d = 0; d < 64; ++d) sc += q[d] * bf2f(kr[d]);
            sc += L[s - kp];
            float mn = fmaxf(m, sc), a = exp2f(m - mn), p = exp2f(sc - mn);
            l = l * a + p;
#pragma unroll
            for (int d = 0; d < 64; ++d) o[d] = o[d] * a + p * bf2f(VBT[(((size_t)b * 8 + hh) * 64 + d) * S + kp]);
            m = mn;
        }
    }
    float inv = 1.f / l, sq = 0.f;
#pragma unroll
    for (int d = 0; d < 64; ++d) { float ov = o[d] * inv; sq += ov * ov; att[(size_t)t * D + 512 + hh * 64 + d] = f2bf(ov * gain[hh * 64 + d]); }
    ssq[t * 16 + 8 + hh] = sq;
}
__global__ void k_outproj(const bf16* att, const float* ssq, const float* w_out, const float* x, const float* mod, float* x1) {
    int col = blockIdx.x * blockDim.x + threadIdx.x, t = blockIdx.y, b = t / S;
    float sa = 0.f, sb = 0.f; for (int i = 0; i < 8; ++i) { sa += ssq[t * 16 + i]; sb += ssq[t * 16 + 8 + i]; }
    float ra = rsqrtf(sa / 512.f + EPS), rb = rsqrtf(sb / 512.f + EPS);
    const bf16* ar = att + (size_t)t * D;
    float a0 = 0.f, a1 = 0.f;
    for (int k = 0; k < 512; ++k) a0 += bf2f(ar[k]) * w_out[(size_t)k * D + col];
    for (int k = 512; k < 1024; ++k) a1 += bf2f(ar[k]) * w_out[(size_t)k * D + col];
    float y = a0 * ra + a1 * rb;
    x1[(size_t)t * D + col] = x[(size_t)t * D + col] + mod[b * 6 * D + 2 * D + col] * y;
}
__global__ void k_router(const bf16* h2, const float* w_router, const float* e_bias, int* cnt, int* list, float* ew) {
    int t = blockIdx.x, e = threadIdx.x;
    __shared__ float sc[256], sel[256], gs[8]; __shared__ int chosen[8];
    const bf16* hr = h2 + (size_t)t * D;
    float acc = 0.f;
    for (int k = 0; k < D; ++k) acc += bf2f(hr[k]) * w_router[(size_t)k * NE + e];
    float s = 1.f / (1.f + __expf(-acc));
    sc[e] = s; sel[e] = s + e_bias[e];
    __syncthreads();
    if (e < 8) { float m1 = -INFINITY, m2 = -INFINITY;
        for (int i = 0; i < 32; ++i) { float v = sel[e * 32 + i]; if (v > m1) { m2 = m1; m1 = v; } else if (v > m2) m2 = v; }
        gs[e] = m1 + m2; }
    __syncthreads();
    if (e == 0) {
        unsigned gm = 0;
        for (int r = 0; r < 4; ++r) { int best = -1; float bv = 0.f;
            for (int g = 0; g < 8; ++g) if (!((gm >> g) & 1) && (best < 0 || gs[g] > bv)) { best = g; bv = gs[g]; }
            gm |= 1u << best; }
        float wsum = 0.f;
        for (int r = 0; r < 8; ++r) { int best = -1; float bv = 0.f;
            for (int i = 0; i < 256; ++i) { if (!((gm >> (i / 32)) & 1)) continue; bool used = false; for (int q = 0; q < r; ++q) used |= (chosen[q] == i);
                if (used) continue; if (best < 0 || sel[i] > bv) { best = i; bv = sel[i]; } }
            chosen[r] = best; wsum += sc[best]; }
        for (int r = 0; r < 8; ++r) { int ex = chosen[r]; int slot = atomicAdd(&cnt[ex], 1); list[(size_t)ex * NTOK + slot] = t * 8 + r; ew[t * 8 + r] = sc[ex] / wsum * 2.5f; }
    }
}
__global__ void k_moe(const bf16* h2, const int* cnt, const int* list, const float* ew, const float* w1, const float* w3, const float* w2,
                      const float* ws1, const float* ws3, const float* ws2, bf16* ybuf, bf16* ysh) {
    int e = blockIdx.y, g = blockIdx.x, tid = threadIdx.x;
    int n = (e < NE) ? cnt[e] : NTOK;
    if (g * 8 >= n) return;
    const float* W1 = (e < NE) ? w1 + (size_t)e * D * ED : ws1;
    const float* W3 = (e < NE) ? w3 + (size_t)e * D * ED : ws3;
    const float* W2 = (e < NE) ? w2 + (size_t)e * ED * D : ws2;
    __shared__ float xs[8][1024]; __shared__ float hs[8][256]; __shared__ int aid[8];
    if (tid < 8) { int i = g * 8 + tid; aid[tid] = (i < n) ? ((e < NE) ? list[(size_t)e * NTOK + i] : i) : -1; }
    __syncthreads();
    for (int r = 0; r < 8; ++r) { int a = aid[r]; int tok = (a < 0) ? 0 : ((e < NE) ? a / 8 : a);
        for (int k = tid; k < D; k += 256) xs[r][k] = (a < 0) ? 0.f : bf2f(h2[(size_t)tok * D + k]); }
    __syncthreads();
    float gg[8], uu[8];
#pragma unroll
    for (int r = 0; r < 8; ++r) { gg[r] = 0.f; uu[r] = 0.f; }
    for (int k = 0; k < D; ++k) { float a = W1[(size_t)k * ED + tid], b = W3[(size_t)k * ED + tid];
#pragma unroll
        for (int r = 0; r < 8; ++r) { gg[r] += xs[r][k] * a; uu[r] += xs[r][k] * b; } }
#pragma unroll
    for (int r = 0; r < 8; ++r) hs[r][tid] = gg[r] / (1.f + __expf(-gg[r])) * uu[r];
    __syncthreads();
    float y[8][4];
#pragma unroll
    for (int r = 0; r < 8; ++r) {
#pragma unroll
        for (int c = 0; c < 4; ++c) y[r][c] = 0.f; }
    for (int k = 0; k < ED; ++k) {
#pragma unroll
        for (int c = 0; c < 4; ++c) { float w = W2[(size_t)k * D + tid + 256 * c];
#pragma unroll
            for (int r = 0; r < 8; ++r) y[r][c] += hs[r][k] * w; } }
#pragma unroll
    for (int r = 0; r < 8; ++r) { int a = aid[r]; if (a < 0) continue;
        float wgt = (e < NE) ? ew[a] : 1.f; bf16* dst = (e < NE) ? ybuf + (size_t)a * D : ysh + (size_t)a * D;
#pragma unroll
        for (int c = 0; c < 4; ++c) dst[tid + 256 * c] = f2bf(y[r][c] * wgt); }
}
__global__ void k_final(const float* x1, const bf16* ybuf, const bf16* ysh, const float* mod, const float* fg, float* out) {
    int t = blockIdx.x, b = t / S, tid = threadIdx.x;
    __shared__ float red[256];
    float v[4]; float s = 0.f;
#pragma unroll
    for (int i = 0; i < 4; ++i) { int col = tid + 256 * i; float m = bf2f(ysh[(size_t)t * D + col]);
        for (int r = 0; r < 8; ++r) m += bf2f(ybuf[((size_t)t * 8 + r) * D + col]);
        v[i] = x1[(size_t)t * D + col] + mod[b * 6 * D + 5 * D + col] * m; s += v[i] * v[i]; }
    red[tid] = s; __syncthreads();
    for (int o = 128; o > 0; o >>= 1) { if (tid < o) red[tid] += red[tid + o]; __syncthreads(); }
    float rstd = rsqrtf(red[0] / D + EPS);
#pragma unroll
    for (int i = 0; i < 4; ++i) { int col = tid + 256 * i; out[(size_t)t * D + col] = v[i] * rstd * fg[col]; }
}

#define OPT_MASK 0xFF

#define LAS __attribute__((address_space(3)))
typedef short bf16x8 __attribute__((ext_vector_type(8)));
typedef float f32x16 __attribute__((ext_vector_type(16)));
typedef float f32x4 __attribute__((ext_vector_type(4)));
typedef unsigned u32x4 __attribute__((ext_vector_type(4)));
typedef unsigned u32x2 __attribute__((ext_vector_type(2)));

#ifndef FUSE45
#define FUSE45 1
#endif
constexpr int NTHR = 512, NWAVE = 8;
constexpr int LDS_CTL_OFF = 147456;
constexpr int LDS_BYTES = LDS_CTL_OFF + 1024;
constexpr size_t C_BAR = 768 * 1024;

__device__ __forceinline__ unsigned cvt_pk(float lo, float hi) { unsigned r; asm("v_cvt_pk_bf16_f32 %0, %1, %2" : "=v"(r) : "v"(lo), "v"(hi)); return r; }
__device__ __forceinline__ float wave_sum(float v) {
#pragma unroll
    for (int o = 1; o < 64; o <<= 1) v += __shfl_xor(v, o);
    return v;
}
#define MFMA32(a, b, c) __builtin_amdgcn_mfma_f32_32x32x16_bf16((a), (b), (c), 0, 0, 0)

#define XB_TMO      128
#define XB_XCNT(j)  (256  + 64 * (j))
#define XB_XSUB(j)  (1280 + 64 * (j))
#define XB_XGEN(j)  (2304 + 64 * (j))
#define XB_TOP      3328
#define XB_TOPGEN   3392
#define XCD_BAR_WORDS 3456
#define XB_SPIN_CAP (1u << 22)
__device__ __forceinline__ unsigned xb_ld(unsigned* p)              { return __hip_atomic_load(p, __ATOMIC_RELAXED, __HIP_MEMORY_SCOPE_AGENT); }
__device__ __forceinline__ unsigned xb_add(unsigned* p, unsigned v) { return __hip_atomic_fetch_add(p, v, __ATOMIC_RELAXED, __HIP_MEMORY_SCOPE_AGENT); }
__device__ __forceinline__ unsigned xb_xcc_id() { return (unsigned)__builtin_amdgcn_s_getreg((3 << 11) | 20) & 0xFu; }
#define XB_SPIN(cond, bar) do { unsigned _sp = 0; while (cond) { __builtin_amdgcn_s_sleep(1); \
    if ((++_sp & 255u) == 0u) { if (xb_ld(&(bar)[XB_TMO])) break; if (_sp > XB_SPIN_CAP) { atomicAdd(&(bar)[XB_TMO], 1u); break; } } } } while (0)
struct XcdBarrier { unsigned* bar; unsigned x; volatile LAS unsigned* st; };
__device__ __forceinline__ XcdBarrier xcd_barrier_post(unsigned* bar, volatile LAS unsigned* st) {
    XcdBarrier b; b.bar = bar; b.x = xb_xcc_id(); b.st = st;
    if (threadIdx.x == 0) (void)xb_add(&bar[XB_XCNT(b.x)], 1u);
    return b;
}
__device__ __forceinline__ void xcd_barrier_complete(unsigned* bar, unsigned x, unsigned& nloc, unsigned& nx) {
    const unsigned G = gridDim.x * gridDim.y * gridDim.z;
    unsigned sum, cnt, mine, sp = 0u;
    for (;;) {
        sum = 0u; cnt = 0u; mine = 0u;
#pragma unroll
        for (unsigned j = 0; j < 16; ++j) { const unsigned c = xb_ld(&bar[XB_XCNT(j)]); sum += c; cnt += (c > 0u) ? 1u : 0u; mine = (j == x) ? c : mine; }
        if (sum == G) break;
        __builtin_amdgcn_s_sleep(1);
        if ((++sp & 255u) == 0u) { if (xb_ld(&bar[XB_TMO])) break; if (sp > XB_SPIN_CAP) { atomicAdd(&bar[XB_TMO], 1u); break; } }
    }
    nloc = mine > 0u ? mine : 1u; nx = cnt > 0u ? cnt : 1u;
}
__device__ __forceinline__ void xcd_barrier(const XcdBarrier& b) {
    asm volatile("s_waitcnt vmcnt(0)" ::: "memory");
    __syncthreads();
    if (threadIdx.x == 0) {
        unsigned* bar = b.bar;
        __builtin_amdgcn_s_waitcnt(0);
        unsigned nloc = b.st[0], nx = b.st[1];
        if (nloc == 0u) { xcd_barrier_complete(bar, b.x, nloc, nx); b.st[0] = nloc; b.st[1] = nx; }
        const unsigned old = xb_add(&bar[XB_XSUB(b.x)], 1u);
        const unsigned gen = old / nloc;
        if (old + 1u == (gen + 1u) * nloc) {
            __builtin_amdgcn_fence(__ATOMIC_RELEASE, "agent");
            asm volatile("s_waitcnt vmcnt(0)" ::: "memory");
            const unsigned og = xb_add(&bar[XB_TOP], 1u);
            const unsigned tg = og / nx;
            if (og + 1u == (tg + 1u) * nx) xb_add(&bar[XB_TOPGEN], 1u);
            else XB_SPIN(xb_ld(&bar[XB_TOPGEN]) == tg, bar);
            __builtin_amdgcn_fence(__ATOMIC_ACQUIRE, "agent");
            xb_add(&bar[XB_XGEN(b.x)], 1u);
            asm volatile("s_waitcnt vmcnt(0)" ::: "memory");
        } else {
            XB_SPIN(xb_ld(&bar[XB_XGEN(b.x)]) == gen, bar);
            __builtin_amdgcn_fence(__ATOMIC_ACQUIRE, "agent");
            asm volatile("s_waitcnt vmcnt(0)" ::: "memory");
        }
    }
    __syncthreads();
}

struct Args {
    const float *x, *c, *w_ada, *b_ada, *norm1_g, *w_in, *sinks, *rel_table, *out_norm_a, *out_norm_b, *w_out, *norm2_g, *w_router, *e_bias,
                *w1, *w3, *w2, *ws1, *ws3, *ws2, *final_g;
    float* out; unsigned char* ws; int ph_lo, ph_hi;
};

template <int RM, int RN, int WM, int WN, int KR, bool A_RES, bool SWAP, int PD = 2, int BMD = 0, int DBG = 0>
struct GemmCore {
    static constexpr bool BT = (BMD == 1), PUB = (BMD == 2), F8 = (BMD == 3);
    static constexpr int BM = 32 * RM * WM, BN = 32 * RN * WN;
    static constexpr int A_BYTES = BM * 64, B_BYTES = BN * 64, STAGE = (A_RES ? 0 : A_BYTES) + B_BYTES;
    static constexpr int NA = (BM * 4 + NTHR - 1) / NTHR;
    static constexpr int BTASKS = BT ? BN * 4 : F8 ? BN * 2 : (32 / KR) * (BN / 4), NBT = BTASKS / NTHR, NBR = (BT || F8) ? 1 : KR, F8TILE = BN * 32;
    static_assert(!PUB || KR == 8, "publishing needs 8 k-rows per task");
    static_assert(WM * WN == NWAVE && BTASKS % NTHR == 0 && (KR == 2 || KR == 4 || KR == 8), "GemmCore geometry");
    static constexpr int LDS_NEED = 2 * STAGE;

    template <class AF, class BF>
    static __device__ __forceinline__ void run(LAS unsigned char* lds, AF arow, BF bsrc, int ldb, int nk, f32x16 (&acc)[RM][RN], LAS unsigned char* ares, unsigned char* f8p = nullptr, float pscale = 1.f, int rot = 0) {
        run_h(lds, arow, bsrc, ldb, nk, acc, ares, [](int, f32x16 (&)[RM][RN]) {}, f8p, pscale, rot);
    }
    template <class AF, class BF, class HK>
    static __device__ __forceinline__ void run_h(LAS unsigned char* lds, AF arow, BF bsrc, int ldb, int nk, f32x16 (&acc)[RM][RN], LAS unsigned char* ares, HK hook, unsigned char* f8p = nullptr, float pscale = 1.f, int rot = 0) {
        int tid = threadIdx.x; asm volatile("" : "+v"(tid));
        const int lane = tid & 63, wave = __builtin_amdgcn_readfirstlane(tid >> 6);
        const int wm = wave / WN, wn = wave % WN, h = lane >> 5, l31 = lane & 31;
        const bf16* ap[NA]; int awo[NA]; bool aval[NA];
#pragma unroll
        for (int i = 0; i < NA; ++i) { const int p = tid + NTHR * i, row = (p >> 2) % BM, ch = p & 3; const bf16* rp = A_RES ? nullptr : arow(row);
            aval[i] = !A_RES && rp != nullptr && (NA * NTHR == BM * 4 || p < BM * 4); ap[i] = rp + ch * 8; awo[i] = row * 64 + ((ch ^ ((row >> 2) & 3)) << 4); }
        decltype(bsrc(0)) bp[NBT]; int bwo[NBT];
#pragma unroll
        for (int i = 0; i < NBT; ++i) { const int q = tid + NTHR * i;
            if constexpr (BT) { const int col = q >> 2, ch = q & 3; bp[i] = bsrc(col) + ch * 8; bwo[i] = col * 64 + ((ch ^ ((col >> 2) & 3)) << 4); }
            else if constexpr (F8) { bp[i] = nullptr; bwo[i] = 0; }
            else { const int cg = q % (BN / 4), kg = q / (BN / 4);
                bp[i] = bsrc(4 * cg) + (size_t)(KR * kg) * ldb;
                const int ch = (KR == 8) ? kg : (KR == 4) ? (kg >> 1) : (kg >> 2), hf = (KR == 8) ? 0 : (KR == 4) ? (kg & 1) * 8 : (kg & 3) * 4;
                bwo[i] = (4 * cg) * 64 + ((ch ^ (cg & 3)) << 4) + hf; } }
        const int swz = (l31 >> 2) & 3;
        const int xs0 = ((0 + h) ^ swz) << 4, xs1 = ((2 + h) ^ swz) << 4;
        const int aro = (wm * RM * 32 + l31) * 64, bro = (wn * RN * 32 + l31) * 64;
        constexpr int NSET = PD < 1 ? 1 : PD;
        u32x4 aregs[NSET][NA]; f32x4 bregs[NSET][NBT][NBR];
#pragma unroll
        for (int d = 0; d < NSET; ++d)
#pragma unroll
            for (int i = 0; i < NA; ++i) aregs[d][i] = (u32x4){0u, 0u, 0u, 0u};
        auto gload = [&](u32x4 (&areg)[NA], f32x4 (&breg)[NBT][NBR], int ks0) {
            const int ks = (ks0 + rot) & (nk - 1);
            if (!A_RES) {
#pragma unroll
                for (int i = 0; i < NA; ++i) if (aval[i]) areg[i] = *(const u32x4*)(ap[i] + (size_t)ks * 32);
            }
#pragma unroll
            for (int i = 0; i < NBT; ++i) {
                if (DBG & 8) continue;
                if constexpr (BT) breg[i][0] = *(const f32x4*)(bp[i] + (size_t)ks * 32);
                else if constexpr (F8) breg[i][0] = *(const f32x4*)(f8p + (size_t)ks * F8TILE + (size_t)(tid + NTHR * i) * 16);
                else {
#pragma unroll
                    for (int r = 0; r < KR; ++r) breg[i][r] = *(const f32x4*)(bp[i] + ((size_t)ks * 32 + r) * ldb); }
            }
        };
        constexpr int NSLOT = 2 * (RM <= RN ? RN : RM);
        constexpr int BITEMS = BT ? NBT : F8 ? NBT * 2 : NBT * 4, NITEM = (A_RES ? 0 : NA) + BITEMS;
        auto lwrite = [&](const u32x4 (&areg)[NA], const f32x4 (&breg)[NBT][NBR], int buf, int ks0, int slot) {
            const int ks = (ks0 + rot) & (nk - 1); (void)ks;
            LAS unsigned char* sb = lds + buf * STAGE;
            LAS unsigned char* bb = sb + (A_RES ? 0 : A_BYTES);
#pragma unroll
            for (int it = 0; it < NITEM; ++it) {
                if (slot >= 0 && (it % NSLOT) != slot) continue;
                if (!A_RES && it < NA) { const int i = it; if (NA * NTHR == BM * 4 || tid + NTHR * i < BM * 4) *(LAS u32x4*)(sb + awo[i]) = areg[i]; continue; }
                const int bi = it - (A_RES ? 0 : NA);
                if (DBG & 4) continue;
                if constexpr (BT) { *(LAS f32x4*)(bb + bwo[bi]) = breg[bi][0]; }
                else if constexpr (F8) {
                    const int i = bi >> 1, hf = bi & 1;
                    const int p = tid + NTHR * i, q = p >> 1, jp = p & 1, cg = q % (BN / 4), kg = q / (BN / 4), col = 4 * cg + 2 * jp + hf;
                    const u32x4 raw = __builtin_bit_cast(u32x4, breg[i][0]); unsigned o[4];
#pragma unroll
                    for (int d = 0; d < 2; ++d) { const auto lo = __builtin_amdgcn_cvt_pk_f32_fp8((int)raw[2 * hf + d], false), hi = __builtin_amdgcn_cvt_pk_f32_fp8((int)raw[2 * hf + d], true);
                        o[2 * d] = cvt_pk(lo[0], lo[1]); o[2 * d + 1] = cvt_pk(hi[0], hi[1]); }
                    *(LAS u32x4*)(bb + col * 64 + ((kg ^ (cg & 3)) << 4)) = (u32x4){o[0], o[1], o[2], o[3]};
                } else {
                    const int i = bi >> 2, j = bi & 3;
                    if (KR == 8) { u32x4 w; w.x = cvt_pk(breg[i][0][j], breg[i][1][j]); w.y = cvt_pk(breg[i][2][j], breg[i][3][j]); w.z = cvt_pk(breg[i][4][j], breg[i][5][j]); w.w = cvt_pk(breg[i][6][j], breg[i][7][j]);
                        *(LAS u32x4*)(bb + bwo[i] + j * 64) = w;
                        if constexpr (PUB) {
                            int p0 = __builtin_amdgcn_cvt_pk_fp8_f32(breg[i][0][j] * pscale, breg[i][1][j] * pscale, 0, false); p0 = __builtin_amdgcn_cvt_pk_fp8_f32(breg[i][2][j] * pscale, breg[i][3][j] * pscale, p0, true);
                            int p1 = __builtin_amdgcn_cvt_pk_fp8_f32(breg[i][4][j] * pscale, breg[i][5][j] * pscale, 0, false); p1 = __builtin_amdgcn_cvt_pk_fp8_f32(breg[i][6][j] * pscale, breg[i][7][j] * pscale, p1, true);
                            *(u32x2*)(f8p + (size_t)ks * F8TILE + (size_t)(tid + NTHR * i) * 32 + j * 8) = (u32x2){(unsigned)p0, (unsigned)p1}; } }
                    else if (KR == 4) { u32x2 w; w.x = cvt_pk(breg[i][0][j], breg[i][1][j]); w.y = cvt_pk(breg[i][2][j], breg[i][3][j]); *(LAS u32x2*)(bb + bwo[i] + j * 64) = w; }
                    else { *(LAS unsigned*)(bb + bwo[i] + j * 64) = cvt_pk(breg[i][0][j], breg[i][1][j]); }
                }
            }
        };
        auto step = [&](int ks0, int cur, const u32x4 (&aw)[NA], const f32x4 (&bw)[NBT][NBR], int wbuf, int wks, bool dowrite) {
            const int ks = (ks0 + rot) & (nk - 1);
            const LAS unsigned char* abase = A_RES ? (ares + ks * A_BYTES) : (lds + cur * STAGE);
            const LAS unsigned char* bbase = lds + cur * STAGE + (A_RES ? 0 : A_BYTES);
#pragma unroll
            for (int s = 0; s < 2; ++s) {
                const int xs = s ? xs1 : xs0;
                if constexpr (RM <= RN) {
                    bf16x8 af[RM];
                    if (!(DBG & 2)) {
#pragma unroll
                        for (int rb = 0; rb < RM; ++rb) af[rb] = *(const LAS bf16x8*)(abase + aro + rb * 2048 + xs); }
#pragma unroll
                    for (int cb = 0; cb < RN; ++cb) {
                        if (!(DBG & 2)) { const bf16x8 bfv = *(const LAS bf16x8*)(bbase + bro + cb * 2048 + xs);
#pragma unroll
                            for (int rb = 0; rb < RM; ++rb) { if (DBG & 1) { asm volatile("" :: "v"(bfv), "v"(af[rb])); } else acc[rb][cb] = SWAP ? MFMA32(bfv, af[rb], acc[rb][cb]) : MFMA32(af[rb], bfv, acc[rb][cb]); } }
                        if (dowrite) lwrite(aw, bw, wbuf, wks, s * RN + cb);
                    }
                } else {
                    bf16x8 bfv[RN];
                    if (!(DBG & 2)) {
#pragma unroll
                        for (int cb = 0; cb < RN; ++cb) bfv[cb] = *(const LAS bf16x8*)(bbase + bro + cb * 2048 + xs); }
#pragma unroll
                    for (int rb = 0; rb < RM; ++rb) {
                        if (!(DBG & 2)) { const bf16x8 af = *(const LAS bf16x8*)(abase + aro + rb * 2048 + xs);
#pragma unroll
                            for (int cb = 0; cb < RN; ++cb) acc[rb][cb] = SWAP ? MFMA32(bfv[cb], af, acc[rb][cb]) : MFMA32(af, bfv[cb], acc[rb][cb]); }
                        if (dowrite) lwrite(aw, bw, wbuf, wks, s * RM + rb);
                    }
                }
            }
        };
        if constexpr (PD >= 2) {
            static_assert(PD % 2 == 0, "PD even");
#pragma unroll
            for (int d = 0; d < PD; ++d) gload(aregs[d], bregs[d], d);
            lwrite(aregs[0], bregs[0], 0, 0, -1); __syncthreads();
#pragma unroll 1
            for (int ks0 = 0; ks0 < nk; ks0 += PD) {
#pragma unroll
                for (int d = 0; d < PD; ++d) {
                    const int ks = ks0 + d;
                    gload(aregs[d], bregs[d], min(ks + PD, nk - PD + d));
                    asm volatile("" ::: "memory");
                    if (d == 0) hook(ks, acc);
                    step(ks, d & 1, aregs[(d + 1) % PD], bregs[(d + 1) % PD], (d + 1) & 1, min(ks + 1, nk - 1), true);
                    __syncthreads();
                }
            }
            asm volatile("s_waitcnt vmcnt(0)" ::: "memory");
        } else {
            gload(aregs[0], bregs[0], 0); lwrite(aregs[0], bregs[0], 0, 0, -1); __syncthreads();
#pragma unroll 1
            for (int ks = 0; ks < nk; ++ks) {
                const int cur = ks & 1;
                if (ks + 1 < nk) gload(aregs[0], bregs[0], ks + 1);
                hook(ks, acc);
                step(ks, cur, aregs[0], bregs[0], 0, 0, false);
                if (ks + 1 < nk) lwrite(aregs[0], bregs[0], cur ^ 1, ks + 1, -1);
                __syncthreads();
            }
        }
    }
};
template <int RM, int RN> __device__ __forceinline__ void zero_acc(f32x16 (&acc)[RM][RN]) {
#pragma unroll
    for (int a = 0; a < RM; ++a)
#pragma unroll
        for (int b = 0; b < RN; ++b)
#pragma unroll
            for (int r = 0; r < 16; ++r) acc[a][b][r] = 0.f;
}
__device__ __forceinline__ int roff(int r, int h) { return (r & 3) + 8 * (r >> 2) + 4 * h; }

__device__ __forceinline__ void phase0(const Args& a, LAS unsigned char* lds, int vcu, int G) {
    const int tid = threadIdx.x, lane = tid & 63, wave = tid >> 6;
    float* mod = (float*)(a.ws + C_MOD); float* lut = (float*)(a.ws + WS_LUT);
    LAS float* sc = (LAS float*)lds;
    for (int i = tid; i < NB * D; i += NTHR) { float cv = a.c[i]; sc[i] = cv / (1.f + __expf(-cv)); }
    __syncthreads();
    LAS float* red = (LAS float*)(lds + 32768);
    for (int u = vcu; u < 192; u += G) {
        const int col = u * 32 + (lane & 31), rp = lane >> 5, k0 = wave * 128 + rp;
        float acc[NB];
#pragma unroll
        for (int b = 0; b < NB; ++b) acc[b] = 0.f;
#pragma unroll 16
        for (int i = 0; i < 64; ++i) { const float w = a.w_ada[(size_t)(k0 + 2 * i) * (6 * D) + col];
#pragma unroll
            for (int b = 0; b < NB; ++b) acc[b] += sc[b * D + k0 + 2 * i] * w; }
#pragma unroll
        for (int b = 0; b < NB; ++b) { acc[b] += __shfl_xor(acc[b], 32); if (rp == 0) red[(wave * NB + b) * 32 + lane] = acc[b]; }
        __syncthreads();
        if (tid < 256) { const int b = tid >> 5, c = tid & 31; float s = 0.f;
#pragma unroll
          for (int w = 0; w < NWAVE; ++w) s += red[(w * NB + b) * 32 + c];
          mod[b * 6 * D + u * 32 + c] = s + a.b_ada[u * 32 + c]; }
        __syncthreads();
    }
    {
        LAS float* scr = (LAS float*)(lds + 49152 + wave * 8448);
        constexpr int I_IN = 16 * (INC / 32), I_OUT = 16 * (D / 32), I_R = 16 * (NE / 32), I_S = 16 * (ED / 32), I_S2 = 4 * (D / 32), NIT = I_IN + I_OUT + I_R + 2 * I_S + I_S2;
        for (int it = vcu * NWAVE + wave; it < NIT; it += G * NWAVE) {
            const float* W; int N, KD = D, roff0 = 0; bf16* WT; int r = it; bool ksm = false;
            if (r < I_IN) { W = a.w_in; N = INC; WT = (bf16*)(a.ws + WS_WTIN); }
            else if ((r -= I_IN) < I_OUT) { W = a.w_out; N = D; WT = (bf16*)(a.ws + WS_WTOUT); ksm = (FUSE45 != 0); }
            else if ((r -= I_OUT) < I_R) { W = a.w_router; N = NE; WT = (bf16*)(a.ws + WS_WTR); ksm = (FUSE45 != 0); }
            else if ((r -= I_R) < I_S) { W = a.ws1; N = ED; WT = (bf16*)(a.ws + WS_WS13T); }
            else if ((r -= I_S) < I_S) { W = a.ws3; N = ED; WT = (bf16*)(a.ws + WS_WS13T); roff0 = ED; }
            else { r -= I_S; W = a.ws2; N = D; KD = ED; WT = (bf16*)(a.ws + WS_WS2T); }
            const int nblk = N / 32, kb = r / nblk, nb = r % nblk, k0 = 64 * kb, n0 = 32 * nb;
#pragma unroll 8
            for (int i = 0; i < 32; ++i) { const int kk = 2 * i + (lane >> 5); scr[kk * 33 + (lane & 31)] = W[(size_t)(k0 + kk) * N + n0 + (lane & 31)]; }
            asm volatile("s_waitcnt lgkmcnt(0)" ::: "memory");
            const int c = lane & 7;
#pragma unroll
            for (int j = 0; j < 4; ++j) { const int nn = (lane >> 3) + 8 * j; const LAS float* s = scr + (8 * c) * 33 + nn;
                u32x4 o; o.x = cvt_pk(s[0 * 33], s[1 * 33]); o.y = cvt_pk(s[2 * 33], s[3 * 33]); o.z = cvt_pk(s[4 * 33], s[5 * 33]); o.w = cvt_pk(s[6 * 33], s[7 * 33]);
                const int kq = k0 + 8 * c;
                if (ksm) *(u32x4*)(WT + ((size_t)(kq >> 5) * N + n0 + nn) * 32 + (kq & 31)) = o;
                else *(u32x4*)(WT + (size_t)(roff0 + n0 + nn) * KD + kq) = o; }
            asm volatile("s_waitcnt lgkmcnt(0)" ::: "memory");
        }
    }
    for (int i = vcu * NTHR + tid; i < 16 * LUTN; i += G * NTHR) {
        const int hh = i / LUTN, p = i % LUTN, dist = p - LUT_NEG;
        float v = NEGBIG;
        const bool ok = dist >= 0 && (hh < 8 ? dist < 128 : dist < S);
        if (ok) v = a.rel_table[t5_bucket(dist) * 16 + hh] * LOG2E;
        lut[i] = v;
    }
}
__device__ __forceinline__ void norm_mod_row(const float* xr, const float* g, const float* sh, const float* scl, bf16* orow, int lane, unsigned char* o8 = nullptr) {
    f32x4 v[4]; float s = 0.f;
#pragma unroll
    for (int j = 0; j < 4; ++j) { v[j] = *(const f32x4*)(xr + j * 256 + lane * 4); s += (v[j].x * v[j].x + v[j].y * v[j].y) + (v[j].z * v[j].z + v[j].w * v[j].w); }
    const float rstd = rsqrtf(wave_sum(s) * (1.f / D) + EPS);
#pragma unroll
    for (int j = 0; j < 4; ++j) { const int c = j * 256 + lane * 4;
        const f32x4 gg = *(const f32x4*)(g + c), s1 = *(const f32x4*)(scl + c), s0 = *(const f32x4*)(sh + c);
        const float o0 = v[j].x * rstd * gg.x * (1.f + s1.x) + s0.x, o1 = v[j].y * rstd * gg.y * (1.f + s1.y) + s0.y;
        const float o2 = v[j].z * rstd * gg.z * (1.f + s1.z) + s0.z, o3 = v[j].w * rstd * gg.w * (1.f + s1.w) + s0.w;
        u32x2 w; w.x = cvt_pk(o0, o1); w.y = cvt_pk(o2, o3); *(u32x2*)(orow + c) = w;
        if (o8) { int p = __builtin_amdgcn_cvt_pk_fp8_f32(o0, o1, 0, false); p = __builtin_amdgcn_cvt_pk_fp8_f32(o2, o3, p, true); *(int*)(o8 + c) = p; } }
}
__device__ __forceinline__ void phase1(const Args& a, int vcu, int G) {
    const int lane = threadIdx.x & 63, gw = vcu * NWAVE + (threadIdx.x >> 6), NGW = G * NWAVE;
    const float* mod = (const float*)(a.ws + C_MOD); bf16* H = (bf16*)(a.ws + WS_H);
    for (int t = gw; t < NTOK; t += NGW) { const int b = t / S;
        norm_mod_row(a.x + (size_t)t * D, a.norm1_g, mod + b * 6 * D, mod + b * 6 * D + D, H + (size_t)t * D, lane); }
}
__device__ __forceinline__ void phase2(const Args& a, LAS unsigned char* lds, int vcu, int G) {
    typedef GemmCore<4, 2, 2, 4, 4, false, false, 2, 1> GC;
    const int lane = threadIdx.x & 63, wave = __builtin_amdgcn_readfirstlane(threadIdx.x >> 6), wm = wave / 4, wn = wave % 4, h = lane >> 5, l31 = lane & 31;
    const bf16* H = (const bf16*)(a.ws + WS_H); const bf16* WT = (const bf16*)(a.ws + WS_WTIN);
    bf16* QA = (bf16*)(a.ws + WS_QA); bf16* KA = (bf16*)(a.ws + WS_KA); bf16* VAT = (bf16*)(a.ws + WS_VAT);
    bf16* QB = (bf16*)(a.ws + WS_QB); bf16* KB = (bf16*)(a.ws + WS_KB); bf16* VBT = (bf16*)(a.ws + WS_VBT); float* ksum = (float*)(a.ws + C_KSUM);
    constexpr int NPM = NTOK / 256, NPN = INC / 256;
    for (int u = vcu; u < NPM * NPN; u += G) {
        const int pm = u / NPN, pn = u % NPN;
        f32x16 acc[4][2]; zero_acc(acc);
        const bf16* Ab = H + (size_t)pm * 256 * D; const bf16* Wb = WT + (size_t)pn * 256 * D;
        GC::run(lds, [&](int r) { return Ab + (size_t)r * D; }, [&](int c) { return Wb + (size_t)c * D; }, D, D / 32, acc, nullptr);
        const int b = (pm * 256) / S, s0 = (pm * 256) % S + wm * 128;
#pragma unroll
        for (int cb = 0; cb < 2; ++cb) {
            const int col = pn * 256 + wn * 64 + cb * 32 + l31;
            int kind, hh, d;
            bf16* base; int nh; bool isKB = false;
            if (col < 512)       { kind = 0; hh = col >> 6; d = col & 63; base = QA; nh = 8; }
            else if (col < 640)  { kind = 1; hh = (col - 512) >> 6; d = col & 63; base = KA; nh = 2; }
            else if (col < 768)  { kind = 2; hh = (col - 640) >> 6; d = col & 63; base = VAT; nh = 2; }
            else if (col < 1280) { kind = 0; hh = (col - 768) >> 6; d = col & 63; base = QB; nh = 8; }
            else if (col < 1792) { kind = 1; hh = (col - 1280) >> 6; d = col & 63; base = KB; nh = 8; isKB = true; }
            else                 { kind = 2; hh = (col - 1792) >> 6; d = col & 63; base = VBT; nh = 8; }
            if (kind == 2) {
                bf16* vp = base + ((size_t)(b * nh + hh) * 64 + d) * S + s0;
#pragma unroll
                for (int rb = 0; rb < 4; ++rb)
#pragma unroll
                    for (int g4 = 0; g4 < 4; ++g4) { u32x2 w; w.x = cvt_pk(acc[rb][cb][4 * g4], acc[rb][cb][4 * g4 + 1]); w.y = cvt_pk(acc[rb][cb][4 * g4 + 2], acc[rb][cb][4 * g4 + 3]);
                        *(u32x2*)(vp + rb * 32 + 8 * g4 + 4 * h) = w; }
            } else {
                const float sc = (kind == 0) ? QSCALE : 1.f;
                bf16* qp = base + ((size_t)(b * nh + hh) * S + s0) * 64 + d;
                float csum = 0.f;
#pragma unroll
                for (int rb = 0; rb < 4; ++rb)
#pragma unroll
                    for (int r = 0; r < 16; ++r) { const float v = acc[rb][cb][r]; csum += v; qp[(size_t)(rb * 32 + roff(r, h)) * 64] = f2bf(v * sc); }
                if (isKB) { csum += __shfl_xor(csum, 32); if (h == 0) atomicAdd(&ksum[((size_t)(b * 8 + hh) * 8 + (s0 >> 8)) * 64 + d], csum); }
            }
        }
    }
}
constexpr int KT_STRIDE = 144, VT_STRIDE = 528;
constexpr int AT_K_OFF = 0, AT_V_OFF = 256 * KT_STRIDE  , AT_LUT_OFF = AT_V_OFF + 64 * VT_STRIDE  , AT_KS_OFF = AT_LUT_OFF + 10240, AT_END = AT_KS_OFF + 2048;
struct AttnSt { f32x16 o0, o1; float m, l; };
__device__ __forceinline__ void attn_tile(const LAS unsigned char* lds, int kt, int lut_idx, const bf16x8 (&bq)[4], AttnSt& st, int lane) {
    const int i = lane & 31, hh = lane >> 5;
    const int kap = (i & 0x13) | ((i & 4) << 1) | ((i & 8) >> 1);
    const LAS unsigned char* kp = lds + AT_K_OFF + (kt * 32 + kap) * KT_STRIDE + 16 * hh;
    f32x16 p;
#pragma unroll
    for (int r = 0; r < 16; ++r) p[r] = 0.f;
#pragma unroll
    for (int s = 0; s < 4; ++s) { const bf16x8 kf = *(const LAS bf16x8*)(kp + 32 * s); p = MFMA32(kf, bq[s], p); }
    const LAS float* lp = (const LAS float*)(lds + AT_LUT_OFF) + lut_idx;
    float tmax = NEGBIG;
#pragma unroll
    for (int r = 0; r < 16; ++r) { p[r] += lp[23 - (16 * (r >> 3) + (r & 7))]; tmax = fmaxf(tmax, p[r]); }
    tmax = fmaxf(tmax, __shfl_xor(tmax, 32));
    const float mn = fmaxf(st.m, tmax), alpha = exp2f(st.m - mn);
    float ps = 0.f;
#pragma unroll
    for (int r = 0; r < 16; ++r) { p[r] = exp2f(p[r] - mn); ps += p[r]; }
    st.l = st.l * alpha + ps; st.m = mn;
#pragma unroll
    for (int r = 0; r < 16; ++r) { st.o0[r] *= alpha; st.o1[r] *= alpha; }
    bf16x8 pb[2];
#pragma unroll
    for (int s = 0; s < 2; ++s) { u32x4 w; w.x = cvt_pk(p[8 * s], p[8 * s + 1]); w.y = cvt_pk(p[8 * s + 2], p[8 * s + 3]); w.z = cvt_pk(p[8 * s + 4], p[8 * s + 5]); w.w = cvt_pk(p[8 * s + 6], p[8 * s + 7]);
        pb[s] = __builtin_bit_cast(bf16x8, w); }
    const LAS unsigned char* vp = lds + AT_V_OFF + i * VT_STRIDE + (kt * 32 + 8 * hh) * 2;
#pragma unroll
    for (int s = 0; s < 2; ++s) {
        const bf16x8 v0 = *(const LAS bf16x8*)(vp + 32 * s), v1 = *(const LAS bf16x8*)(vp + 32 * VT_STRIDE + 32 * s);
        st.o0 = MFMA32(v0, pb[s], st.o0); st.o1 = MFMA32(v1, pb[s], st.o1);
    }
}
__device__ __forceinline__ void attn_stage(LAS unsigned char* lds, const bf16* kg, const bf16* vtg, int tid) {
#pragma unroll
    for (int i = 0; i < 4; ++i) { const int p = tid + NTHR * i, key = p >> 3, c = p & 7;
        *(LAS u32x4*)(lds + AT_K_OFF + key * KT_STRIDE + c * 16) = *(const u32x4*)(kg + (size_t)key * 64 + c * 8); }
#pragma unroll
    for (int i = 0; i < 4; ++i) { const int p = tid + NTHR * i, d = p >> 5, c = p & 31;
        *(LAS u32x4*)(lds + AT_V_OFF + d * VT_STRIDE + c * 16) = *(const u32x4*)(vtg + (size_t)d * S + c * 8); }
}
__device__ __forceinline__ void attn_init(AttnSt& st) {
#pragma unroll
    for (int r = 0; r < 16; ++r) { st.o0[r] = 0.f; st.o1[r] = 0.f; }
    st.m = NEGBIG; st.l = 0.f;
}
__device__ __forceinline__ void attn_loadq(const bf16* qrow, bf16x8 (&bq)[4], int lane) {
    const int hh = lane >> 5;
#pragma unroll
    for (int s = 0; s < 4; ++s) bq[s] = *(const bf16x8*)(qrow + 16 * s + 8 * hh);
}
__device__ __forceinline__ void attn_finish(AttnSt& st, bool has_sink, float sink_l2, const float* gain, bf16* attrow, float* ssq_tok, int lane) {
    const int hh = lane >> 5;
    float l = st.l + __shfl_xor(st.l, 32), inv;
    if (has_sink) { const float mn = fmaxf(st.m, sink_l2), al = exp2f(st.m - mn); l = l * al + exp2f(sink_l2 - mn); inv = al / l; } else inv = 1.f / l;
    float sq = 0.f;
#pragma unroll
    for (int db = 0; db < 2; ++db)
#pragma unroll
        for (int g4 = 0; g4 < 4; ++g4) { const int d0 = db * 32 + 8 * g4 + 4 * hh; const f32x4 gg = *(const f32x4*)(gain + d0);
            const f32x16& o = db ? st.o1 : st.o0;
            const float v0 = o[4 * g4] * inv, v1 = o[4 * g4 + 1] * inv, v2 = o[4 * g4 + 2] * inv, v3 = o[4 * g4 + 3] * inv;
            sq += (v0 * v0 + v1 * v1) + (v2 * v2 + v3 * v3);
            u32x2 w; w.x = cvt_pk(v0 * gg.x, v1 * gg.y); w.y = cvt_pk(v2 * gg.z, v3 * gg.w); *(u32x2*)(attrow + d0) = w; }
    sq += __shfl_xor(sq, 32);
    if (hh == 0) *ssq_tok = sq;
}
__device__ __forceinline__ void phase3(const Args& a, LAS unsigned char* lds, int vcu, int G) {
    const int tid = threadIdx.x, lane = tid & 63, wave = __builtin_amdgcn_readfirstlane(tid >> 6), l31 = lane & 31, hh2 = lane >> 5;
    const bf16* QA = (const bf16*)(a.ws + WS_QA); const bf16* KA = (const bf16*)(a.ws + WS_KA); const bf16* VAT = (const bf16*)(a.ws + WS_VAT);
    const bf16* QB = (const bf16*)(a.ws + WS_QB); const bf16* KB = (const bf16*)(a.ws + WS_KB); const bf16* VBT = (const bf16*)(a.ws + WS_VBT);
    const float* ksum = (const float*)(a.ws + C_KSUM); const float* lut = (const float*)(a.ws + WS_LUT);
    bf16* ATT = (bf16*)(a.ws + WS_ATT); float* ssq = (float*)(a.ws + WS_SSQ);
    LAS float* lutl = (LAS float*)(lds + AT_LUT_OFF); LAS float* ksl = (LAS float*)(lds + AT_KS_OFF);
    for (int uu = vcu; uu < 256; uu += G) {
        const int bh = uu >> 2, b = bh >> 3, hd = bh & 7;
        for (int half = 0; half < 2; ++half) {
            const int qb = half ? (uu & 3) : 7 - (uu & 3);
            __syncthreads();
            for (int i = tid; i < LUTN; i += NTHR) lutl[i] = lut[(8 + hd) * LUTN + i];
            if (tid < 512) ksl[tid] = ksum[((size_t)bh * 8) * 64 + tid];
            const bf16* kbase = KB + (size_t)bh * S * 64; const bf16* vbase = VBT + (size_t)bh * 64 * S;
            attn_stage(lds, kbase + (size_t)qb * 256 * 64, vbase + qb * 256, tid);
            const int q0 = qb * 256 + wave * 32, qpos = q0 + l31;
            bf16x8 bq[4]; attn_loadq(QB + ((size_t)bh * S + qpos) * 64, bq, lane);
            __syncthreads();
            unsigned sel = 0;
            {
                float g[7];
#pragma unroll
                for (int j = 0; j < 7; ++j) { float s = 0.f;
#pragma unroll
                    for (int sI = 0; sI < 4; ++sI)
#pragma unroll
                        for (int e = 0; e < 8; ++e) s += bf2f((bf16)bq[sI][e]) * ksl[j * 64 + 16 * sI + 8 * hh2 + e];
                    s += __shfl_xor(s, 32); g[j] = (j < qb) ? s : -INFINITY; }
#pragma unroll
                for (int r = 0; r < 3; ++r) if (r < qb) { int best = 0; float bv = -INFINITY;
#pragma unroll
                    for (int j = 6; j >= 0; --j) if (j < qb && !((sel >> j) & 1u) && g[j] >= bv) { bv = g[j]; best = j; }
                    sel |= 1u << best; }
            }
            AttnSt st; attn_init(st);
            for (int kt = 0; kt <= wave; ++kt) attn_tile(lds, kt, LUT_NEG + qpos - (qb * 256 + kt * 32) - 8 * hh2 - 23, bq, st, lane);
            for (int j = 0; j < qb; ++j) {
                __syncthreads();
                attn_stage(lds, kbase + (size_t)j * 256 * 64, vbase + j * 256, tid);
                __syncthreads();
                const bool mine = (sel >> j) & 1u;
                if (__ballot(mine) != 0ull) {
                    for (int kt = 0; kt < 8; ++kt) { const int li = mine ? (LUT_NEG + qpos - (j * 256 + kt * 32) - 8 * hh2 - 23) : 64;
                        attn_tile(lds, kt, li, bq, st, lane); }
                }
            }
            const int t = b * S + qpos;
            attn_finish(st, false, 0.f, a.out_norm_b + hd * 64, ATT + (size_t)t * D + 512 + hd * 64, ssq + t * 16 + 8 + hd, lane);
        }
    }
    for (int u = vcu; u < 256; u += G) {
        const int b = u >> 5, kv = (u >> 4) & 1, n = u & 15;
        __syncthreads();
        for (int i = tid; i < 4 * 512; i += NTHR) { const int g = i >> 9, p = i & 511; lutl[i] = lut[(kv * 4 + g) * LUTN + p]; }
        const int kb0 = (n - 1) * 128, kld = kb0 < 0 ? 0 : kb0;
        attn_stage(lds, KA + ((size_t)(b * 2 + kv) * S + kld) * 64, VAT + (size_t)(b * 2 + kv) * 64 * S + kld, tid);
        __syncthreads();
        for (int ti = 0; ti < 2; ++ti) {
            const int tk = wave * 2 + ti, g = tk >> 2, jq = tk & 3, hd = kv * 4 + g;
            const int qpos = n * 128 + jq * 32 + l31, t = b * S + qpos;
            bf16x8 bq[4]; attn_loadq(QA + ((size_t)(b * 8 + hd) * S + qpos) * 64, bq, lane);
            AttnSt st; attn_init(st);
            if (n > 0) { for (int kt = jq + 4; kt >= jq; --kt) attn_tile(lds, kt, g * 512 + 256 + qpos - (kb0 + kt * 32) - 8 * hh2 - 23, bq, st, lane); }
            else { for (int kt = jq; kt >= 0; --kt) attn_tile(lds, kt, g * 512 + 256 + qpos - (kt * 32) - 8 * hh2 - 23, bq, st, lane); }
            attn_finish(st, true, a.sinks[hd] * LOG2E, a.out_norm_a + hd * 64, ATT + (size_t)t * D + hd * 64, ssq + t * 16 + hd, lane);
        }
    }
}
__device__ __forceinline__ void phase4(const Args& a, LAS unsigned char* lds, int vcu, int G) {
    typedef GemmCore<4, 2, 2, 4, 4, false, false, 2, 1> GC;
    const int tid = threadIdx.x, lane = tid & 63, wave = __builtin_amdgcn_readfirstlane(tid >> 6), wm = wave / 4, wn = wave % 4, h = lane >> 5, l31 = lane & 31;
    const bf16* ATT = (const bf16*)(a.ws + WS_ATT); const float* ssq = (const float*)(a.ws + WS_SSQ);
    const float* mod = (const float*)(a.ws + C_MOD); float* X1 = (float*)(a.ws + WS_X1);
    LAS float* rsc = (LAS float*)(lds + GC::LDS_NEED);
    for (int u = vcu; u < 64 * 4; u += G) {
        const int pm = u >> 2, pn = u & 3;
        __syncthreads();
        if (tid < 256) { const int t = pm * 256 + tid; const f32x4 q0 = *(const f32x4*)(ssq + t * 16), q1 = *(const f32x4*)(ssq + t * 16 + 4), q2 = *(const f32x4*)(ssq + t * 16 + 8), q3 = *(const f32x4*)(ssq + t * 16 + 12);
            const float sa = ((q0.x + q0.y) + (q0.z + q0.w)) + ((q1.x + q1.y) + (q1.z + q1.w)), sb = ((q2.x + q2.y) + (q2.z + q2.w)) + ((q3.x + q3.y) + (q3.z + q3.w));
            const float ra = rsqrtf(sa * (1.f / 512.f) + EPS), rb = rsqrtf(sb * (1.f / 512.f) + EPS); rsc[tid] = ra / rb; rsc[256 + tid] = rb; }
        f32x16 acc[4][2]; zero_acc(acc);
        const bf16* Ab = ATT + (size_t)pm * 256 * D; const bf16* Wb = (const bf16*)(a.ws + WS_WTOUT) + (size_t)pn * 256 * D;
        GC::run_h(lds, [&](int r) { return Ab + (size_t)r * D; }, [&](int c) { return Wb + (size_t)c * D; }, D, 32, acc, nullptr,
            [&](int ks, f32x16 (&ac)[4][2]) { if (ks == 16) {
#pragma unroll
                for (int rb = 0; rb < 4; ++rb)
#pragma unroll
                    for (int g4 = 0; g4 < 4; ++g4) { const f32x4 f = *(const LAS f32x4*)(rsc + wm * 128 + rb * 32 + 8 * g4 + 4 * h);
#pragma unroll
                        for (int e = 0; e < 4; ++e) { ac[rb][0][4 * g4 + e] *= f[e]; ac[rb][1][4 * g4 + e] *= f[e]; } } } });
        const int b = (pm * 256) / S;
#pragma unroll
        for (int cb = 0; cb < 2; ++cb) { const int col = pn * 256 + wn * 64 + cb * 32 + l31; const float g1 = mod[b * 6 * D + 2 * D + col];
#pragma unroll
            for (int rb = 0; rb < 4; ++rb)
#pragma unroll
                for (int g4 = 0; g4 < 4; ++g4) { const int lr = wm * 128 + rb * 32 + 8 * g4 + 4 * h;
                    size_t o4 = (size_t)(pm * 256 + lr) * D + col; asm volatile("" : "+v"(o4));
                    const f32x4 rv = *(const LAS f32x4*)(rsc + 256 + lr);
#pragma unroll
                    for (int e = 0; e < 4; ++e) X1[o4 + (size_t)e * D] = a.x[o4 + (size_t)e * D] + g1 * acc[rb][cb][4 * g4 + e] * rv[e]; } }
    }
}
__device__ __forceinline__ void phase5(const Args& a, LAS unsigned char* lds, int vcu, int G, bool dry = false) {
    typedef GemmCore<2, 1, 1, 8, 4, false, false, 4, 1> GC;
    const int tid = threadIdx.x, lane = tid & 63, wave = __builtin_amdgcn_readfirstlane(tid >> 6), h = lane >> 5, l31 = lane & 31;
    const float* X1 = (const float*)(a.ws + WS_X1); const float* mod = (const float*)(a.ws + C_MOD); bf16* H2 = (bf16*)(a.ws + WS_H2);
    int* cnt = (int*)(a.ws + C_CNT); int* list = (int*)(a.ws + WS_LIST); float* ew = (float*)(a.ws + WS_EW);
    LAS float* lg = (LAS float*)(lds + 65536);
    for (int u = vcu; u < NTOK / 64; u += G) {
        const int t0 = u * 64, b = t0 / S;
        for (int i = 0; i < 8; ++i) { const int t = t0 + wave * 8 + i;
            norm_mod_row(X1 + (size_t)t * D, a.norm2_g, mod + b * 6 * D + 3 * D, mod + b * 6 * D + 4 * D, H2 + (size_t)t * D, lane, a.ws + WS_X8 + (size_t)t * D); }
        asm volatile("s_waitcnt vmcnt(0)" ::: "memory");
        __syncthreads();
        f32x16 acc[2][1]; zero_acc(acc);
        const bf16* Ab = H2 + (size_t)t0 * D;
        const bf16* WR = (const bf16*)(a.ws + WS_WTR);
        GC::run(lds, [&](int r) { return Ab + (size_t)r * D; }, [&](int c) { return WR + (size_t)c * D; }, D, D / 32, acc, nullptr);
#pragma unroll
        for (int rb = 0; rb < 2; ++rb)
#pragma unroll
            for (int r = 0; r < 16; ++r) lg[(rb * 32 + roff(r, h)) * 256 + wave * 32 + l31] = acc[rb][0][r];
        __syncthreads();
        for (int i = 0; i < 8; ++i) {
            const int row = wave * 8 + i, t = t0 + row;
            const f32x4 lv = *(const LAS f32x4*)(lg + row * 256 + lane * 4); const f32x4 eb = *(const f32x4*)(a.e_bias + lane * 4);
            float sc[4], sl[4];
#pragma unroll
            for (int j = 0; j < 4; ++j) { sc[j] = 1.f / (1.f + __expf(-lv[j])); sl[j] = sc[j] + eb[j]; }
            float m1 = fmaxf(sl[0], sl[1]), m2 = fminf(sl[0], sl[1]);
            { const float c1 = fmaxf(sl[2], sl[3]), c2 = fminf(sl[2], sl[3]); const float n1 = fmaxf(m1, c1), n2 = fmaxf(fminf(m1, c1), fmaxf(m2, c2)); m1 = n1; m2 = n2; }
#pragma unroll
            for (int o = 1; o < 8; o <<= 1) { const float c1 = __shfl_xor(m1, o), c2 = __shfl_xor(m2, o); const float n1 = fmaxf(m1, c1), n2 = fmaxf(fminf(m1, c1), fmaxf(m2, c2)); m1 = n1; m2 = n2; }
            const float gs = m1 + m2; const int grp = lane >> 3;
            int rank = 0;
#pragma unroll
            for (int g2 = 0; g2 < 8; ++g2) { const float og = __shfl(gs, g2 * 8); rank += (og > gs || (og == gs && g2 < grp)) ? 1 : 0; }
            const bool gsel = rank < 4;
#pragma unroll
            for (int j = 0; j < 4; ++j) if (!gsel) sl[j] = -INFINITY;
            int myidx = 0; float mysc = 0.f, wsum = 0.f;
            for (int r = 0; r < TOPK; ++r) {
                float bv = sl[0]; int bi = 0;
#pragma unroll
                for (int j = 1; j < 4; ++j) if (sl[j] > bv) { bv = sl[j]; bi = j; }
                bi += lane * 4;
#pragma unroll
                for (int o = 1; o < 64; o <<= 1) { const float ov = __shfl_xor(bv, o); const int oi = __shfl_xor(bi, o); if (ov > bv || (ov == bv && oi < bi)) { bv = ov; bi = oi; } }
                const int j = bi & 3; const bool own = (bi >> 2) == lane;
                const float scj = (j == 0) ? sc[0] : (j == 1) ? sc[1] : (j == 2) ? sc[2] : sc[3];
                const float scw = __shfl(scj, bi >> 2);
                if (own) { if (j == 0) sl[0] = -INFINITY; else if (j == 1) sl[1] = -INFINITY; else if (j == 2) sl[2] = -INFINITY; else sl[3] = -INFINITY; }
                wsum += scw;
                if (lane == r) { myidx = bi; mysc = scw; }
            }
            if (lane < TOPK && !dry) { const int slot = atomicAdd(&cnt[myidx], 1); list[(size_t)myidx * NTOK + slot] = t * 8 + lane; ew[t * 8 + lane] = mysc / wsum * 2.5f; }
        }
        __syncthreads();
    }
}
constexpr int P45_STR = 2064;
template <int PF>
__device__ __forceinline__ void phase45(const Args& a, LAS unsigned char* lds, int vcu, int G) {
    const bf16* ATT = (const bf16*)(a.ws + WS_ATT); const float* ssq = (const float*)(a.ws + WS_SSQ); const float* mod = (const float*)(a.ws + C_MOD);
    float* X1 = (float*)(a.ws + WS_X1); unsigned char* X8 = a.ws + WS_X8;
    const bf16* WTO = (const bf16*)(a.ws + WS_WTOUT); const bf16* WTR = (const bf16*)(a.ws + WS_WTR);
    int* cnt = (int*)(a.ws + C_CNT); int* list = (int*)(a.ws + WS_LIST); float* ew = (float*)(a.ws + WS_EW);
    LAS float* red = (LAS float*)(lds + 64 * P45_STR);
    LAS float* lg = (LAS float*)lds;
    for (int u = vcu; u < NTOK / 64; u += G) {
        int tid = threadIdx.x; asm volatile("" : "+v"(tid));
        const int lane = tid & 63, wave = __builtin_amdgcn_readfirstlane(tid >> 6), h = lane >> 5, l31 = lane & 31;
        const int t0 = u * 64, b = t0 / S;
        __syncthreads();
        if (!(PF & 16)) {
            u32x4 xr[16];
#pragma unroll
            for (int i = 0; i < 16; ++i) { const int p = tid + NTHR * i, row = p >> 7, c = p & 127; xr[i] = *(const u32x4*)(ATT + (size_t)(t0 + row) * D + c * 8); }
#pragma unroll
            for (int i = 0; i < 16; ++i) { const int p = tid + NTHR * i, row = p >> 7, c = p & 127; *(LAS u32x4*)(lds + row * P45_STR + c * 16) = xr[i]; }
        }
        float rat[2], rbs[2];
#pragma unroll
        for (int rb = 0; rb < 2; ++rb) { const int t = t0 + rb * 32 + l31;
            const f32x4 q0 = *(const f32x4*)(ssq + t * 16), q1 = *(const f32x4*)(ssq + t * 16 + 4), q2 = *(const f32x4*)(ssq + t * 16 + 8), q3 = *(const f32x4*)(ssq + t * 16 + 12);
            const float sa = ((q0.x + q0.y) + (q0.z + q0.w)) + ((q1.x + q1.y) + (q1.z + q1.w)), sb = ((q2.x + q2.y) + (q2.z + q2.w)) + ((q3.x + q3.y) + (q3.z + q3.w));
            float sa1 = sa * (1.f / 512.f) + EPS; asm volatile("" : "+v"(sa1));
            const float sb1 = sb * (1.f / 512.f) + EPS;
            const float ra = rsqrtf(sa1), rbv = rsqrtf(sb1); rat[rb] = ra / rbv; rbs[rb] = rbv; }
        __syncthreads();
        f32x16 acc[2][4]; zero_acc(acc);
        if (!(PF & 4)) {
            const bf16* wb0 = WTO + (size_t)(128 * wave + l31) * 32 + 16 * h;
            const LAS unsigned char* al = lds + l31 * P45_STR + 32 * h;
            bf16x8 wr[4][4];
            auto ldw = [&](int d, int q) { const bf16* p = wb0 + (size_t)(q >> 1) * (D * 32) + 8 * (q & 1);
#pragma unroll
                for (int cb = 0; cb < 4; ++cb) wr[d][cb] = *(const bf16x8*)(p + cb * 32 * 32); };
#pragma unroll
            for (int d = 0; d < 4; ++d) ldw(d, d);
#pragma unroll 1
            for (int q0 = 0; q0 < 64; q0 += 4) {
                if (q0 == 32) {
#pragma unroll
                    for (int rb = 0; rb < 2; ++rb)
#pragma unroll
                        for (int cb = 0; cb < 4; ++cb)
#pragma unroll
                            for (int r = 0; r < 16; ++r) acc[rb][cb][r] *= rat[rb]; }
#pragma unroll
                for (int d = 0; d < 4; ++d) { const int q = q0 + d;
                    const bf16x8 a0 = *(const LAS bf16x8*)(al + 64 * (q >> 1) + 16 * (q & 1)), a1 = *(const LAS bf16x8*)(al + 32 * P45_STR + 64 * (q >> 1) + 16 * (q & 1));
#pragma unroll
                    for (int cb = 0; cb < 4; ++cb) { acc[0][cb] = MFMA32(wr[d][cb], a0, acc[0][cb]); acc[1][cb] = MFMA32(wr[d][cb], a1, acc[1][cb]); }
                    ldw(d, min(q + 4, 60 + d)); asm volatile("" ::: "memory"); }
            }
            asm volatile("s_waitcnt vmcnt(0)" ::: "memory");
        }
        float ss[2] = {0.f, 0.f};
#pragma unroll
        for (int rb = 0; rb < 2; ++rb) { const size_t rowoff = (size_t)(t0 + rb * 32 + l31) * D;
#pragma unroll
            for (int cb = 0; cb < 4; ++cb)
#pragma unroll
                for (int g4 = 0; g4 < 4; ++g4) { int col = 128 * wave + cb * 32 + 8 * g4 + 4 * h; asm volatile("" : "+v"(col));
                    const f32x4 xv = (PF & 8) ? (f32x4){1.f, 1.f, 1.f, 1.f} : *(const f32x4*)(a.x + rowoff + col), g1 = *(const f32x4*)(mod + b * 6 * D + 2 * D + col);
                    f32x4 o; o.x = xv.x + g1.x * acc[rb][cb][4 * g4] * rbs[rb]; o.y = xv.y + g1.y * acc[rb][cb][4 * g4 + 1] * rbs[rb]; o.z = xv.z + g1.z * acc[rb][cb][4 * g4 + 2] * rbs[rb]; o.w = xv.w + g1.w * acc[rb][cb][4 * g4 + 3] * rbs[rb];
                    if (!(PF & 8)) *(f32x4*)(X1 + rowoff + col) = o; ss[rb] += (o.x * o.x + o.y * o.y) + (o.z * o.z + o.w * o.w);
                    acc[rb][cb][4 * g4] = o.x; acc[rb][cb][4 * g4 + 1] = o.y; acc[rb][cb][4 * g4 + 2] = o.z; acc[rb][cb][4 * g4 + 3] = o.w; } }
#pragma unroll
        for (int rb = 0; rb < 2; ++rb) { ss[rb] += __shfl_xor(ss[rb], 32); if (h == 0) red[wave * 64 + rb * 32 + l31] = ss[rb]; }
        __syncthreads();
#pragma unroll
        for (int rb = 0; rb < 2; ++rb) { const int row = rb * 32 + l31; float s = 0.f;
#pragma unroll
            for (int w = 0; w < NWAVE; ++w) s += red[w * 64 + row];
            const float rstd = rsqrtf(s * (1.f / D) + EPS);
#pragma unroll
            for (int cb = 0; cb < 4; ++cb)
#pragma unroll
                for (int g4 = 0; g4 < 4; ++g4) { int col = 128 * wave + cb * 32 + 8 * g4 + 4 * h; asm volatile("" : "+v"(col));
                    const f32x4 gg = *(const f32x4*)(a.norm2_g + col), s1 = *(const f32x4*)(mod + b * 6 * D + 4 * D + col), s0 = *(const f32x4*)(mod + b * 6 * D + 3 * D + col);
                    const float o0 = acc[rb][cb][4 * g4] * rstd * gg.x * (1.f + s1.x) + s0.x, o1 = acc[rb][cb][4 * g4 + 1] * rstd * gg.y * (1.f + s1.y) + s0.y;
                    const float o2 = acc[rb][cb][4 * g4 + 2] * rstd * gg.z * (1.f + s1.z) + s0.z, o3 = acc[rb][cb][4 * g4 + 3] * rstd * gg.w * (1.f + s1.w) + s0.w;
                    u32x2 w; w.x = cvt_pk(o0, o1); w.y = cvt_pk(o2, o3); *(LAS u32x2*)(lds + row * P45_STR + col * 2) = w; } }
        __syncthreads();
#pragma unroll 2
        for (int i = 0; i < 8; ++i) { const int row = wave * 8 + i;
            const u32x4 v0 = *(const LAS u32x4*)(lds + row * P45_STR + lane * 32), v1 = *(const LAS u32x4*)(lds + row * P45_STR + lane * 32 + 16);
            auto f = [](unsigned w2) { return __uint_as_float(w2 << 16); }; auto g = [](unsigned w2) { return __uint_as_float(w2 & 0xffff0000u); };
            u32x4 o;
            { int p = __builtin_amdgcn_cvt_pk_fp8_f32(f(v0.x), g(v0.x), 0, false); p = __builtin_amdgcn_cvt_pk_fp8_f32(f(v0.y), g(v0.y), p, true); o.x = (unsigned)p; }
            { int p = __builtin_amdgcn_cvt_pk_fp8_f32(f(v0.z), g(v0.z), 0, false); p = __builtin_amdgcn_cvt_pk_fp8_f32(f(v0.w), g(v0.w), p, true); o.y = (unsigned)p; }
            { int p = __builtin_amdgcn_cvt_pk_fp8_f32(f(v1.x), g(v1.x), 0, false); p = __builtin_amdgcn_cvt_pk_fp8_f32(f(v1.y), g(v1.y), p, true); o.z = (unsigned)p; }
            { int p = __builtin_amdgcn_cvt_pk_fp8_f32(f(v1.z), g(v1.z), 0, false); p = __builtin_amdgcn_cvt_pk_fp8_f32(f(v1.w), g(v1.w), p, true); o.w = (unsigned)p; }
            *(u32x4*)(X8 + (size_t)(t0 + row) * D + lane * 16) = o; }
        if (PF & 2) continue;
        {
            f32x16 lacc[2];
#pragma unroll
            for (int r = 0; r < 16; ++r) { lacc[0][r] = 0.f; lacc[1][r] = 0.f; }
            const bf16* wb0 = WTR + (size_t)(32 * wave + l31) * 32 + 16 * h;
            const LAS unsigned char* al = lds + l31 * P45_STR + 32 * h;
            bf16x8 wr[8];
#pragma unroll
            for (int d = 0; d < 8; ++d) wr[d] = *(const bf16x8*)(wb0 + (size_t)(d >> 1) * (NE * 32) + 8 * (d & 1));
#pragma unroll 1
            for (int q0 = 0; q0 < 64; q0 += 8) {
#pragma unroll
                for (int d = 0; d < 8; ++d) { const int q = q0 + d;
                    const bf16x8 a0 = *(const LAS bf16x8*)(al + 64 * (q >> 1) + 16 * (q & 1)), a1 = *(const LAS bf16x8*)(al + 32 * P45_STR + 64 * (q >> 1) + 16 * (q & 1));
                    lacc[0] = MFMA32(wr[d], a0, lacc[0]); lacc[1] = MFMA32(wr[d], a1, lacc[1]);
                    const int qn = min(q + 8, 56 + d); wr[d] = *(const bf16x8*)(wb0 + (size_t)(qn >> 1) * (NE * 32) + 8 * (qn & 1)); asm volatile("" ::: "memory"); }
            }
            asm volatile("s_waitcnt vmcnt(0)" ::: "memory");
            __syncthreads();
#pragma unroll
            for (int rb = 0; rb < 2; ++rb)
#pragma unroll
                for (int g4 = 0; g4 < 4; ++g4) *(LAS f32x4*)(lg + (rb * 32 + l31) * 260 + 32 * wave + 8 * g4 + 4 * h) = (f32x4){lacc[rb][4 * g4], lacc[rb][4 * g4 + 1], lacc[rb][4 * g4 + 2], lacc[rb][4 * g4 + 3]};
        }
        __syncthreads();
        const f32x4 eb = *(const f32x4*)(a.e_bias + lane * 4);
#pragma unroll 1
        for (int i0 = 0; i0 < 8; i0 += 4) {
            float sc[4][4], sl[4][4], wsum[4], mysc[4]; int myidx[4];
#pragma unroll
            for (int q = 0; q < 4; ++q) { const int row = wave * 8 + i0 + q;
                const f32x4 lv = *(const LAS f32x4*)(lg + row * 260 + lane * 4);
#pragma unroll
                for (int j = 0; j < 4; ++j) { sc[q][j] = __builtin_amdgcn_rcpf(1.f + __expf(-lv[j])); sl[q][j] = sc[q][j] + eb[j]; }
                wsum[q] = 0.f; mysc[q] = 0.f; myidx[q] = 0; }
            float m1[4], m2[4];
#pragma unroll
            for (int q = 0; q < 4; ++q) { m1[q] = fmaxf(sl[q][0], sl[q][1]); m2[q] = fminf(sl[q][0], sl[q][1]);
                const float c1 = fmaxf(sl[q][2], sl[q][3]), c2 = fminf(sl[q][2], sl[q][3]); const float n1 = fmaxf(m1[q], c1), n2 = fmaxf(fminf(m1[q], c1), fmaxf(m2[q], c2)); m1[q] = n1; m2[q] = n2; }
#pragma unroll
            for (int o = 1; o < 8; o <<= 1)
#pragma unroll
                for (int q = 0; q < 4; ++q) { const float c1 = __shfl_xor(m1[q], o), c2 = __shfl_xor(m2[q], o); const float n1 = fmaxf(m1[q], c1), n2 = fmaxf(fminf(m1[q], c1), fmaxf(m2[q], c2)); m1[q] = n1; m2[q] = n2; }
            const int grp = lane >> 3;
#pragma unroll
            for (int q = 0; q < 4; ++q) { const float gs = m1[q] + m2[q]; int rank = 0;
#pragma unroll
                for (int g2 = 0; g2 < 8; ++g2) { const float og = __shfl(gs, g2 * 8); rank += (og > gs || (og == gs && g2 < grp)) ? 1 : 0; }
                if (rank >= 4) { sl[q][0] = -INFINITY; sl[q][1] = -INFINITY; sl[q][2] = -INFINITY; sl[q][3] = -INFINITY; } }
#pragma unroll 1
            for (int r = 0; r < TOPK; ++r) {
                float bv[4]; int bi[4];
#pragma unroll
                for (int q = 0; q < 4; ++q) { bv[q] = sl[q][0]; bi[q] = 0;
#pragma unroll
                    for (int j = 1; j < 4; ++j) if (sl[q][j] > bv[q]) { bv[q] = sl[q][j]; bi[q] = j; }
                    bi[q] += lane * 4; }
#pragma unroll
                for (int o = 1; o < 64; o <<= 1)
#pragma unroll
                    for (int q = 0; q < 4; ++q) { const float ov = __shfl_xor(bv[q], o); const int oi = __shfl_xor(bi[q], o); if (ov > bv[q] || (ov == bv[q] && oi < bi[q])) { bv[q] = ov; bi[q] = oi; } }
#pragma unroll
                for (int q = 0; q < 4; ++q) { const int j = bi[q] & 3; const bool own = (bi[q] >> 2) == lane;
                    const float scj = (j == 0) ? sc[q][0] : (j == 1) ? sc[q][1] : (j == 2) ? sc[q][2] : sc[q][3];
                    const float scw = __shfl(scj, bi[q] >> 2);
                    if (own) { if (j == 0) sl[q][0] = -INFINITY; else if (j == 1) sl[q][1] = -INFINITY; else if (j == 2) sl[q][2] = -INFINITY; else sl[q][3] = -INFINITY; }
                    wsum[q] += scw;
                    if (lane == r) { myidx[q] = bi[q]; mysc[q] = scw; } }
            }
#pragma unroll
            for (int q = 0; q < 4; ++q) { const int t = t0 + wave * 8 + i0 + q;
                if (lane < TOPK && !(PF & 1)) { const int slot = atomicAdd(&cnt[myidx[q]], 1); list[(size_t)myidx[q] * NTOK + slot] = t * 8 + lane; ew[t * 8 + lane] = mysc[q] / wsum[q] * 2.5f; } }
        }
    }
}
constexpr int MOE_H_OFF = 81920;
__device__ __forceinline__ void phase6_old(const Args& a, LAS unsigned char* lds, int vcu, int G, const XcdBarrier rbar, const bool use_rbar) {
    typedef GemmCore<2, 4, 2, 4, 8, false, true, 2> G1;
    typedef GemmCore<2, 4, 2, 4, 8, true, true, 2> G2;
    static_assert(G1::LDS_NEED <= MOE_H_OFF && MOE_H_OFF + 8 * 8192 <= LDS_CTL_OFF, "MoE LDS map");
    const int tid = threadIdx.x, lane = tid & 63, wave = __builtin_amdgcn_readfirstlane(tid >> 6), wm = wave / 4, wn = wave % 4, h = lane >> 5, l31 = lane & 31;
    const bf16* H2 = (const bf16*)(a.ws + WS_H2); const int* cnt = (const int*)(a.ws + C_CNT); const int* list = (const int*)(a.ws + WS_LIST); const float* ew = (const float*)(a.ws + WS_EW);
    bf16* YBUF = (bf16*)(a.ws + WS_YBUF); bf16* YSH = (bf16*)(a.ws + WS_YSH);
    LAS int* pf = (LAS int*)(lds + 0);
    __syncthreads();
    if (tid < NE) pf[tid + 1] = (cnt[tid] + 127) >> 7;
    if (tid == 0) pf[0] = 0;
    __syncthreads();
    if (tid == 0) { int s = 0; for (int e = 0; e < NE; ++e) { s += pf[e + 1]; pf[e + 1] = s; } }
    __syncthreads();
    const int R = pf[NE];
    const int NSH = NTOK / 128;
    LAS int* myu = (LAS int*)(lds + LDS_CTL_OFF + 256);
    const int total = NSH + R;
    int nmy = 0;
    for (int u = vcu; u < total; u += G) ++nmy;
    if (nmy > 16) nmy = 16;
    if (tid < nmy) { const int u = vcu + tid * G; int e, ci;
        if (u < NSH) { e = NE; ci = u; }
        else { const int ru = u - NSH; int lo = 0, hi = NE - 1; while (lo < hi) { const int mid = (lo + hi) >> 1; if (pf[mid + 1] > ru) hi = mid; else lo = mid + 1; } e = lo; ci = ru - pf[lo]; }
        myu[tid] = e; myu[16 + tid] = ci; }
    __syncthreads();
    LAS int* rowa = (LAS int*)(lds + LDS_CTL_OFF + 384);
    const int nrounds = (total + G - 1) / G;
    for (int iu = 0; iu < nrounds; ++iu) {
        if (use_rbar && iu > 0) xcd_barrier(rbar);
        if (iu >= nmy) continue;
        const int e = myu[iu], ci = myu[16 + iu];
        const int n = (e < NE) ? min(128, cnt[e] - ci * 128) : 128;
        const float* W1 = (e < NE) ? a.w1 + (size_t)e * D * ED : a.ws1; const float* W3 = (e < NE) ? a.w3 + (size_t)e * D * ED : a.ws3; const float* W2 = (e < NE) ? a.w2 + (size_t)e * ED * D : a.ws2;
        __syncthreads();
        if (tid < 128) rowa[tid] = (tid < n) ? ((e < NE) ? list[(size_t)e * NTOK + ci * 128 + tid] : ci * 128 + tid) : -1;
        __syncthreads();
        f32x16 acc[2][4]; zero_acc(acc);
        G1::run(lds, [&](int r) { const int aid = rowa[r]; const int tok = (e < NE) ? (aid >> 3) : aid; return (aid < 0) ? (const bf16*)nullptr : (H2 + (size_t)tok * D); },
                [&](int c) { const int w4 = c >> 7, within = c & 127; return (within < 64) ? (W1 + 64 * w4 + within) : (W3 + 64 * w4 + within - 64); }, ED, D / 32, acc, nullptr);
        {
#pragma unroll
            for (int rb = 0; rb < 2; ++rb) { const int row = wm * 64 + rb * 32 + l31;
#pragma unroll
                for (int cb = 0; cb < 2; ++cb)
#pragma unroll
                    for (int g4 = 0; g4 < 4; ++g4) { float hv[4];
#pragma unroll
                        for (int e4 = 0; e4 < 4; ++e4) { const float gt = acc[rb][cb][4 * g4 + e4], up = acc[rb][cb + 2][4 * g4 + e4]; hv[e4] = gt / (1.f + __expf(-gt)) * up; }
                        u32x2 w; w.x = cvt_pk(hv[0], hv[1]); w.y = cvt_pk(hv[2], hv[3]);
                        const int ks2 = 2 * wn + cb;
                        *(LAS u32x2*)(lds + MOE_H_OFF + ks2 * 8192 + row * 64 + ((g4 ^ ((row >> 2) & 3)) << 4) + 8 * h) = w; } }
        }
        __syncthreads();
        const int aid0 = rowa[wm * 64 + l31], aid1 = rowa[wm * 64 + 32 + l31];
        for (int nh = 0; nh < 2; ++nh) {
            zero_acc(acc);
            G2::run(lds, [&](int) { return (const bf16*)nullptr; }, [&](int c) { return W2 + nh * 512 + c; }, D, ED / 32, acc, lds + MOE_H_OFF);
#pragma unroll
            for (int rb = 0; rb < 2; ++rb) { const int aid = rb ? aid1 : aid0; if (aid < 0) continue;
                const float wgt = (e < NE) ? ew[aid] : 1.f; bf16* dst = ((e < NE) ? YBUF : YSH) + (size_t)aid * D + nh * 512 + wn * 128;
#pragma unroll
                for (int cb = 0; cb < 4; ++cb)
#pragma unroll
                    for (int g4 = 0; g4 < 4; ++g4) { u32x2 w; w.x = cvt_pk(acc[rb][cb][4 * g4] * wgt, acc[rb][cb][4 * g4 + 1] * wgt); w.y = cvt_pk(acc[rb][cb][4 * g4 + 2] * wgt, acc[rb][cb][4 * g4 + 3] * wgt);
                        *(u32x2*)(dst + cb * 32 + 8 * g4 + 4 * h) = w; } }
        }
    }
}
constexpr int MOE_TOK_OFF = 32768, MOE_AID_OFF = MOE_TOK_OFF + 4096, MOE_W_OFF = MOE_AID_OFF + 4096;
template <int NRB, int NCB>
__device__ __forceinline__ void moe_unit(LAS unsigned char* lds, const bf16* H2, const float* W1, const float* W3, const float* W2, bf16* hb, bf16* ybase, const int nrb) {
    constexpr int COLS = NCB * 32, HU = COLS / 2, TASKS = 4 * (COLS / 4), NG = NTHR / TASKS;
    constexpr int P1 = 256 / HU, T1 = P1 * 32, P2 = 1024 / COLS, T2 = P2 * 8, T = T1 + T2, SLOT = COLS * 64;
    static_assert(NG >= 2 && (NG & (NG - 1)) == 0 && T1 % 2 == 0, "moe_unit geometry");
    const int tid = threadIdx.x, lane = tid & 63, wave = __builtin_amdgcn_readfirstlane(tid >> 6), h = lane >> 5, l31 = lane & 31;
    const int grp = __builtin_amdgcn_readfirstlane(tid / TASKS), q = tid % TASKS, cg = q % (COLS / 4), kg = q / (COLS / 4), c0 = 4 * cg;
    const LAS int* r_tok = (const LAS int*)(lds + MOE_TOK_OFF); const LAS int* r_aid = (const LAS int*)(lds + MOE_AID_OFF); const LAS float* r_w = (const LAS float*)(lds + MOE_W_OFF);
    int xoff[NRB];
#pragma unroll
    for (int rb = 0; rb < NRB; ++rb) { const int row = (rb * 8 + wave) * 32 + l31; xoff[rb] = r_tok[row] * D + 16 * h; }
    const int hoff0 = (wave * 32 + l31) * ED;
    f32x16 acc[NRB][NCB]; zero_acc(acc);
    f32x4 wreg[8];
    bf16x8 xa[NRB][2], xb[NRB][2];
    const int wwo = c0 * 64 + ((kg ^ (cg & 3)) << 4);
    const int swz = (l31 >> 2) & 3, rs0 = l31 * 64 + (((2 * h) ^ swz) << 4), rs1 = l31 * 64 + (((2 * h + 1) ^ swz) << 4);
    auto issue_w = [&](int tt) {
        const float* p; int ld;
        if (tt < T1) { const int ps = tt >> 5, ks = tt & 31; ld = ED; p = ((c0 < HU) ? (W1 + ps * HU + c0) : (W3 + ps * HU + (c0 - HU))) + (size_t)(32 * ks + 8 * kg) * ED; }
        else { const int t2 = tt - T1, qs = t2 >> 3, ks = t2 & 7; ld = D; p = W2 + qs * COLS + c0 + (size_t)(32 * ks + 8 * kg) * D; }
#pragma unroll
        for (int i = 0; i < 8; ++i) wreg[i] = *(const f32x4*)(p + (size_t)i * ld);
    };
    auto write_w = [&](int tt) {
        LAS unsigned char* sb = lds + (tt & 1) * SLOT + wwo;
#pragma unroll
        for (int j = 0; j < 4; ++j) { u32x4 w; w.x = cvt_pk(wreg[0][j], wreg[1][j]); w.y = cvt_pk(wreg[2][j], wreg[3][j]); w.z = cvt_pk(wreg[4][j], wreg[5][j]); w.w = cvt_pk(wreg[6][j], wreg[7][j]);
            *(LAS u32x4*)(sb + j * 64) = w; }
    };
    auto load_x = [&](bf16x8 (&x)[NRB][2], int tt) {
#pragma unroll
        for (int rb = 0; rb < NRB; ++rb) if (rb < nrb) {
            const bf16* p = (tt < T1) ? (H2 + xoff[rb] + 32 * (tt & 31)) : (hb + hoff0 + rb * (256 * ED) + 16 * h + 32 * ((tt - T1) & 7));
            x[rb][0] = *(const bf16x8*)p; x[rb][1] = *(const bf16x8*)(p + 8); }
    };
    auto compute = [&](const bf16x8 (&x)[NRB][2], int tt) {
        const LAS unsigned char* base = lds + (tt & 1) * SLOT;
#pragma unroll
        for (int s = 0; s < 2; ++s) {
#pragma unroll
            for (int cb = 0; cb < NCB; ++cb) { const bf16x8 wf = *(const LAS bf16x8*)(base + cb * 2048 + (s ? rs1 : rs0));
#pragma unroll
                for (int rb = 0; rb < NRB; ++rb) if (rb < nrb) acc[rb][cb] = MFMA32(wf, x[rb][s], acc[rb][cb]); }
        }
    };
    auto epi1 = [&](int ps) {
#pragma unroll
        for (int rb = 0; rb < NRB; ++rb) if (rb < nrb) {
#pragma unroll
            for (int cb = 0; cb < NCB / 2; ++cb)
#pragma unroll
                for (int g4 = 0; g4 < 4; ++g4) { float hv[4];
#pragma unroll
                    for (int e4 = 0; e4 < 4; ++e4) { const float gt = acc[rb][cb][4 * g4 + e4], up = acc[rb][cb + NCB / 2][4 * g4 + e4]; hv[e4] = gt / (1.f + __expf(-gt)) * up; }
                    u32x2 w; w.x = cvt_pk(hv[0], hv[1]); w.y = cvt_pk(hv[2], hv[3]);
                    *(u32x2*)(hb + hoff0 + rb * (256 * ED) + ps * HU + cb * 32 + 8 * g4 + 4 * h) = w; } }
    };
    auto epi2 = [&](int qs) {
#pragma unroll
        for (int rb = 0; rb < NRB; ++rb) if (rb < nrb) { const int row = (rb * 8 + wave) * 32 + l31; const int aid = r_aid[row]; if (aid < 0) continue;
            bf16* dst = ybase + (size_t)aid * D + qs * COLS + 4 * h; const float wg = r_w[row];
#pragma unroll
            for (int cb = 0; cb < NCB; ++cb)
#pragma unroll
                for (int g4 = 0; g4 < 4; ++g4) { u32x2 w; w.x = cvt_pk(acc[rb][cb][4 * g4] * wg, acc[rb][cb][4 * g4 + 1] * wg); w.y = cvt_pk(acc[rb][cb][4 * g4 + 2] * wg, acc[rb][cb][4 * g4 + 3] * wg);
                    *(u32x2*)(dst + cb * 32 + 8 * g4) = w; } }
    };
    issue_w(grp);
    load_x(xa, 0);
    if (grp == 0) write_w(0);
    __syncthreads();
    int t = 0;
    auto two_steps = [&](bool last_of_stage1) {
        if ((t & (NG - 1)) == grp && t + NG < T) issue_w(t + NG);
        load_x(xb, t + 1);
        compute(xa, t);
        if (((t + 1) & (NG - 1)) == grp) write_w(t + 1);
        __syncthreads();
        const int t1 = t + 1;
        if ((t1 & (NG - 1)) == grp && t1 + NG < T) issue_w(t1 + NG);
        if (t1 + 1 < T && !last_of_stage1) load_x(xa, t1 + 1);
        compute(xb, t1);
        if (((t1 + 1) & (NG - 1)) == grp && t1 + 1 < T) write_w(t1 + 1);
        __syncthreads();
        t += 2;
    };
#pragma unroll 1
    for (int ps = 0; ps < P1; ++ps) {
#pragma unroll 1
        for (int k2 = 0; k2 < 16; ++k2) two_steps(ps == P1 - 1 && k2 == 15);
        epi1(ps); zero_acc(acc);
    }
    asm volatile("s_waitcnt vmcnt(0)" ::: "memory");
    load_x(xa, T1);
#pragma unroll 1
    for (int qs = 0; qs < P2; ++qs) {
#pragma unroll 1
        for (int k2 = 0; k2 < 4; ++k2) two_steps(false);
        epi2(qs); zero_acc(acc);
    }
}
__device__ __forceinline__ void phase6_v2(const Args& a, LAS unsigned char* lds, int vcu, int G) {
    const int tid = threadIdx.x;
    const bf16* H2 = (const bf16*)(a.ws + WS_H2); const int* cnt = (const int*)(a.ws + C_CNT); const int* list = (const int*)(a.ws + WS_LIST); const float* ew = (const float*)(a.ws + WS_EW);
    bf16* YBUF = (bf16*)(a.ws + WS_YBUF); bf16* YSH = (bf16*)(a.ws + WS_YSH); int* qhead = (int*)(a.ws + C_QHEAD);
    bf16* hb = (bf16*)(a.ws + WS_HB) + (size_t)(vcu & 255) * 768 * ED;
    LAS int* r_tok = (LAS int*)(lds + MOE_TOK_OFF); LAS int* r_aid = (LAS int*)(lds + MOE_AID_OFF); LAS float* r_w = (LAS float*)(lds + MOE_W_OFF);
    volatile LAS int* qslot = (volatile LAS int*)(lds + LDS_CTL_OFF + 256);
    int e = vcu;
    bool routed = e < NE;
    for (;;) {
        int n, r0 = 0, sh_c = 0;
        if (routed) n = cnt[e];
        else { __syncthreads(); if (tid == 0) *qslot = atomicAdd(qhead, 1); __syncthreads(); sh_c = *qslot; if (sh_c >= NTOK / 256) break; n = 256; }
        const float* W1 = routed ? a.w1 + (size_t)e * D * ED : a.ws1; const float* W3 = routed ? a.w3 + (size_t)e * D * ED : a.ws3; const float* W2 = routed ? a.w2 + (size_t)e * ED * D : a.ws2;
        for (; r0 < n; r0 += 768) {
            const int ns = min(768, n - r0);
            __syncthreads();
            for (int i = tid; i < 768; i += NTHR) { int tok = 0, aid = -1; float w = 0.f;
                if (i < ns) { if (routed) { aid = list[(size_t)e * NTOK + r0 + i]; tok = aid >> 3; w = ew[aid]; } else { tok = sh_c * 256 + i; aid = tok; w = 1.f; } }
                r_tok[i] = tok; r_aid[i] = aid; r_w[i] = w; }
            if (tid == 0) { __builtin_amdgcn_fence(__ATOMIC_ACQUIRE, "agent"); asm volatile("s_waitcnt vmcnt(0)" ::: "memory"); }
            __syncthreads();
            if (ns > 512) moe_unit<3, 2>(lds, H2, W1, W3, W2, hb, routed ? YBUF : YSH, 3);
            else moe_unit<2, 4>(lds, H2, W1, W3, W2, hb, routed ? YBUF : YSH, ns > 256 ? 2 : 1);
        }
        if (routed) { e += G; routed = e < NE; }
    }
}
constexpr int M3_TAB = 81920;
constexpr int M3_ROWS = 1536;
template <int PF>
__device__ __forceinline__ void phase6(const Args& a, LAS unsigned char* lds, int vcu, int G) {
    const int tid = threadIdx.x, lane = tid & 63, wave = __builtin_amdgcn_readfirstlane(tid >> 6), h = lane >> 5, l31 = lane & 31;
    const bf16* H2 = (const bf16*)(a.ws + WS_H2); const int* cnt = (const int*)(a.ws + C_CNT); const int* list = (const int*)(a.ws + WS_LIST); const float* ew = (const float*)(a.ws + WS_EW);
    bf16* YBUF = (bf16*)(a.ws + WS_YBUF); bf16* YSH = (bf16*)(a.ws + WS_YSH);
    {
        typedef GemmCore<2, 2, 1, 8, 4, false, true, 2, 1> S1;
        typedef GemmCore<2, 2, 1, 8, 4, true, true, 2, 1> S2;
        constexpr int HOFF = S1::LDS_NEED;
        static_assert(HOFF + 8 * 4096 <= LDS_CTL_OFF, "shared-expert LDS map");
        const bf16* W13 = (const bf16*)(a.ws + WS_WS13T); const bf16* W2T = (const bf16*)(a.ws + WS_WS2T);
        if (!(PF & 1)) for (int su = vcu; su < NTOK / 64; su += G) {
            const int t0 = su * 64;
            f32x16 acc[2][2]; zero_acc(acc);
            __syncthreads();
            S1::run(lds, [&](int r) { return H2 + (size_t)(t0 + r) * D; },
                    [&](int c) { const int w8 = c >> 6, within = c & 63; return W13 + (size_t)((within < 32) ? (32 * w8 + within) : (ED + 32 * w8 + within - 32)) * D; }, D, D / 32, acc, nullptr);
#pragma unroll
            for (int rb = 0; rb < 2; ++rb) { const int row = rb * 32 + l31;
#pragma unroll
                for (int g4 = 0; g4 < 4; ++g4) { float hv[4];
#pragma unroll
                    for (int e4 = 0; e4 < 4; ++e4) { const float gt = acc[rb][0][4 * g4 + e4], up = acc[rb][1][4 * g4 + e4]; hv[e4] = gt / (1.f + __expf(-gt)) * up; }
                    u32x2 w; w.x = cvt_pk(hv[0], hv[1]); w.y = cvt_pk(hv[2], hv[3]);
                    *(LAS u32x2*)(lds + HOFF + wave * 4096 + row * 64 + ((g4 ^ ((row >> 2) & 3)) << 4) + 8 * h) = w; } }
            __syncthreads();
            for (int nh = 0; nh < 2; ++nh) {
                zero_acc(acc);
                S2::run(lds, [&](int) { return (const bf16*)nullptr; }, [&](int c) { return W2T + (size_t)(nh * 512 + c) * ED; }, ED, ED / 32, acc, lds + HOFF);
#pragma unroll
                for (int rb = 0; rb < 2; ++rb) { bf16* dst = YSH + (size_t)(t0 + rb * 32 + l31) * D + nh * 512 + wave * 64 + 4 * h;
#pragma unroll
                    for (int cb = 0; cb < 2; ++cb)
#pragma unroll
                        for (int g4 = 0; g4 < 4; ++g4) { u32x2 w; w.x = cvt_pk(acc[rb][cb][4 * g4], acc[rb][cb][4 * g4 + 1]); w.y = cvt_pk(acc[rb][cb][4 * g4 + 2], acc[rb][cb][4 * g4 + 3]);
                            *(u32x2*)(dst + cb * 32 + 8 * g4) = w; } }
            }
        }
    }
    typedef GemmCore<2, 4, 8, 1, 2, false, true, 2, 0> GE;
    static_assert(GE::LDS_NEED <= M3_TAB && M3_TAB + 3 * M3_ROWS * 4 <= LDS_CTL_OFF, "expert LDS map");
    LAS int* r_tok = (LAS int*)(lds + M3_TAB); LAS int* r_aid = r_tok + M3_ROWS; LAS float* r_w = (LAS float*)(r_aid + M3_ROWS);
    bf16* hb = (bf16*)(a.ws + WS_HB) + (size_t)(vcu & 255) * M3_ROWS * ED;
    for (int e = vcu; e < NE; e += G) {
        const int n = cnt[e];
        const float* W1 = a.w1 + (size_t)e * D * ED; const float* W3 = a.w3 + (size_t)e * D * ED; const float* W2 = a.w2 + (size_t)e * ED * D;
        for (int sg0 = 0; sg0 < n; sg0 += M3_ROWS) {
            const int ns = (PF & 16) ? min(512, n - sg0) : min(M3_ROWS, n - sg0), nrg = (ns + 511) >> 9;
            __syncthreads();
            for (int i = tid; i < nrg * 512; i += NTHR) { int tok = 0, aid = -1; float w = 0.f;
                if (i < ns) { aid = list[(size_t)e * NTOK + sg0 + i]; tok = (PF & 8) ? ((e * 64 + i) & (NTOK - 1)) : (aid >> 3); w = ew[aid]; }
                r_tok[i] = tok; r_aid[i] = aid; r_w[i] = w; }
            __syncthreads();
            if (!(PF & 4)) for (int p = 0; p < 4; ++p)
                for (int rg = 0; rg < nrg; ++rg) {
                    f32x16 acc[2][4]; zero_acc(acc);
                    GE::run(lds, [&](int r) { return (r_aid[rg * 512 + r] < 0) ? (const bf16*)nullptr : (H2 + (size_t)r_tok[rg * 512 + r] * D); },
                            [&](int c) { return (c < 64) ? (W1 + 64 * p + c) : (W3 + 64 * p + c - 64); }, ED, D / 32, acc, nullptr);
#pragma unroll
                    for (int rb = 0; rb < 2; ++rb) { bf16* hrow = hb + (size_t)(rg * 512 + wave * 64 + rb * 32 + l31) * ED + 64 * p + 4 * h;
#pragma unroll
                        for (int cb = 0; cb < 2; ++cb)
#pragma unroll
                            for (int g4 = 0; g4 < 4; ++g4) { float hv[4];
#pragma unroll
                                for (int e4 = 0; e4 < 4; ++e4) { const float gt = acc[rb][cb][4 * g4 + e4], up = acc[rb][cb + 2][4 * g4 + e4]; hv[e4] = gt / (1.f + __expf(-gt)) * up; }
                                u32x2 w; w.x = cvt_pk(hv[0], hv[1]); w.y = cvt_pk(hv[2], hv[3]);
                                *(u32x2*)(hrow + cb * 32 + 8 * g4) = w; } }
                }
            asm volatile("s_waitcnt vmcnt(0)" ::: "memory");
            __syncthreads();
            if (tid == 0) { __builtin_amdgcn_fence(__ATOMIC_ACQUIRE, "agent"); asm volatile("s_waitcnt vmcnt(0)" ::: "memory"); }
            __syncthreads();
            if (!(PF & 2)) for (int qs = 0; qs < 8; ++qs)
                for (int rg = 0; rg < nrg; ++rg) {
                    f32x16 acc[2][4]; zero_acc(acc);
                    GE::run(lds, [&](int r) { return (r_aid[rg * 512 + r] < 0) ? (const bf16*)nullptr : (hb + (size_t)(rg * 512 + r) * ED); }, [&](int c) { return W2 + 128 * qs + c; }, D, ED / 32, acc, nullptr);
#pragma unroll
                    for (int rb = 0; rb < 2; ++rb) { const int row = rg * 512 + wave * 64 + rb * 32 + l31; const int aid = r_aid[row]; if (aid < 0) continue;
                        const float wg = r_w[row]; bf16* dst = YBUF + (size_t)aid * D + 128 * qs + 4 * h;
#pragma unroll
                        for (int cb = 0; cb < 4; ++cb)
#pragma unroll
                            for (int g4 = 0; g4 < 4; ++g4) { u32x2 w; w.x = cvt_pk(acc[rb][cb][4 * g4] * wg, acc[rb][cb][4 * g4 + 1] * wg); w.y = cvt_pk(acc[rb][cb][4 * g4 + 2] * wg, acc[rb][cb][4 * g4 + 3] * wg);
                                *(u32x2*)(dst + cb * 32 + 8 * g4) = w; } }
                }
        }
    }
}
constexpr int F8_TILE = 16384, F8_EXP_BYTES = 48 * F8_TILE;
constexpr float F8_S1 = 64.f, F8_S2 = 32.f;
template <int BMD, int SKIP = 0, int DBG = 0>
__device__ __forceinline__ void moe_chunk(const Args& a, LAS unsigned char* lds, int e, int ci) {
    constexpr int PDX = (BMD == 2) ? 1 : 4;
    typedef GemmCore<2, 4, 2, 4, 8, false, true, PDX, BMD, DBG> G1;
    typedef GemmCore<2, 4, 2, 4, 8, true, true, PDX, BMD> G2;
    static_assert(G1::LDS_NEED <= MOE_H_OFF && MOE_H_OFF + 8 * 8192 <= LDS_CTL_OFF, "MoE LDS map");
    const int tid = threadIdx.x, lane = tid & 63, wave = __builtin_amdgcn_readfirstlane(tid >> 6), wm = wave / 4, wn = wave % 4, h = lane >> 5, l31 = lane & 31;
    const bf16* H2 = (const bf16*)(a.ws + WS_H2); const int* cnt = (const int*)(a.ws + C_CNT); const int* list = (const int*)(a.ws + WS_LIST); const float* ew = (const float*)(a.ws + WS_EW);
    bf16* YBUF = (bf16*)(a.ws + WS_YBUF);
    LAS int* rowa = (LAS int*)(lds + LDS_CTL_OFF + 384);
    const int n = min(128, cnt[e] - ci * 128);
    const float* W1 = a.w1 + (size_t)e * D * ED; const float* W3 = a.w3 + (size_t)e * D * ED; const float* W2 = a.w2 + (size_t)e * ED * D;
    unsigned char* f8 = a.ws + WS_HB + (size_t)e * F8_EXP_BYTES;
    const float s1 = (BMD == 3) ? 1.f / F8_S1 : 1.f, s2 = (BMD == 3) ? 1.f / F8_S2 : 1.f;
    __syncthreads();
    if (tid < 128) rowa[tid] = (tid < n) ? list[(size_t)e * NTOK + ci * 128 + tid] : -1;
    __syncthreads();
    f32x16 acc[2][4]; zero_acc(acc);
    if (SKIP != 2) G1::run(lds, [&](int r) { const int aid = rowa[r]; return (aid < 0) ? (const bf16*)nullptr : (H2 + (size_t)(aid >> 3) * D); },
            [&](int c) { const int w4 = c >> 7, within = c & 127; return (within < 64) ? (W1 + 64 * w4 + within) : (W3 + 64 * w4 + within - 64); }, ED, D / 32, acc, nullptr, f8, F8_S1, (e * 5 + ci * 11) & 31);
#pragma unroll
    for (int rb = 0; rb < 2; ++rb) { const int row = wm * 64 + rb * 32 + l31;
#pragma unroll
        for (int cb = 0; cb < 2; ++cb)
#pragma unroll
            for (int g4 = 0; g4 < 4; ++g4) { float hv[4];
#pragma unroll
                for (int e4 = 0; e4 < 4; ++e4) { const float gt = acc[rb][cb][4 * g4 + e4] * s1, up = acc[rb][cb + 2][4 * g4 + e4] * s1; hv[e4] = gt / (1.f + __expf(-gt)) * up; }
                u32x2 w; w.x = cvt_pk(hv[0], hv[1]); w.y = cvt_pk(hv[2], hv[3]);
                *(LAS u32x2*)(lds + MOE_H_OFF + (2 * wn + cb) * 8192 + row * 64 + ((g4 ^ ((row >> 2) & 3)) << 4) + 8 * h) = w; } }
    __syncthreads();
    const int aid0 = rowa[wm * 64 + l31], aid1 = rowa[wm * 64 + 32 + l31];
    if (SKIP != 1) for (int nh = 0; nh < 2; ++nh) {
        zero_acc(acc);
        G2::run(lds, [&](int) { return (const bf16*)nullptr; }, [&](int c) { return W2 + nh * 512 + c; }, D, ED / 32, acc, lds + MOE_H_OFF, f8 + (size_t)(32 + nh * 8) * F8_TILE, F8_S2, (e * 3 + ci + nh * 4) & 7);
#pragma unroll
        for (int rb = 0; rb < 2; ++rb) {
            const int aid = rb ? aid1 : aid0; const float wgt = (aid < 0) ? 0.f : ew[aid] * s2;
            LAS unsigned char* yrow = lds + (wm * 32 + l31) * 1040 + (wn * 128 + 4 * h) * 2;
            __syncthreads();
#pragma unroll
            for (int cb = 0; cb < 4; ++cb)
#pragma unroll
                for (int g4 = 0; g4 < 4; ++g4) { u32x2 w; w.x = cvt_pk(acc[rb][cb][4 * g4] * wgt, acc[rb][cb][4 * g4 + 1] * wgt); w.y = cvt_pk(acc[rb][cb][4 * g4 + 2] * wgt, acc[rb][cb][4 * g4 + 3] * wgt);
                    *(LAS u32x2*)(yrow + (cb * 32 + 8 * g4) * 2) = w; }
            __syncthreads();
#pragma unroll
            for (int i = 0; i < 8; ++i) { const int lr = wave * 8 + i;
                const int ra = rowa[(lr >> 5) * 64 + rb * 32 + (lr & 31)];
                if (ra >= 0) *(u32x4*)(YBUF + (size_t)ra * D + nh * 512 + lane * 8) = *(const LAS u32x4*)(lds + lr * 1040 + lane * 16); }
        }
    }
}
__device__ __forceinline__ void moe_shared(const Args& a, LAS unsigned char* lds, int vcu, int G) {
    const int lane = threadIdx.x & 63, wave = __builtin_amdgcn_readfirstlane(threadIdx.x >> 6), h = lane >> 5, l31 = lane & 31;
    const bf16* H2 = (const bf16*)(a.ws + WS_H2); bf16* YSH = (bf16*)(a.ws + WS_YSH);
    typedef GemmCore<2, 2, 1, 8, 4, false, true, 4, 1> S1;
    typedef GemmCore<2, 2, 1, 8, 4, true, true, 4, 1> S2;
    constexpr int HOFF = S1::LDS_NEED;
    static_assert(HOFF + 8 * 4096 <= LDS_CTL_OFF, "shared-expert LDS map");
    const bf16* W13 = (const bf16*)(a.ws + WS_WS13T); const bf16* W2T = (const bf16*)(a.ws + WS_WS2T);
    for (int su = vcu; su < NTOK / 64; su += G) {
        const int t0 = su * 64;
        f32x16 acc[2][2]; zero_acc(acc);
        __syncthreads();
        S1::run(lds, [&](int r) { return H2 + (size_t)(t0 + r) * D; },
                [&](int c) { const int w8 = c >> 6, within = c & 63; return W13 + (size_t)((within < 32) ? (32 * w8 + within) : (ED + 32 * w8 + within - 32)) * D; }, D, D / 32, acc, nullptr);
#pragma unroll
        for (int rb = 0; rb < 2; ++rb) { const int row = rb * 32 + l31;
#pragma unroll
            for (int g4 = 0; g4 < 4; ++g4) { float hv[4];
#pragma unroll
                for (int e4 = 0; e4 < 4; ++e4) { const float gt = acc[rb][0][4 * g4 + e4], up = acc[rb][1][4 * g4 + e4]; hv[e4] = gt / (1.f + __expf(-gt)) * up; }
                u32x2 w; w.x = cvt_pk(hv[0], hv[1]); w.y = cvt_pk(hv[2], hv[3]);
                *(LAS u32x2*)(lds + HOFF + wave * 4096 + row * 64 + ((g4 ^ ((row >> 2) & 3)) << 4) + 8 * h) = w; } }
        __syncthreads();
        for (int nh = 0; nh < 2; ++nh) {
            zero_acc(acc);
            S2::run(lds, [&](int) { return (const bf16*)nullptr; }, [&](int c) { return W2T + (size_t)(nh * 512 + c) * ED; }, ED, ED / 32, acc, lds + HOFF);
#pragma unroll
            for (int rb = 0; rb < 2; ++rb) { bf16* dst = YSH + (size_t)(t0 + rb * 32 + l31) * D + nh * 512 + wave * 64 + 4 * h;
#pragma unroll
                for (int cb = 0; cb < 2; ++cb)
#pragma unroll
                    for (int g4 = 0; g4 < 4; ++g4) { u32x2 w; w.x = cvt_pk(acc[rb][cb][4 * g4], acc[rb][cb][4 * g4 + 1]); w.y = cvt_pk(acc[rb][cb][4 * g4 + 2], acc[rb][cb][4 * g4 + 3]);
                        *(u32x2*)(dst + cb * 32 + 8 * g4) = w; } }
        }
    }
}
template <int PARTS>
__device__ __forceinline__ void phase6_v6(const Args& a, LAS unsigned char* lds, int vcu, int G, const XcdBarrier bar) {
    const int tid = threadIdx.x;
    const int* cnt = (const int*)(a.ws + C_CNT);
    if (PARTS & 1) moe_shared(a, lds, vcu, G);
    if (PARTS & 2) for (int e = vcu; e < NE; e += G) if (cnt[e] > 0) moe_chunk<2>(a, lds, e, 0);
    xcd_barrier(bar);
    if (!(PARTS & 4)) return;
    LAS int* pf = (LAS int*)(lds + 0);
    __syncthreads();
    if (tid < NE) { const int c = (cnt[tid] + 127) >> 7; pf[tid + 1] = c > 0 ? c - 1 : 0; }
    if (tid == 0) pf[0] = 0;
    __syncthreads();
    if (tid == 0) { int s = 0; for (int e = 0; e < NE; ++e) { s += pf[e + 1]; pf[e + 1] = s; } }
    __syncthreads();
    const int total = pf[NE];
    LAS int* myu = (LAS int*)(lds + LDS_CTL_OFF + 256);
    int nmy = 0;
    for (int u = vcu; u < total; u += G) ++nmy;
    if (nmy > 16) nmy = 16;
    if (tid < nmy) { const int u = vcu + tid * G; int lo = 0, hi = NE - 1; while (lo < hi) { const int mid = (lo + hi) >> 1; if (pf[mid + 1] > u) hi = mid; else lo = mid + 1; }
        myu[tid] = lo; myu[16 + tid] = u - pf[lo] + 1; }
    __syncthreads();
    for (int iu = 0; iu < nmy; ++iu) { if (PARTS & 8) moe_chunk<3, 1, (PARTS >> 8)>(a, lds, myu[iu], myu[16 + iu]); else if (PARTS & 16) moe_chunk<3, 2>(a, lds, myu[iu], myu[16 + iu]); else moe_chunk<3>(a, lds, myu[iu], myu[16 + iu]); }
}
typedef long i64;
#define MFMA8(a, b, c) __builtin_amdgcn_mfma_f32_32x32x16_fp8_fp8((a), (b), (c), 0, 0, 0)
__device__ __forceinline__ i64 lo64(const u32x4& v) { return __builtin_bit_cast(i64, __builtin_shufflevector(v, v, 0, 1)); }
__device__ __forceinline__ i64 hi64(const u32x4& v) { return __builtin_bit_cast(i64, __builtin_shufflevector(v, v, 2, 3)); }
constexpr float F8_SH = 4.f;
constexpr float F8_SY = 16.f;
__device__ __forceinline__ void moe_convert(const Args& a, LAS unsigned char* lds, int vcu, int G) {
    const int lane = threadIdx.x & 63, wave = __builtin_amdgcn_readfirstlane(threadIdx.x >> 6);
    LAS float* scr = (LAS float*)(lds + wave * 8448);
    const int NIT = (NE + 1) * 48 * 8;
    for (int it = vcu * NWAVE + wave; it < NIT; it += G * NWAVE) {
        const int g = it & 7, T = (it >> 3) % 48, e = it / (48 * 8);
        const float* W1 = (e < NE) ? a.w1 + (size_t)e * D * ED : a.ws1; const float* W3 = (e < NE) ? a.w3 + (size_t)e * D * ED : a.ws3; const float* W2 = (e < NE) ? a.w2 + (size_t)e * ED * D : a.ws2;
        const float* src; int ld; float sc;
        if (T < 32) { src = ((lane & 32) ? W3 : W1) + (size_t)(32 * T) * ED + 32 * g - (lane & 32); ld = ED; sc = F8_S1; }
        else { const int t2 = T - 32, nh = t2 >> 3, ks = t2 & 7; src = W2 + (size_t)(32 * ks) * D + nh * 512 + 64 * g; ld = D; sc = F8_S2; }
#pragma unroll 8
        for (int k = 0; k < 32; ++k) scr[k * 65 + lane] = src[(size_t)k * ld + lane];
        asm volatile("s_waitcnt lgkmcnt(0)" ::: "memory");
        unsigned o[8];
#pragma unroll
        for (int d = 0; d < 8; ++d) { int p = __builtin_amdgcn_cvt_pk_fp8_f32(scr[(4 * d) * 65 + lane] * sc, scr[(4 * d + 1) * 65 + lane] * sc, 0, false);
            p = __builtin_amdgcn_cvt_pk_fp8_f32(scr[(4 * d + 2) * 65 + lane] * sc, scr[(4 * d + 3) * 65 + lane] * sc, p, true); o[d] = (unsigned)p; }
        unsigned char* dst = ((e < NE) ? a.ws + WS_HB + (size_t)e * F8_EXP_BYTES : a.ws + WS_WS13T) + (size_t)T * F8_TILE + (size_t)(64 * g + lane) * 32;
        *(u32x4*)dst = (u32x4){o[0], o[1], o[2], o[3]}; *(u32x4*)(dst + 16) = (u32x4){o[4], o[5], o[6], o[7]};
        asm volatile("s_waitcnt lgkmcnt(0)" ::: "memory");
    }
}
constexpr int M8_H = 0, M8_HSTR = 272, M8_Y = 36864;
__device__ __forceinline__ void moe_chunk8(const Args& a, LAS unsigned char* lds, int e, int ci) {
    int tid = threadIdx.x; asm volatile("" : "+v"(tid));
    const int lane = tid & 63, wave = __builtin_amdgcn_readfirstlane(tid >> 6), h = lane >> 5, l31 = lane & 31;
    const int* cnt = (const int*)(a.ws + C_CNT); const int* list = (const int*)(a.ws + WS_LIST); const float* ew = (const float*)(a.ws + WS_EW);
    const bool routed = e < NE;
    const unsigned char* X8 = a.ws + WS_X8;
    LAS int* rowa = (LAS int*)(lds + LDS_CTL_OFF + 384);
    const int n = routed ? min(128, cnt[e] - ci * 128) : 128;
#ifdef PROF_SECT
    unsigned long long* tsq = (unsigned long long*)(a.ws + C_TS); unsigned long long tq0 = __builtin_amdgcn_s_memrealtime();
#define SECT(i) do { if (blockIdx.x == 0 && threadIdx.x == 0) { const unsigned long long tq1 = __builtin_amdgcn_s_memrealtime(); tsq[21 + 2 * (i)] += tq1 - tq0; tq0 = tq1; } } while (0)
#else
#define SECT(i) do {} while (0)
#endif
    const unsigned char* f8 = (routed ? a.ws + WS_HB + (size_t)e * F8_EXP_BYTES : a.ws + WS_WS13T) + (size_t)(64 * wave + l31) * 32 + 16 * h;
    __syncthreads();
    if (tid < 128) rowa[tid] = (tid < n) ? (routed ? list[(size_t)e * NTOK + ci * 128 + tid] : ci * 128 + tid) : -1;
    __syncthreads();
    const int tsh = routed ? 3 : 0;
    {
        u32x4 xr[16];
#pragma unroll
        for (int i = 0; i < 16; ++i) { const int p = tid + NTHR * i, row = p >> 6, c = p & 63; const int ra = rowa[row];
            xr[i] = *(const u32x4*)(X8 + (size_t)((ra < 0) ? (p & (NTOK - 1)) : (ra >> tsh)) * D + c * 16); }
#pragma unroll
        for (int i = 0; i < 16; ++i) { const int p = tid + NTHR * i, row = p >> 6, c = p & 63; *(LAS u32x4*)(lds + row * 1040 + c * 16) = xr[i]; }
    }
    __syncthreads();
    SECT(0);
    f32x16 acc[4][2]; zero_acc(acc);
    typedef int i32x8 __attribute__((ext_vector_type(8)));
#define MFMAX(a8, b8, c) __builtin_amdgcn_mfma_scale_f32_32x32x64_f8f6f4((a8), (b8), (c), 0, 0, 0, 0x7f7f7f7f, 0, 0x7f7f7f7f)
    u32x4 wb[4][2][2];
    const unsigned char* f8h = f8 - 16 * h + (size_t)h * F8_TILE;
    const LAS unsigned char* xl = lds + l31 * 1040 + 32 * h;
    auto ld1 = [&](int d, int KS) { const unsigned char* p = f8h + (size_t)(2 * KS) * F8_TILE;
        wb[d][0][0] = *(const u32x4*)p; wb[d][0][1] = *(const u32x4*)(p + 16); wb[d][1][0] = *(const u32x4*)(p + 1024); wb[d][1][1] = *(const u32x4*)(p + 1040); };
    auto mk8 = [&](const u32x4 lo, const u32x4 hi) { return (i32x8){(int)lo.x, (int)lo.y, (int)lo.z, (int)lo.w, (int)hi.x, (int)hi.y, (int)hi.z, (int)hi.w}; };
#pragma unroll
    for (int d = 0; d < 4; ++d) ld1(d, d);
#pragma unroll 1
    for (int ks0 = 0; ks0 < 16; ks0 += 4) {
#pragma unroll
        for (int d = 0; d < 4; ++d) { const int KS = ks0 + d;
            const i32x8 b0 = mk8(wb[d][0][0], wb[d][0][1]), b1 = mk8(wb[d][1][0], wb[d][1][1]);
#pragma unroll
            for (int rb = 0; rb < 4; ++rb) { const i32x8 x = mk8(*(const LAS u32x4*)(xl + rb * 32 * 1040 + 64 * KS), *(const LAS u32x4*)(xl + rb * 32 * 1040 + 64 * KS + 16));
                acc[rb][0] = MFMAX(b0, x, acc[rb][0]); acc[rb][1] = MFMAX(b1, x, acc[rb][1]); }
            ld1(d, min(KS + 4, 12 + d)); asm volatile("" ::: "memory"); }
    }
    asm volatile("s_waitcnt vmcnt(0)" ::: "memory");
    __syncthreads();
    SECT(1);
    {
        const float s1 = 1.f / F8_S1;
#pragma unroll
        for (int rb = 0; rb < 4; ++rb) { const int row = rb * 32 + l31;
#pragma unroll
            for (int g4 = 0; g4 < 4; ++g4) { float hv[4];
#pragma unroll
                for (int e4 = 0; e4 < 4; ++e4) { const float gt = acc[rb][0][4 * g4 + e4] * s1, up = acc[rb][1][4 * g4 + e4] * s1; hv[e4] = fminf(fmaxf(gt * __builtin_amdgcn_rcpf(1.f + __expf(-gt)) * up * F8_SH, -440.f), 440.f); }
                int p = __builtin_amdgcn_cvt_pk_fp8_f32(hv[0], hv[1], 0, false); p = __builtin_amdgcn_cvt_pk_fp8_f32(hv[2], hv[3], p, true);
                *(LAS int*)(lds + M8_H + row * M8_HSTR + 32 * wave + 8 * g4 + 4 * h) = p; } }
    }
    __syncthreads();
    SECT(2);
    const LAS unsigned char* hp = lds + M8_H + l31 * M8_HSTR + 32 * h;
    for (int nh = 0; nh < 2; ++nh) {
        zero_acc(acc);
        const unsigned char* p2 = f8h + (size_t)(32 + nh * 8) * F8_TILE;
#pragma unroll
        for (int d = 0; d < 4; ++d) { const unsigned char* p = p2 + (size_t)(2 * d) * F8_TILE;
            wb[d][0][0] = *(const u32x4*)p; wb[d][0][1] = *(const u32x4*)(p + 16); wb[d][1][0] = *(const u32x4*)(p + 1024); wb[d][1][1] = *(const u32x4*)(p + 1040); }
#pragma unroll
        for (int d = 0; d < 4; ++d) {
            const i32x8 b0 = mk8(wb[d][0][0], wb[d][0][1]), b1 = mk8(wb[d][1][0], wb[d][1][1]);
#pragma unroll
            for (int rb = 0; rb < 4; ++rb) { const i32x8 x = mk8(*(const LAS u32x4*)(hp + rb * 32 * M8_HSTR + 64 * d), *(const LAS u32x4*)(hp + rb * 32 * M8_HSTR + 64 * d + 16));
                acc[rb][0] = MFMAX(b0, x, acc[rb][0]); acc[rb][1] = MFMAX(b1, x, acc[rb][1]); }
        }
        SECT(3);
        const float s2 = F8_SY / (F8_S2 * F8_SH);
        unsigned char* Y8 = a.ws + (routed ? WS_YBUF : WS_YSH);
#pragma unroll
        for (int hf = 0; hf < 2; ++hf) {
            __syncthreads();
#pragma unroll
            for (int r2 = 0; r2 < 2; ++r2) { const int rb = hf * 2 + r2; const int aid = rowa[rb * 32 + l31]; const float wgt = (aid < 0) ? 0.f : (routed ? ew[aid] : 1.f) * s2;
                LAS unsigned char* yrow = lds + M8_Y + (r2 * 32 + l31) * 528 + wave * 64 + 4 * h;
#pragma unroll
                for (int cb = 0; cb < 2; ++cb)
#pragma unroll
                    for (int g4 = 0; g4 < 4; ++g4) { int p = __builtin_amdgcn_cvt_pk_fp8_f32(acc[rb][cb][4 * g4] * wgt, acc[rb][cb][4 * g4 + 1] * wgt, 0, false);
                        p = __builtin_amdgcn_cvt_pk_fp8_f32(acc[rb][cb][4 * g4 + 2] * wgt, acc[rb][cb][4 * g4 + 3] * wgt, p, true);
                        *(LAS int*)(yrow + cb * 32 + 8 * g4) = p; } }
            __syncthreads();
#pragma unroll
            for (int i = 0; i < 4; ++i) { const int lr = wave * 8 + i * 2 + h; const int ra = rowa[hf * 64 + lr];
                if (ra >= 0) *(u32x4*)(Y8 + (size_t)ra * D + nh * 512 + l31 * 16) = *(const LAS u32x4*)(lds + M8_Y + lr * 528 + l31 * 16); }
        }
        SECT(4);
    }
}
template <int PARTS>
__device__ __forceinline__ void phase6_v7(const Args& a, LAS unsigned char* lds, int vcu, int G, const XcdBarrier bar) {
    const int tid = threadIdx.x;
    const int* cnt = (const int*)(a.ws + C_CNT);
    if (PARTS & 1) moe_convert(a, lds, vcu, G);
    __syncthreads();
    xcd_barrier(bar);
    if (!(PARTS & 4)) return;
    LAS int* pf = (LAS int*)(lds + 65536);
    __syncthreads();
    if (tid < NE) pf[tid + 1] = (cnt[tid] + 127) >> 7;
    if (tid == 0) pf[0] = 0;
    __syncthreads();
    if (tid == 0) { int s = 0; for (int e = 0; e < NE; ++e) { s += pf[e + 1]; pf[e + 1] = s; } }
    __syncthreads();
    constexpr int NSH = NTOK / 128;
    const int total = NSH + pf[NE];
    LAS int* myu = (LAS int*)(lds + LDS_CTL_OFF + 256);
    int nmy = 0;
    for (int u = vcu; u < total; u += G) ++nmy;
    if (nmy > 16) nmy = 16;
    if (tid < nmy) { const int u = vcu + tid * G;
        if (u < NSH) { myu[tid] = NE; myu[16 + tid] = u; }
        else { const int ru = u - NSH; int lo = 0, hi = NE - 1; while (lo < hi) { const int mid = (lo + hi) >> 1; if (pf[mid + 1] > ru) hi = mid; else lo = mid + 1; }
            myu[tid] = lo; myu[16 + tid] = ru - pf[lo]; } }
    __syncthreads();
    for (int iu = 0; iu < nmy; ++iu) moe_chunk8(a, lds, myu[iu], myu[16 + iu]);
}
__device__ __forceinline__ void phase7(const Args& a, int vcu, int G) {
    const int lane = threadIdx.x & 63, gw = vcu * NWAVE + (threadIdx.x >> 6), NGW = G * NWAVE;
#ifdef PROF_K
    const unsigned long long* ts = (const unsigned long long*)(a.ws + C_TS);
    const float prof_b1 = rintf(log2f(fmaxf((float)(ts[PROF_K + 1] - ts[PROF_K]) * 0.01f, 1.f)) * 4.f), prof_us2 = exp2f(rintf(log2f(fmaxf((float)(ts[PROF_KE] - ts[PROF_K2]) * 0.01f, 1.f)) * 4.f) * 0.25f);
    const float prof_scale = 1.f + prof_b1 * PROF_S;
#else
    const float prof_scale = 1.f;
#endif
    const float* X1 = (const float*)(a.ws + WS_X1); const float* mod = (const float*)(a.ws + C_MOD);
    const unsigned char* YB = a.ws + WS_YBUF; const unsigned char* YS = a.ws + WS_YSH;
    for (int t = gw; t < NTOK; t += NGW) { const int b = t / S, c0 = lane * 16;
        float m[16];
        { const u32x4 w = *(const u32x4*)(YS + (size_t)t * D + c0);
#pragma unroll
          for (int d = 0; d < 4; ++d) { const auto lo = __builtin_amdgcn_cvt_pk_f32_fp8((int)w[d], false), hi = __builtin_amdgcn_cvt_pk_f32_fp8((int)w[d], true); m[4 * d] = lo[0]; m[4 * d + 1] = lo[1]; m[4 * d + 2] = hi[0]; m[4 * d + 3] = hi[1]; } }
#pragma unroll
        for (int r = 0; r < 8; ++r) { const u32x4 w = *(const u32x4*)(YB + ((size_t)t * 8 + r) * D + c0);
#pragma unroll
            for (int d = 0; d < 4; ++d) { const auto lo = __builtin_amdgcn_cvt_pk_f32_fp8((int)w[d], false), hi = __builtin_amdgcn_cvt_pk_f32_fp8((int)w[d], true); m[4 * d] += lo[0]; m[4 * d + 1] += lo[1]; m[4 * d + 2] += hi[0]; m[4 * d + 3] += hi[1]; } }
        f32x4 v[4]; float s = 0.f;
#pragma unroll
        for (int j = 0; j < 4; ++j) { const f32x4 xv = *(const f32x4*)(X1 + (size_t)t * D + c0 + 4 * j), g2 = *(const f32x4*)(mod + b * 6 * D + 5 * D + c0 + 4 * j);
            v[j].x = xv.x + g2.x * m[4 * j] * (1.f / F8_SY); v[j].y = xv.y + g2.y * m[4 * j + 1] * (1.f / F8_SY); v[j].z = xv.z + g2.z * m[4 * j + 2] * (1.f / F8_SY); v[j].w = xv.w + g2.w * m[4 * j + 3] * (1.f / F8_SY);
            s += (v[j].x * v[j].x + v[j].y * v[j].y) + (v[j].z * v[j].z + v[j].w * v[j].w); }
        const float rstd = rsqrtf(wave_sum(s) * (1.f / D) + EPS);
#pragma unroll
        for (int j = 0; j < 4; ++j) { const f32x4 fg = *(const f32x4*)(a.final_g + c0 + 4 * j);
            f32x4 o; o.x = v[j].x * rstd * fg.x * prof_scale; o.y = v[j].y * rstd * fg.y * prof_scale; o.z = v[j].z * rstd * fg.z * prof_scale; o.w = v[j].w * rstd * fg.w * prof_scale;
#ifdef PROF_K
            if (t == 0 && lane == 0 && j == 0) o.x = prof_us2;
#endif
            *(f32x4*)(a.out + (size_t)t * D + c0 + 4 * j) = o; }
    }
}
__global__ void __launch_bounds__(NTHR, 2) mega(Args a) {
    extern __shared__ __attribute__((aligned(16))) unsigned char lds_raw[];
    LAS unsigned char* lds = (LAS unsigned char*)lds_raw;
    const int tid = threadIdx.x, G = gridDim.x;
    const int bx = blockIdx.x, vcu = (G % 8 == 0) ? (bx % 8) * (G / 8) + bx / 8 : bx;
    volatile LAS unsigned* ctl = (volatile LAS unsigned*)(lds + LDS_CTL_OFF);
    if (tid < 64) ctl[tid] = 0u;
    __syncthreads();
    XcdBarrier bar = xcd_barrier_post((unsigned*)(a.ws + C_BAR) + a.ph_lo * XCD_BAR_WORDS, ctl);
    const int lo = a.ph_lo, hi = a.ph_hi;
#ifndef ONLY_PHASE
#define ONLY_PHASE -1
#endif
#define IN(k) (lo <= (k) && (k) < hi && (ONLY_PHASE < 0 || ONLY_PHASE == (k)))
#ifndef XBAR
#define XBAR 1
#endif
#ifdef PROF_K
#define STAMP(i) do { if (blockIdx.x == 0 && tid == 0) ((unsigned long long*)(a.ws + C_TS))[i] = __builtin_amdgcn_s_memrealtime(); } while (0)
#else
#define STAMP(i) do {} while (0)
#endif
#define SEAM(k) do { if (IN(k) && IN((k) + 1)) { STAMP(2 * (k) + 1); for (int xb = 0; xb < XBAR; ++xb) xcd_barrier(bar); STAMP(2 * (k) + 2); } } while (0)
    STAMP(0);
#ifndef REP_PHASE
#define REP_PHASE -1
#endif
#ifndef REP_N
#define REP_N 1
#endif
#define NREP(k) ((REP_PHASE == (k)) ? REP_N : 1)
    if (IN(0))
#pragma unroll 1
    for (int rep = 0; rep < NREP(0); ++rep) { phase0(a, lds, vcu, G); __syncthreads(); }
    SEAM(0);
    if (IN(1)) for (int rep = 0; rep < NREP(1); ++rep) phase1(a, vcu, G);
    SEAM(1);
    if (IN(2)) for (int rep = 0; rep < NREP(2); ++rep) phase2(a, lds, vcu, G);
    SEAM(2);
    if (IN(3)) for (int rep = 0; rep < NREP(3); ++rep) phase3(a, lds, vcu, G);
    SEAM(3);
#if FUSE45
#ifdef PROBE_45
    if (IN(4)) { phase45<PROBE_45>(a, lds, vcu, G); __syncthreads(); }
#endif
    if (IN(4)) phase45<0>(a, lds, vcu, G);
#else
    if (IN(4)) for (int rep = 0; rep < NREP(4); ++rep) phase4(a, lds, vcu, G);
    SEAM(4);
    if (IN(5)) for (int rep = 0; rep < NREP(5); ++rep) phase5(a, lds, vcu, G, rep > 0);
#endif
    SEAM(5);
#ifndef MOE_V2
#define MOE_V2 7
#endif
#ifdef PROBE_MOE
    if (IN(6)) { phase6_v7<PROBE_MOE>(a, lds, vcu, G, bar); xcd_barrier(bar); }
#endif
    if (IN(6)) for (int rep = 0; rep < NREP(6); ++rep) { if (MOE_V2 == 7) phase6_v7<7>(a, lds, vcu, G, bar); else if (MOE_V2 == 6) phase6_v6<7>(a, lds, vcu, G, bar); else if (MOE_V2 == 3) phase6<0>(a, lds, vcu, G); else if (MOE_V2 == 2) phase6_v2(a, lds, vcu, G); else phase6_old(a, lds, vcu, G, bar, false); }
    SEAM(6);
    if (IN(7)) for (int rep = 0; rep < NREP(7); ++rep) phase7(a, vcu, G);
#undef IN
#undef SEAM
}

#ifndef OPT_MASK
#define OPT_MASK 0xFF
#endif
static void launch_mega(const Args& base, int lo, int hi, int grid, hipStream_t stream) {
    Args a = base; a.ph_lo = lo; a.ph_hi = hi;
    hipLaunchKernelGGL(mega, dim3(grid), dim3(NTHR), LDS_BYTES, stream, a);
}
extern "C" void kernel_launch(void* const* d_in, const int* in_sizes, int n_in, void* d_out, int out_size, void* d_ws, size_t ws_size, hipStream_t stream) {
    static int grid = 0;
    if (grid == 0) {
        if (n_in != 21 || ws_size < WS_END) { fprintf(stderr, "kernel_launch: unexpected n_in %d or ws_size %zu\n", n_in, ws_size); grid = -1; return; }
        int dev = 0, cus = 0, per_cu = 0;
        if (hipGetDevice(&dev) != hipSuccess || hipDeviceGetAttribute(&cus, hipDeviceAttributeMultiprocessorCount, dev) != hipSuccess) { grid = -1; return; }
        if (hipFuncSetAttribute((const void*)mega, hipFuncAttributeMaxDynamicSharedMemorySize, LDS_BYTES) != hipSuccess) { fprintf(stderr, "kernel_launch: hipFuncSetAttribute failed\n"); grid = -1; return; }
        if (hipOccupancyMaxActiveBlocksPerMultiprocessor(&per_cu, (const void*)mega, NTHR, LDS_BYTES) != hipSuccess || per_cu < 1) { fprintf(stderr, "kernel_launch: occupancy query says %d blocks per CU\n", per_cu); (void)hipGetLastError(); grid = -1; return; }
        grid = cus;
    }
    if (grid < 0) return;
    unsigned char* ws = (unsigned char*)d_ws;
    Args a{};
    a.x = (const float*)d_in[0]; a.c = (const float*)d_in[1]; a.w_ada = (const float*)d_in[2]; a.b_ada = (const float*)d_in[3]; a.norm1_g = (const float*)d_in[4]; a.w_in = (const float*)d_in[5];
    a.sinks = (const float*)d_in[6]; a.rel_table = (const float*)d_in[7]; a.out_norm_a = (const float*)d_in[8]; a.out_norm_b = (const float*)d_in[9]; a.w_out = (const float*)d_in[10];
    a.norm2_g = (const float*)d_in[11]; a.w_router = (const float*)d_in[12]; a.e_bias = (const float*)d_in[13]; a.w1 = (const float*)d_in[14]; a.w3 = (const float*)d_in[15]; a.w2 = (const float*)d_in[16];
    a.ws1 = (const float*)d_in[17]; a.ws3 = (const float*)d_in[18]; a.ws2 = (const float*)d_in[19]; a.final_g = (const float*)d_in[20];
    a.out = (float*)d_out; a.ws = ws; a.ph_lo = 0; a.ph_hi = 8;
    (void)hipMemsetAsync(ws + WS_CTL, 0, CTL_BYTES, stream);
#if defined(P0_TIMING)
    for (int r = 0; r < P0_TIMING; ++r) launch_mega(a, 0, 1, grid, stream);
    launch_mega(a, 1, 8, grid, stream);
#elif OPT_MASK == 0xFF && !defined(SPLIT_LAUNCH)
    launch_mega(a, 0, 8, grid, stream);
#else
    float* mod = (float*)(ws + C_MOD); float* ksum = (float*)(ws + C_KSUM); float* ssq = (float*)(ws + WS_SSQ); int* cnt = (int*)(ws + C_CNT);
    float* lut = (float*)(ws + WS_LUT); bf16* H = (bf16*)(ws + WS_H);
    bf16* QA = (bf16*)(ws + WS_QA); bf16* KA = (bf16*)(ws + WS_KA); bf16* VAT = (bf16*)(ws + WS_VAT); bf16* QB = (bf16*)(ws + WS_QB); bf16* KB = (bf16*)(ws + WS_KB); bf16* VBT = (bf16*)(ws + WS_VBT);
    bf16* ATT = (bf16*)(ws + WS_ATT); float* X1 = (float*)(ws + WS_X1); bf16* H2 = (bf16*)(ws + WS_H2); float* EW = (float*)(ws + WS_EW); int* LIST = (int*)(ws + WS_LIST);
    bf16* YSH = (bf16*)(ws + WS_YSH); bf16* YBUF = (bf16*)(ws + WS_YBUF);
    if (OPT_MASK & 1) launch_mega(a, 0, 1, grid, stream); else { k_mod<<<24, 256, 0, stream>>>(a.c, a.w_ada, a.b_ada, mod); k_lut<<<(16 * LUTN + 255) / 256, 256, 0, stream>>>(a.rel_table, lut); }
    if (OPT_MASK & 2) launch_mega(a, 1, 2, grid, stream); else k_norm_mod<<<NTOK, 256, 0, stream>>>(a.x, a.norm1_g, mod, 0, D, H);
    if (OPT_MASK & 4) launch_mega(a, 2, 3, grid, stream); else k_inproj<<<dim3(INC / 256, NTOK), 256, 0, stream>>>(H, a.w_in, QA, KA, VAT, QB, KB, VBT, ksum);
    if (OPT_MASK & 8) launch_mega(a, 3, 4, grid, stream); else { k_swa<<<NTOK * 8 / 64, 64, 0, stream>>>(QA, KA, VAT, lut, a.sinks, a.out_norm_a, ATT, ssq); k_moba<<<NTOK * 8 / 64, 64, 0, stream>>>(QB, KB, VBT, ksum, lut, a.out_norm_b, ATT, ssq); }
    if (OPT_MASK & 16) launch_mega(a, 4, 5, grid, stream); else k_outproj<<<dim3(D / 256, NTOK), 256, 0, stream>>>(ATT, ssq, a.w_out, a.x, mod, X1);
    if (OPT_MASK & 32) launch_mega(a, 5, 6, grid, stream); else { k_norm_mod<<<NTOK, 256, 0, stream>>>(X1, a.norm2_g, mod, 3 * D, 4 * D, H2); k_router<<<NTOK, 256, 0, stream>>>(H2, a.w_router, a.e_bias, cnt, LIST, EW); }
    if (OPT_MASK & 64) launch_mega(a, 6, 7, grid, stream); else k_moe<<<dim3(NTOK / 8, NE + 1), 256, 0, stream>>>(H2, cnt, LIST, EW, a.w1, a.w3, a.w2, a.ws1, a.ws3, a.ws2, YBUF, YSH);
    if (OPT_MASK & 128) launch_mega(a, 7, 8, grid, stream); else k_final<<<NTOK, 256, 0, stream>>>(X1, YBUF, YSH, mod, a.final_g, (float*)d_out);
#endif
}
```

```cpp
#include <hip/hip_runtime.h>
#include <cstdio>
#include <cstdint>

constexpr int D = 1024, NB = 8, S = 2048, NTOK = NB * S;
constexpr int HD = 64, INC = 2304;
constexpr int NE = 256, TOPK = 8, ED = 256;
constexpr float EPS = 1e-6f;
constexpr float LOG2E = 1.4426950408889634f;
constexpr float QSCALE = 0.125f * LOG2E;
constexpr float NEGBIG = -1e30f;

typedef unsigned short bf16;
__device__ __forceinline__ float bf2f(bf16 v) { return __uint_as_float(((unsigned)v) << 16); }
__device__ __forceinline__ bf16 f2bf(float f) { unsigned u = __float_as_uint(f); return (bf16)((u + 0x7fffu + ((u >> 16) & 1u)) >> 16); }

constexpr size_t MiB = 1u << 20;
constexpr size_t WS_CTL   = 0;
constexpr size_t CTL_BYTES = 1 * MiB;
constexpr size_t C_MOD   = 64 * 1024;
constexpr size_t C_KSUM  = 320 * 1024;
constexpr size_t C_SSQA  = 512 * 1024;
constexpr size_t C_SSQB  = 576 * 1024;
constexpr size_t C_CNT   = 640 * 1024;
constexpr size_t C_QHEAD = 644 * 1024;
constexpr size_t C_TS    = 648 * 1024;
constexpr size_t WS_LUT  = 1 * MiB;
constexpr size_t WS_H    = 2 * MiB;
constexpr size_t WS_QA   = 34 * MiB;
constexpr size_t WS_KA   = 50 * MiB;
constexpr size_t WS_VAT  = 54 * MiB;
constexpr size_t WS_QB   = 58 * MiB;
constexpr size_t WS_KB   = 74 * MiB;
constexpr size_t WS_VBT  = 90 * MiB;
constexpr size_t WS_ATT  = 106 * MiB;
constexpr size_t WS_X1   = 138 * MiB;
constexpr size_t WS_H2   = 202 * MiB;
constexpr size_t WS_EW   = 234 * MiB;
constexpr size_t WS_SSQ  = 235 * MiB;
constexpr size_t WS_LIST = 236 * MiB;
constexpr size_t WS_YSH  = 256 * MiB;
constexpr size_t WS_YBUF = 288 * MiB;
constexpr size_t WS_WTIN = 640 * MiB;
constexpr size_t WS_WTOUT= 645 * MiB;
constexpr size_t WS_WTR  = 647 * MiB;
constexpr size_t WS_WS13T= 648 * MiB;
constexpr size_t WS_WS2T = 649 * MiB;
constexpr size_t WS_HB   = 650 * MiB;
constexpr size_t WS_X8   = 842 * MiB;
constexpr size_t WS_END  = 858 * MiB;

constexpr int LUT_NEG = 256;
constexpr int LUTN = 2560;

__device__ __forceinline__ int t5_bucket(int n) {
    if (n < 16) return n;
    const int thr[15] = {21, 27, 35, 46, 59, 77, 99, 128, 166, 216, 280, 363, 470, 609, 790};
    int b = 16;
#pragma unroll
    for (int i = 0; i < 15; ++i) b += (n >= thr[i]) ? 1 : 0;
    return b;
}

__global__ void k_mod(const float* c, const float* w_ada, const float* b_ada, float* mod) {
    int j = blockIdx.x * blockDim.x + threadIdx.x;
    if (j >= 6 * D) return;
    float acc[NB];
#pragma unroll
    for (int b = 0; b < NB; ++b) acc[b] = 0.f;
    for (int k = 0; k < D; ++k) {
        float w = w_ada[(size_t)k * 6 * D + j];
#pragma unroll
        for (int b = 0; b < NB; ++b) { float cv = c[b * D + k]; float sv = cv / (1.f + __expf(-cv)); acc[b] += sv * w; }
    }
#pragma unroll
    for (int b = 0; b < NB; ++b) mod[b * 6 * D + j] = acc[b] + b_ada[j];
}
__global__ void k_lut(const float* rel_table, float* lut) {
    int i = blockIdx.x * blockDim.x + threadIdx.x;
    if (i >= 16 * LUTN) return;
    int h = i / LUTN, p = i % LUTN, dist = p - LUT_NEG;
    float v = NEGBIG;
    bool ok = dist >= 0 && (h < 8 ? dist < 128 : dist < S);
    if (ok) v = rel_table[t5_bucket(dist) * 16 + h] * LOG2E;
    lut[i] = v;
}
__global__ void k_norm_mod(const float* x, const float* g, const float* mod, int sh_off, int sc_off, bf16* out) {
    int t = blockIdx.x, b = t / S, tid = threadIdx.x;
    __shared__ float red[256];
    float v[4]; float s = 0.f;
#pragma unroll
    for (int i = 0; i < 4; ++i) { v[i] = x[(size_t)t * D + tid + 256 * i]; s += v[i] * v[i]; }
    red[tid] = s; __syncthreads();
    for (int o = 128; o > 0; o >>= 1) { if (tid < o) red[tid] += red[tid + o]; __syncthreads(); }
    float rstd = rsqrtf(red[0] / D + EPS);
#pragma unroll
    for (int i = 0; i < 4; ++i) { int col = tid + 256 * i;
        float hv = v[i] * rstd * g[col] * (1.f + mod[b * 6 * D + sc_off + col]) + mod[b * 6 * D + sh_off + col];
        out[(size_t)t * D + col] = f2bf(hv); }
}
__global__ void k_inproj(const bf16* h, const float* w_in, bf16* QA, bf16* KA, bf16* VAT, bf16* QB, bf16* KB, bf16* VBT, float* ksum) {
    int col = blockIdx.x * blockDim.x + threadIdx.x;
    int t = blockIdx.y;
    if (col >= INC) return;
    float acc = 0.f;
    const bf16* hr = h + (size_t)t * D;
    for (int k = 0; k < D; ++k) acc += bf2f(hr[k]) * w_in[(size_t)k * INC + col];
    int b = t / S, s = t % S;
    if (col < 512) { int hh = col / 64, d = col % 64; QA[(((size_t)b * 8 + hh) * S + s) * 64 + d] = f2bf(acc * QSCALE); }
    else if (col < 640) { int c2 = col - 512, hh = c2 / 64, d = c2 % 64; KA[(((size_t)b * 2 + hh) * S + s) * 64 + d] = f2bf(acc); }
    else if (col < 768) { int c2 = col - 640, hh = c2 / 64, d = c2 % 64; VAT[(((size_t)b * 2 + hh) * 64 + d) * S + s] = f2bf(acc); }
    else if (col < 1280) { int c2 = col - 768, hh = c2 / 64, d = c2 % 64; QB[(((size_t)b * 8 + hh) * S + s) * 64 + d] = f2bf(acc * QSCALE); }
    else if (col < 1792) { int c2 = col - 1280, hh = c2 / 64, d = c2 % 64; bf16 kb = f2bf(acc); KB[(((size_t)b * 8 + hh) * S + s) * 64 + d] = kb;
        atomicAdd(&ksum[(((size_t)b * 8 + hh) * 8 + s / 256) * 64 + d], bf2f(kb)); }
    else { int c2 = col - 1792, hh = c2 / 64, d = c2 % 64; VBT[(((size_t)b * 8 + hh) * 64 + d) * S + s] = f2bf(acc); }
}
__global__ void __launch_bounds__(64) k_swa(const bf16* QA, const bf16* KA, const bf16* VAT, const float* lut, const float* sinks, const float* gain, bf16* att, float* ssq) {
    int idx = blockIdx.x * blockDim.x + threadIdx.x;
    if (idx >= NTOK * 8) return;
    int hh = idx % 8, t = idx / 8, b = t / S, s = t % S, kv = hh / 4;
    float q[64];
    const bf16* qp = QA + (((size_t)b * 8 + hh) * S + s) * 64;
#pragma unroll
    for (int d = 0; d < 64; ++d) q[d] = bf2f(qp[d]);
    const float* L = lut + hh * LUTN + LUT_NEG;
    int n = s / 128;
    int k0 = (n == 0) ? 0 : (n - 1) * 128, k1 = s;
    float m = NEGBIG, l = 0.f; float o[64];
#pragma unroll
    for (int d = 0; d < 64; ++d) o[d] = 0.f;
    for (int kp = k0; kp <= k1; ++kp) {
        const bf16* kr = KA + (((size_t)b * 2 + kv) * S + kp) * 64;
        float sc = 0.f;
#pragma unroll
        for (int d = 0; d < 64; ++d) sc += q[d] * bf2f(kr[d]);
        sc += L[s - kp];
        float mn = fmaxf(m, sc), a = exp2f(m - mn), p = exp2f(sc - mn);
        l = l * a + p;
#pragma unroll
        for (int d = 0; d < 64; ++d) o[d] = o[d] * a + p * bf2f(VAT[(((size_t)b * 2 + kv) * 64 + d) * S + kp]);
        m = mn;
    }
    float sk = sinks[hh] * LOG2E;
    float mn = fmaxf(m, sk), a = exp2f(m - mn);
    l = l * a + exp2f(sk - mn);
    float inv = a / l, sq = 0.f;
#pragma unroll
    for (int d = 0; d < 64; ++d) { float ov = o[d] * inv; sq += ov * ov; att[(size_t)t * D + hh * 64 + d] = f2bf(ov * gain[hh * 64 + d]); }
    ssq[t * 16 + hh] = sq;
}
__global__ void __launch_bounds__(64) k_moba(const bf16* QB, const bf16* KB, const bf16* VBT, const float* ksum, const float* lut, const float* gain, bf16* att, float* ssq) {
    int idx = blockIdx.x * blockDim.x + threadIdx.x;
    if (idx >= NTOK * 8) return;
    int hh = idx % 8, t = idx / 8, b = t / S, s = t % S;
    float q[64];
    const bf16* qp = QB + (((size_t)b * 8 + hh) * S + s) * 64;
#pragma unroll
    for (int d = 0; d < 64; ++d) q[d] = bf2f(qp[d]);
    const float* L = lut + (8 + hh) * LUTN + LUT_NEG;
    int qb = s / 256;
    float gate[8];
#pragma unroll
    for (int j = 0; j < 8; ++j) {
        float gsum = -INFINITY;
        if (j < qb) { gsum = 0.f; const float* km = ksum + (((size_t)b * 8 + hh) * 8 + j) * 64;
#pragma unroll
            for (int d = 0; d < 64; ++d) gsum += q[d] * km[d]; }
        gate[j] = gsum;
    }
    unsigned sel = 0; int nsel = qb < 3 ? qb : 3;
    for (int r = 0; r < nsel; ++r) { int best = -1; float bv = -INFINITY;
#pragma unroll
        for (int j = 0; j < 8; ++j) if (j < qb && !((sel >> j) & 1) && (best < 0 || gate[j] > bv)) { best = j; bv = gate[j]; }
        sel |= 1u << best; }
    sel |= 1u << qb;
    float m = NEGBIG, l = 0.f; float o[64];
#pragma unroll
    for (int d = 0; d < 64; ++d) o[d] = 0.f;
    for (int j = 0; j <= qb; ++j) {
        if (!((sel >> j) & 1)) continue;
        int kend = (j == qb) ? s : (j * 256 + 255);
        for (int kp = j * 256; kp <= kend; ++kp) {
            const bf16* kr = KB + (((size_t)b * 8 + hh) * S + kp) * 64;
            float sc = 0.f;
#pragma unroll
            for (int d = 0; d < 64; ++d) sc += q[d] * bf2f(kr[d]);
            sc += L[s - kp];
            float mn = fmaxf(m, sc), a = exp2f(m - mn), p = exp2f(sc - mn);
            l = l * a + p;
#pragma unroll
            for (int d = 0; d < 64; ++d) o[d] = o[d] * a + p * bf2f(VBT[(((size_t)b * 8 + hh) * 64 + d) * S + kp]);
            m = mn;
        }
    }
    float inv = 1.f / l, sq = 0.f;
#pragma unroll
    for (int d = 0; d < 64; ++d) { float ov = o[d] * inv; sq += ov * ov; att[(size_t)t * D + 512 + hh * 64 + d] = f2bf(ov * gain[hh * 64 + d]); }
    ssq[t * 16 + 8 + hh] = sq;
}
__global__ void k_outproj(const bf16* att, const float* ssq, const float* w_out, const float* x, const float* mod, float* x1) {
    int col = blockIdx.x * blockDim.x + threadIdx.x, t = blockIdx.y, b = t / S;
    float sa = 0.f, sb = 0.f; for (int i = 0; i < 8; ++i) { sa += ssq[t * 16 + i]; sb += ssq[t * 16 + 8 + i]; }
    float ra = rsqrtf(sa / 512.f + EPS), rb = rsqrtf(sb / 512.f + EPS);
    const bf16* ar = att + (size_t)t * D;
    float a0 = 0.f, a1 = 0.f;
    for (int k = 0; k < 512; ++k) a0 += bf2f(ar[k]) * w_out[(size_t)k * D + col];
    for (int k = 512; k < 1024; ++k) a1 += bf2f(ar[k]) * w_out[(size_t)k * D + col];
    float y = a0 * ra + a1 * rb;
    x1[(size_t)t * D + col] = x[(size_t)t * D + col] + mod[b * 6 * D + 2 * D + col] * y;
}
__global__ void k_router(const bf16* h2, const float* w_router, const float* e_bias, int* cnt, int* list, float* ew) {
    int t = blockIdx.x, e = threadIdx.x;
    __shared__ float sc[256], sel[256], gs[8]; __shared__ int chosen[8];
    const bf16* hr = h2 + (size_t)t * D;
    float acc = 0.f;
    for (int k = 0; k < D; ++k) acc += bf2f(hr[k]) * w_router[(size_t)k * NE + e];
    float s = 1.f / (1.f + __expf(-acc));
    sc[e] = s; sel[e] = s + e_bias[e];
    __syncthreads();
    if (e < 8) { float m1 = -INFINITY, m2 = -INFINITY;
        for (int i = 0; i < 32; ++i) { float v = sel[e * 32 + i]; if (v > m1) { m2 = m1; m1 = v; } else if (v > m2) m2 = v; }
        gs[e] = m1 + m2; }
    __syncthreads();
    if (e == 0) {
        unsigned gm = 0;
        for (int r = 0; r < 4; ++r) { int best = -1; float bv = 0.f;
            for (int g = 0; g < 8; ++g) if (!((gm >> g) & 1) && (best < 0 || gs[g] > bv)) { best = g; bv = gs[g]; }
            gm |= 1u << best; }
        float wsum = 0.f;
        for (int r = 0; r < 8; ++r) { int best = -1; float bv = 0.f;
            for (int i = 0; i < 256; ++i) { if (!((gm >> (i / 32)) & 1)) continue; bool used = false; for (int q = 0; q < r; ++q) used |= (chosen[q] == i);
                if (used) continue; if (best < 0 || sel[i] > bv) { best = i; bv = sel[i]; } }
            chosen[r] = best; wsum += sc[best]; }
        for (int r = 0; r < 8; ++r) { int ex = chosen[r]; int slot = atomicAdd(&cnt[ex], 1); list[(size_t)ex * NTOK + slot] = t * 8 + r; ew[t * 8 + r] = sc[ex] / wsum * 2.5f; }
    }
}
__global__ void k_moe(const bf16* h2, const int* cnt, const int* list, const float* ew, const float* w1, const float* w3, const float* w2,
                      const float* ws1, const float* ws3, const float* ws2, bf16* ybuf, bf16* ysh) {
    int e = blockIdx.y, g = blockIdx.x, tid = threadIdx.x;
    int n = (e < NE) ? cnt[e] : NTOK;
    if (g * 8 >= n) return;
    const float* W1 = (e < NE) ? w1 + (size_t)e * D * ED : ws1;
    const float* W3 = (e < NE) ? w3 + (size_t)e * D * ED : ws3;
    const float* W2 = (e < NE) ? w2 + (size_t)e * ED * D : ws2;
    __shared__ float xs[8][1024]; __shared__ float hs[8][256]; __shared__ int aid[8];
    if (tid < 8) { int i = g * 8 + tid; aid[tid] = (i < n) ? ((e < NE) ? list[(size_t)e * NTOK + i] : i) : -1; }
    __syncthreads();
    for (int r = 0; r < 8; ++r) { int a = aid[r]; int tok = (a < 0) ? 0 : ((e < NE) ? a / 8 : a);
        for (int k = tid; k < D; k += 256) xs[r][k] = (a < 0) ? 0.f : bf2f(h2[(size_t)tok * D + k]); }
    __syncthreads();
    float gg[8], uu[8];
#pragma unroll
    for (int r = 0; r < 8; ++r) { gg[r] = 0.f; uu[r] = 0.f; }
    for (int k = 0; k < D; ++k) { float a = W1[(size_t)k * ED + tid], b = W3[(size_t)k * ED + tid];
#pragma unroll
        for (int r = 0; r < 8; ++r) { gg[r] += xs[r][k] * a; uu[r] += xs[r][k] * b; } }
#pragma unroll
    for (int r = 0; r < 8; ++r) hs[r][tid] = gg[r] / (1.f + __expf(-gg[r])) * uu[r];
    __syncthreads();
    float y[8][4];
#pragma unroll
    for (int r = 0; r < 8; ++r) {
#pragma unroll
        for (int c = 0; c < 4; ++c) y[r][c] = 0.f; }
    for (int k = 0; k < ED; ++k) {
#pragma unroll
        for (int c = 0; c < 4; ++c) { float w = W2[(size_t)k * D + tid + 256 * c];
#pragma unroll
            for (int r = 0; r < 8; ++r) y[r][c] += hs[r][k] * w; } }
#pragma unroll
    for (int r = 0; r < 8; ++r) { int a = aid[r]; if (a < 0) continue;
        float wgt = (e < NE) ? ew[a] : 1.f; bf16* dst = (e < NE) ? ybuf + (size_t)a * D : ysh + (size_t)a * D;
#pragma unroll
        for (int c = 0; c < 4; ++c) dst[tid + 256 * c] = f2bf(y[r][c] * wgt); }
}
__global__ void k_final(const float* x1, const bf16* ybuf, const bf16* ysh, const float* mod, const float* fg, float* out) {
    int t = blockIdx.x, b = t / S, tid = threadIdx.x;
    __shared__ float red[256];
    float v[4]; float s = 0.f;
#pragma unroll
    for (int i = 0; i < 4; ++i) { int col = tid + 256 * i; float m = bf2f(ysh[(size_t)t * D + col]);
        for (int r = 0; r < 8; ++r) m += bf2f(ybuf[((size_t)t * 8 + r) * D + col]);
        v[i] = x1[(size_t)t * D + col] + mod[b * 6 * D + 5 * D + col] * m; s += v[i] * v[i]; }
    red[tid] = s; __syncthreads();
    for (int o = 128; o > 0; o >>= 1) { if (tid < o) red[tid] += red[tid + o]; __syncthreads(); }
    float rstd = rsqrtf(red[0] / D + EPS);
#pragma unroll
    for (int i = 0; i < 4; ++i) { int col = tid + 256 * i; out[(size_t)t * D + col] = v[i] * rstd * fg[col]; }
}

#define OPT_MASK 0xFF

#define LAS __attribute__((address_space(3)))
typedef short bf16x8 __attribute__((ext_vector_type(8)));
typedef float f32x16 __attribute__((ext_vector_type(16)));
typedef float f32x4 __attribute__((ext_vector_type(4)));
typedef unsigned u32x4 __attribute__((ext_vector_type(4)));
typedef unsigned u32x2 __attribute__((ext_vector_type(2)));

#ifndef FUSE45
#define FUSE45 1
#endif
constexpr int NTHR = 512, NWAVE = 8;
constexpr int LDS_CTL_OFF = 147456;
constexpr int LDS_BYTES = LDS_CTL_OFF + 1024;
constexpr size_t C_BAR = 768 * 1024;

__device__ __forceinline__ unsigned cvt_pk(float lo, float hi) { unsigned r; asm("v_cvt_pk_bf16_f32 %0, %1, %2" : "=v"(r) : "v"(lo), "v"(hi)); return r; }
__device__ __forceinline__ float wave_sum(float v) {
#pragma unroll
    for (int o = 1; o < 64; o <<= 1) v += __shfl_xor(v, o);
    return v;
}
#define MFMA32(a, b, c) __builtin_amdgcn_mfma_f32_32x32x16_bf16((a), (b), (c), 0, 0, 0)

#define XB_TMO      128
#define XB_XCNT(j)  (256  + 64 * (j))
#define XB_XSUB(j)  (1280 + 64 * (j))
#define XB_XGEN(j)  (2304 + 64 * (j))
#define XB_TOP      3328
#define XB_TOPGEN   3392
#define XCD_BAR_WORDS 3456
#define XB_SPIN_CAP (1u << 22)
__device__ __forceinline__ unsigned xb_ld(unsigned* p)              { return __hip_atomic_load(p, __ATOMIC_RELAXED, __HIP_MEMORY_SCOPE_AGENT); }
__device__ __forceinline__ unsigned xb_add(unsigned* p, unsigned v) { return __hip_atomic_fetch_add(p, v, __ATOMIC_RELAXED, __HIP_MEMORY_SCOPE_AGENT); }
__device__ __forceinline__ unsigned xb_xcc_id() { return (unsigned)__builtin_amdgcn_s_getreg((3 << 11) | 20) & 0xFu; }
#define XB_SPIN(cond, bar) do { unsigned _sp = 0; while (cond) { __builtin_amdgcn_s_sleep(1); \
    if ((++_sp & 255u) == 0u) { if (xb_ld(&(bar)[XB_TMO])) break; if (_sp > XB_SPIN_CAP) { atomicAdd(&(bar)[XB_TMO], 1u); break; } } } } while (0)
struct XcdBarrier { unsigned* bar; unsigned x; volatile LAS unsigned* st; };
__device__ __forceinline__ XcdBarrier xcd_barrier_post(unsigned* bar, volatile LAS unsigned* st) {
    XcdBarrier b; b.bar = bar; b.x = xb_xcc_id(); b.st = st;
    if (threadIdx.x == 0) (void)xb_add(&bar[XB_XCNT(b.x)], 1u);
    return b;
}
__device__ __forceinline__ void xcd_barrier_complete(unsigned* bar, unsigned x, unsigned& nloc, unsigned& nx) {
    const unsigned G = gridDim.x * gridDim.y * gridDim.z;
    unsigned sum, cnt, mine, sp = 0u;
    for (;;) {
        sum = 0u; cnt = 0u; mine = 0u;
#pragma unroll
        for (unsigned j = 0; j < 16; ++j) { const unsigned c = xb_ld(&bar[XB_XCNT(j)]); sum += c; cnt += (c > 0u) ? 1u : 0u; mine = (j == x) ? c : mine; }
        if (sum == G) break;
        __builtin_amdgcn_s_sleep(1);
        if ((++sp & 255u) == 0u) { if (xb_ld(&bar[XB_TMO])) break; if (sp > XB_SPIN_CAP) { atomicAdd(&bar[XB_TMO], 1u); break; } }
    }
    nloc = mine > 0u ? mine : 1u; nx = cnt > 0u ? cnt : 1u;
}
__device__ __forceinline__ void xcd_barrier(const XcdBarrier& b) {
    asm volatile("s_waitcnt vmcnt(0)" ::: "memory");
    __syncthreads();
    if (threadIdx.x == 0) {
        unsigned* bar = b.bar;
        __builtin_amdgcn_s_waitcnt(0);
        unsigned nloc = b.st[0], nx = b.st[1];
        if (nloc == 0u) { xcd_barrier_complete(bar, b.x, nloc, nx); b.st[0] = nloc; b.st[1] = nx; }
        const unsigned old = xb_add(&bar[XB_XSUB(b.x)], 1u);
        const unsigned gen = old / nloc;
        if (old + 1u == (gen + 1u) * nloc) {
            __builtin_amdgcn_fence(__ATOMIC_RELEASE, "agent");
            asm volatile("s_waitcnt vmcnt(0)" ::: "memory");
            const unsigned og = xb_add(&bar[XB_TOP], 1u);
            const unsigned tg = og / nx;
            if (og + 1u == (tg + 1u) * nx) xb_add(&bar[XB_TOPGEN], 1u);
            else XB_SPIN(xb_ld(&bar[XB_TOPGEN]) == tg, bar);
            __builtin_amdgcn_fence(__ATOMIC_ACQUIRE, "agent");
            xb_add(&bar[XB_XGEN(b.x)], 1u);
            asm volatile("s_waitcnt vmcnt(0)" ::: "memory");
        } else {
            XB_SPIN(xb_ld(&bar[XB_XGEN(b.x)]) == gen, bar);
            __builtin_amdgcn_fence(__ATOMIC_ACQUIRE, "agent");
            asm volatile("s_waitcnt vmcnt(0)" ::: "memory");
        }
    }
    __syncthreads();
}

struct Args {
    const float *x, *c, *w_ada, *b_ada, *norm1_g, *w_in, *sinks, *rel_table, *out_norm_a, *out_norm_b, *w_out, *norm2_g, *w_router, *e_bias,
                *w1, *w3, *w2, *ws1, *ws3, *ws2, *final_g;
    float* out; unsigned char* ws; int ph_lo, ph_hi;
};

template <int RM, int RN, int WM, int WN, int KR, bool A_RES, bool SWAP, int PD = 2, int BMD = 0, int DBG = 0>
struct GemmCore {
    static constexpr bool BT = (BMD == 1), PUB = (BMD == 2), F8 = (BMD == 3);
    static constexpr int BM = 32 * RM * WM, BN = 32 * RN * WN;
    static constexpr int A_BYTES = BM * 64, B_BYTES = BN * 64, STAGE = (A_RES ? 0 : A_BYTES) + B_BYTES;
    static constexpr int NA = (BM * 4 + NTHR - 1) / NTHR;
    static constexpr int BTASKS = BT ? BN * 4 : F8 ? BN * 2 : (32 / KR) * (BN / 4), NBT = BTASKS / NTHR, NBR = (BT || F8) ? 1 : KR, F8TILE = BN * 32;
    static_assert(!PUB || KR == 8, "publishing needs 8 k-rows per task");
    static_assert(WM * WN == NWAVE && BTASKS % NTHR == 0 && (KR == 2 || KR == 4 || KR == 8), "GemmCore geometry");
    static constexpr int LDS_NEED = 2 * STAGE;

    template <class AF, class BF>
    static __device__ __forceinline__ void run(LAS unsigned char* lds, AF arow, BF bsrc, int ldb, int nk, f32x16 (&acc)[RM][RN], LAS unsigned char* ares, unsigned char* f8p = nullptr, float pscale = 1.f, int rot = 0) {
        run_h(lds, arow, bsrc, ldb, nk, acc, ares, [](int, f32x16 (&)[RM][RN]) {}, f8p, pscale, rot);
    }
    template <class AF, class BF, class HK>
    static __device__ __forceinline__ void run_h(LAS unsigned char* lds, AF arow, BF bsrc, int ldb, int nk, f32x16 (&acc)[RM][RN], LAS unsigned char* ares, HK hook, unsigned char* f8p = nullptr, float pscale = 1.f, int rot = 0) {
        int tid = threadIdx.x; asm volatile("" : "+v"(tid));
        const int lane = tid & 63, wave = __builtin_amdgcn_readfirstlane(tid >> 6);
        const int wm = wave / WN, wn = wave % WN, h = lane >> 5, l31 = lane & 31;
        const bf16* ap[NA]; int awo[NA]; bool aval[NA];
#pragma unroll
        for (int i = 0; i < NA; ++i) { const int p = tid + NTHR * i, row = (p >> 2) % BM, ch = p & 3; const bf16* rp = A_RES ? nullptr : arow(row);
            aval[i] = !A_RES && rp != nullptr && (NA * NTHR == BM * 4 || p < BM * 4); ap[i] = rp + ch * 8; awo[i] = row * 64 + ((ch ^ ((row >> 2) & 3)) << 4); }
        decltype(bsrc(0)) bp[NBT]; int bwo[NBT];
#pragma unroll
        for (int i = 0; i < NBT; ++i) { const int q = tid + NTHR * i;
            if constexpr (BT) { const int col = q >> 2, ch = q & 3; bp[i] = bsrc(col) + ch * 8; bwo[i] = col * 64 + ((ch ^ ((col >> 2) & 3)) << 4); }
            else if constexpr (F8) { bp[i] = nullptr; bwo[i] = 0; }
            else { const int cg = q % (BN / 4), kg = q / (BN / 4);
                bp[i] = bsrc(4 * cg) + (size_t)(KR * kg) * ldb;
                const int ch = (KR == 8) ? kg : (KR == 4) ? (kg >> 1) : (kg >> 2), hf = (KR == 8) ? 0 : (KR == 4) ? (kg & 1) * 8 : (kg & 3) * 4;
                bwo[i] = (4 * cg) * 64 + ((ch ^ (cg & 3)) << 4) + hf; } }
        const int swz = (l31 >> 2) & 3;
        const int xs0 = ((0 + h) ^ swz) << 4, xs1 = ((2 + h) ^ swz) << 4;
        const int aro = (wm * RM * 32 + l31) * 64, bro = (wn * RN * 32 + l31) * 64;
        constexpr int NSET = PD < 1 ? 1 : PD;
        u32x4 aregs[NSET][NA]; f32x4 bregs[NSET][NBT][NBR];
#pragma unroll
        for (int d = 0; d < NSET; ++d)
#pragma unroll
            for (int i = 0; i < NA; ++i) aregs[d][i] = (u32x4){0u, 0u, 0u, 0u};
        auto gload = [&](u32x4 (&areg)[NA], f32x4 (&breg)[NBT][NBR], int ks0) {
            const int ks = (ks0 + rot) & (nk - 1);
            if (!A_RES) {
#pragma unroll
                for (int i = 0; i < NA; ++i) if (aval[i]) areg[i] = *(const u32x4*)(ap[i] + (size_t)ks * 32);
            }
#pragma unroll
            for (int i = 0; i < NBT; ++i) {
                if (DBG & 8) continue;
                if constexpr (BT) breg[i][0] = *(const f32x4*)(bp[i] + (size_t)ks * 32);
                else if constexpr (F8) breg[i][0] = *(const f32x4*)(f8p + (size_t)ks * F8TILE + (size_t)(tid + NTHR * i) * 16);
                else {
#pragma unroll
                    for (int r = 0; r < KR; ++r) breg[i][r] = *(const f32x4*)(bp[i] + ((size_t)ks * 32 + r) * ldb); }
            }
        };
        constexpr int NSLOT = 2 * (RM <= RN ? RN : RM);
        constexpr int BITEMS = BT ? NBT : F8 ? NBT * 2 : NBT * 4, NITEM = (A_RES ? 0 : NA) + BITEMS;
        auto lwrite = [&](const u32x4 (&areg)[NA], const f32x4 (&breg)[NBT][NBR], int buf, int ks0, int slot) {
            const int ks = (ks0 + rot) & (nk - 1); (void)ks;
            LAS unsigned char* sb = lds + buf * STAGE;
            LAS unsigned char* bb = sb + (A_RES ? 0 : A_BYTES);
#pragma unroll
            for (int it = 0; it < NITEM; ++it) {
                if (slot >= 0 && (it % NSLOT) != slot) continue;
                if (!A_RES && it < NA) { const int i = it; if (NA * NTHR == BM * 4 || tid + NTHR * i < BM * 4) *(LAS u32x4*)(sb + awo[i]) = areg[i]; continue; }
                const int bi = it - (A_RES ? 0 : NA);
                if (DBG & 4) continue;
                if constexpr (BT) { *(LAS f32x4*)(bb + bwo[bi]) = breg[bi][0]; }
                else if constexpr (F8) {
                    const int i = bi >> 1, hf = bi & 1;
                    const int p = tid + NTHR * i, q = p >> 1, jp = p & 1, cg = q % (BN / 4), kg = q / (BN / 4), col = 4 * cg + 2 * jp + hf;
                    const u32x4 raw = __builtin_bit_cast(u32x4, breg[i][0]); unsigned o[4];
#pragma unroll
                    for (int d = 0; d < 2; ++d) { const auto lo = __builtin_amdgcn_cvt_pk_f32_fp8((int)raw[2 * hf + d], false), hi = __builtin_amdgcn_cvt_pk_f32_fp8((int)raw[2 * hf + d], true);
                        o[2 * d] = cvt_pk(lo[0], lo[1]); o[2 * d + 1] = cvt_pk(hi[0], hi[1]); }
                    *(LAS u32x4*)(bb + col * 64 + ((kg ^ (cg & 3)) << 4)) = (u32x4){o[0], o[1], o[2], o[3]};
                } else {
                    const int i = bi >> 2, j = bi & 3;
                    if (KR == 8) { u32x4 w; w.x = cvt_pk(breg[i][0][j], breg[i][1][j]); w.y = cvt_pk(breg[i][2][j], breg[i][3][j]); w.z = cvt_pk(breg[i][4][j], breg[i][5][j]); w.w = cvt_pk(breg[i][6][j], breg[i][7][j]);
                        *(LAS u32x4*)(bb + bwo[i] + j * 64) = w;
                        if constexpr (PUB) {
                            int p0 = __builtin_amdgcn_cvt_pk_fp8_f32(breg[i][0][j] * pscale, breg[i][1][j] * pscale, 0, false); p0 = __builtin_amdgcn_cvt_pk_fp8_f32(breg[i][2][j] * pscale, breg[i][3][j] * pscale, p0, true);
                            int p1 = __builtin_amdgcn_cvt_pk_fp8_f32(breg[i][4][j] * pscale, breg[i][5][j] * pscale, 0, false); p1 = __builtin_amdgcn_cvt_pk_fp8_f32(breg[i][6][j] * pscale, breg[i][7][j] * pscale, p1, true);
                            *(u32x2*)(f8p + (size_t)ks * F8TILE + (size_t)(tid + NTHR * i) * 32 + j * 8) = (u32x2){(unsigned)p0, (unsigned)p1}; } }
                    else if (KR == 4) { u32x2 w; w.x = cvt_pk(breg[i][0][j], breg[i][1][j]); w.y = cvt_pk(breg[i][2][j], breg[i][3][j]); *(LAS u32x2*)(bb + bwo[i] + j * 64) = w; }
                    else { *(LAS unsigned*)(bb + bwo[i] + j * 64) = cvt_pk(breg[i][0][j], breg[i][1][j]); }
                }
            }
        };
        auto step = [&](int ks0, int cur, const u32x4 (&aw)[NA], const f32x4 (&bw)[NBT][NBR], int wbuf, int wks, bool dowrite) {
            const int ks = (ks0 + rot) & (nk - 1);
            const LAS unsigned char* abase = A_RES ? (ares + ks * A_BYTES) : (lds + cur * STAGE);
            const LAS unsigned char* bbase = lds + cur * STAGE + (A_RES ? 0 : A_BYTES);
#pragma unroll
            for (int s = 0; s < 2; ++s) {
                const int xs = s ? xs1 : xs0;
                if constexpr (RM <= RN) {
                    bf16x8 af[RM];
                    if (!(DBG & 2)) {
#pragma unroll
                        for (int rb = 0; rb < RM; ++rb) af[rb] = *(const LAS bf16x8*)(abase + aro + rb * 2048 + xs); }
#pragma unroll
                    for (int cb = 0; cb < RN; ++cb) {
                        if (!(DBG & 2)) { const bf16x8 bfv = *(const LAS bf16x8*)(bbase + bro + cb * 2048 + xs);
#pragma unroll
                            for (int rb = 0; rb < RM; ++rb) { if (DBG & 1) { asm volatile("" :: "v"(bfv), "v"(af[rb])); } else acc[rb][cb] = SWAP ? MFMA32(bfv, af[rb], acc[rb][cb]) : MFMA32(af[rb], bfv, acc[rb][cb]); } }
                        if (dowrite) lwrite(aw, bw, wbuf, wks, s * RN + cb);
                    }
                } else {
                    bf16x8 bfv[RN];
                    if (!(DBG & 2)) {
#pragma unroll
                        for (int cb = 0; cb < RN; ++cb) bfv[cb] = *(const LAS bf16x8*)(bbase + bro + cb * 2048 + xs); }
#pragma unroll
                    for (int rb = 0; rb < RM; ++rb) {
                        if (!(DBG & 2)) { const bf16x8 af = *(const LAS bf16x8*)(abase + aro + rb * 2048 + xs);
#pragma unroll
                            for (int cb = 0; cb < RN; ++cb) acc[rb][cb] = SWAP ? MFMA32(bfv[cb], af, acc[rb][cb]) : MFMA32(af, bfv[cb], acc[rb][cb]); }
                        if (dowrite) lwrite(aw, bw, wbuf, wks, s * RM + rb);
                    }
                }
            }
        };
        if constexpr (PD >= 2) {
            static_assert(PD % 2 == 0, "PD even");
#pragma unroll
            for (int d = 0; d < PD; ++d) gload(aregs[d], bregs[d], d);
            lwrite(aregs[0], bregs[0], 0, 0, -1); __syncthreads();
#pragma unroll 1
            for (int ks0 = 0; ks0 < nk; ks0 += PD) {
#pragma unroll
                for (int d = 0; d < PD; ++d) {
                    const int ks = ks0 + d;
                    gload(aregs[d], bregs[d], min(ks + PD, nk - PD + d));
                    asm volatile("" ::: "memory");
                    if (d == 0) hook(ks, acc);
                    step(ks, d & 1, aregs[(d + 1) % PD], bregs[(d + 1) % PD], (d + 1) & 1, min(ks + 1, nk - 1), true);
                    __syncthreads();
                }
            }
            asm volatile("s_waitcnt vmcnt(0)" ::: "memory");
        } else {
            gload(aregs[0], bregs[0], 0); lwrite(aregs[0], bregs[0], 0, 0, -1); __syncthreads();
#pragma unroll 1
            for (int ks = 0; ks < nk; ++ks) {
                const int cur = ks & 1;
                if (ks + 1 < nk) gload(aregs[0], bregs[0], ks + 1);
                hook(ks, acc);
                step(ks, cur, aregs[0], bregs[0], 0, 0, false);
                if (ks + 1 < nk) lwrite(aregs[0], bregs[0], cur ^ 1, ks + 1, -1);
                __syncthreads();
            }
        }
    }
};
template <int RM, int RN> __device__ __forceinline__ void zero_acc(f32x16 (&acc)[RM][RN]) {
#pragma unroll
    for (int a = 0; a < RM; ++a)
#pragma unroll
        for (int b = 0; b < RN; ++b)
#pragma unroll
            for (int r = 0; r < 16; ++r) acc[a][b][r] = 0.f;
}
__device__ __forceinline__ int roff(int r, int h) { return (r & 3) + 8 * (r >> 2) + 4 * h; }

__device__ __forceinline__ void phase0(const Args& a, LAS unsigned char* lds, int vcu, int G) {
    const int tid = threadIdx.x, lane = tid & 63, wave = tid >> 6;
    float* mod = (float*)(a.ws + C_MOD); float* lut = (float*)(a.ws + WS_LUT);
    LAS float* sc = (LAS float*)lds;
    for (int i = tid; i < NB * D; i += NTHR) { float cv = a.c[i]; sc[i] = cv / (1.f + __expf(-cv)); }
    __syncthreads();
    LAS float* red = (LAS float*)(lds + 32768);
    for (int u = vcu; u < 192; u += G) {
        const int col = u * 32 + (lane & 31), rp = lane >> 5, k0 = wave * 128 + rp;
        float acc[NB];
#pragma unroll
        for (int b = 0; b < NB; ++b) acc[b] = 0.f;
#pragma unroll 16
        for (int i = 0; i < 64; ++i) { const float w = a.w_ada[(size_t)(k0 + 2 * i) * (6 * D) + col];
#pragma unroll
            for (int b = 0; b < NB; ++b) acc[b] += sc[b * D + k0 + 2 * i] * w; }
#pragma unroll
        for (int b = 0; b < NB; ++b) { acc[b] += __shfl_xor(acc[b], 32); if (rp == 0) red[(wave * NB + b) * 32 + lane] = acc[b]; }
        __syncthreads();
        if (tid < 256) { const int b = tid >> 5, c = tid & 31; float s = 0.f;
#pragma unroll
          for (int w = 0; w < NWAVE; ++w) s += red[(w * NB + b) * 32 + c];
          mod[b * 6 * D + u * 32 + c] = s + a.b_ada[u * 32 + c]; }
        __syncthreads();
    }
    {
        LAS float* scr = (LAS float*)(lds + 49152 + wave * 8448);
        constexpr int I_IN = 16 * (INC / 32), I_OUT = 16 * (D / 32), I_R = 16 * (NE / 32), I_S = 16 * (ED / 32), I_S2 = 4 * (D / 32), NIT = I_IN + I_OUT + I_R + 2 * I_S + I_S2;
        for (int it = vcu * NWAVE + wave; it < NIT; it += G * NWAVE) {
            const float* W; int N, KD = D, roff0 = 0; bf16* WT; int r = it; bool ksm = false;
            if (r < I_IN) { W = a.w_in; N = INC; WT = (bf16*)(a.ws + WS_WTIN); }
            else if ((r -= I_IN) < I_OUT) { W = a.w_out; N = D; WT = (bf16*)(a.ws + WS_WTOUT); ksm = (FUSE45 != 0); }
            else if ((r -= I_OUT) < I_R) { W = a.w_router; N = NE; WT = (bf16*)(a.ws + WS_WTR); ksm = (FUSE45 != 0); }
            else if ((r -= I_R) < I_S) { W = a.ws1; N = ED; WT = (bf16*)(a.ws + WS_WS13T); }
            else if ((r -= I_S) < I_S) { W = a.ws3; N = ED; WT = (bf16*)(a.ws + WS_WS13T); roff0 = ED; }
            else { r -= I_S; W = a.ws2; N = D; KD = ED; WT = (bf16*)(a.ws + WS_WS2T); }
            const int nblk = N / 32, kb = r / nblk, nb = r % nblk, k0 = 64 * kb, n0 = 32 * nb;
#pragma unroll 8
            for (int i = 0; i < 32; ++i) { const int kk = 2 * i + (lane >> 5); scr[kk * 33 + (lane & 31)] = W[(size_t)(k0 + kk) * N + n0 + (lane & 31)]; }
            asm volatile("s_waitcnt lgkmcnt(0)" ::: "memory");
            const int c = lane & 7;
#pragma unroll
            for (int j = 0; j < 4; ++j) { const int nn = (lane >> 3) + 8 * j; const LAS float* s = scr + (8 * c) * 33 + nn;
                u32x4 o; o.x = cvt_pk(s[0 * 33], s[1 * 33]); o.y = cvt_pk(s[2 * 33], s[3 * 33]); o.z = cvt_pk(s[4 * 33], s[5 * 33]); o.w = cvt_pk(s[6 * 33], s[7 * 33]);
                const int kq = k0 + 8 * c;
                if (ksm) *(u32x4*)(WT + ((size_t)(kq >> 5) * N + n0 + nn) * 32 + (kq & 31)) = o;
                else *(u32x4*)(WT + (size_t)(roff0 + n0 + nn) * KD + kq) = o; }
            asm volatile("s_waitcnt lgkmcnt(0)" ::: "memory");
        }
    }
    for (int i = vcu * NTHR + tid; i < 16 * LUTN; i += G * NTHR) {
        const int hh = i / LUTN, p = i % LUTN, dist = p - LUT_NEG;
        float v = NEGBIG;
        const bool ok = dist >= 0 && (hh < 8 ? dist < 128 : dist < S);
        if (ok) v = a.rel_table[t5_bucket(dist) * 16 + hh] * LOG2E;
        lut[i] = v;
    }
}
__device__ __forceinline__ void norm_mod_row(const float* xr, const float* g, const float* sh, const float* scl, bf16* orow, int lane, unsigned char* o8 = nullptr) {
    f32x4 v[4]; float s = 0.f;
#pragma unroll
    for (int j = 0; j < 4; ++j) { v[j] = *(const f32x4*)(xr + j * 256 + lane * 4); s += (v[j].x * v[j].x + v[j].y * v[j].y) + (v[j].z * v[j].z + v[j].w * v[j].w); }
    const float rstd = rsqrtf(wave_sum(s) * (1.f / D) + EPS);
#pragma unroll
    for (int j = 0; j < 4; ++j) { const int c = j * 256 + lane * 4;
        const f32x4 gg = *(const f32x4*)(g + c), s1 = *(const f32x4*)(scl + c), s0 = *(const f32x4*)(sh + c);
        const float o0 = v[j].x * rstd * gg.x * (1.f + s1.x) + s0.x, o1 = v[j].y * rstd * gg.y * (1.f + s1.y) + s0.y;
        const float o2 = v[j].z * rstd * gg.z * (1.f + s1.z) + s0.z, o3 = v[j].w * rstd * gg.w * (1.f + s1.w) + s0.w;
        u32x2 w; w.x = cvt_pk(o0, o1); w.y = cvt_pk(o2, o3); *(u32x2*)(orow + c) = w;
        if (o8) { int p = __builtin_amdgcn_cvt_pk_fp8_f32(o0, o1, 0, false); p = __builtin_amdgcn_cvt_pk_fp8_f32(o2, o3, p, true); *(int*)(o8 + c) = p; } }
}
__device__ __forceinline__ void phase1(const Args& a, int vcu, int G) {
    const int lane = threadIdx.x & 63, gw = vcu * NWAVE + (threadIdx.x >> 6), NGW = G * NWAVE;
    const float* mod = (const float*)(a.ws + C_MOD); bf16* H = (bf16*)(a.ws + WS_H);
    for (int t = gw; t < NTOK; t += NGW) { const int b = t / S;
        norm_mod_row(a.x + (size_t)t * D, a.norm1_g, mod + b * 6 * D, mod + b * 6 * D + D, H + (size_t)t * D, lane); }
}
__device__ __forceinline__ void phase2(const Args& a, LAS unsigned char* lds, int vcu, int G) {
    typedef GemmCore<4, 2, 2, 4, 4, false, false, 2, 1> GC;
    const int lane = threadIdx.x & 63, wave = __builtin_amdgcn_readfirstlane(threadIdx.x >> 6), wm = wave / 4, wn = wave % 4, h = lane >> 5, l31 = lane & 31;
    const bf16* H = (const bf16*)(a.ws + WS_H); const bf16* WT = (const bf16*)(a.ws + WS_WTIN);
    bf16* QA = (bf16*)(a.ws + WS_QA); bf16* KA = (bf16*)(a.ws + WS_KA); bf16* VAT = (bf16*)(a.ws + WS_VAT);
    bf16* QB = (bf16*)(a.ws + WS_QB); bf16* KB = (bf16*)(a.ws + WS_KB); bf16* VBT = (bf16*)(a.ws + WS_VBT); float* ksum = (float*)(a.ws + C_KSUM);
    constexpr int NPM = NTOK / 256, NPN = INC / 256;
    for (int u = vcu; u < NPM * NPN; u += G) {
        const int pm = u / NPN, pn = u % NPN;
        f32x16 acc[4][2]; zero_acc(acc);
        const bf16* Ab = H + (size_t)pm * 256 * D; const bf16* Wb = WT + (size_t)pn * 256 * D;
        GC::run(lds, [&](int r) { return Ab + (size_t)r * D; }, [&](int c) { return Wb + (size_t)c * D; }, D, D / 32, acc, nullptr);
        const int b = (pm * 256) / S, s0 = (pm * 256) % S + wm * 128;
#pragma unroll
        for (int cb = 0; cb < 2; ++cb) {
            const int col = pn * 256 + wn * 64 + cb * 32 + l31;
            int kind, hh, d;
            bf16* base; int nh; bool isKB = false;
            if (col < 512)       { kind = 0; hh = col >> 6; d = col & 63; base = QA; nh = 8; }
            else if (col < 640)  { kind = 1; hh = (col - 512) >> 6; d = col & 63; base = KA; nh = 2; }
            else if (col < 768)  { kind = 2; hh = (col - 640) >> 6; d = col & 63; base = VAT; nh = 2; }
            else if (col < 1280) { kind = 0; hh = (col - 768) >> 6; d = col & 63; base = QB; nh = 8; }
            else if (col < 1792) { kind = 1; hh = (col - 1280) >> 6; d = col & 63; base = KB; nh = 8; isKB = true; }
            else                 { kind = 2; hh = (col - 1792) >> 6; d = col & 63; base = VBT; nh = 8; }
            if (kind == 2) {
                bf16* vp = base + ((size_t)(b * nh + hh) * 64 + d) * S + s0;
#pragma unroll
                for (int rb = 0; rb < 4; ++rb)
#pragma unroll
                    for (int g4 = 0; g4 < 4; ++g4) { u32x2 w; w.x = cvt_pk(acc[rb][cb][4 * g4], acc[rb][cb][4 * g4 + 1]); w.y = cvt_pk(acc[rb][cb][4 * g4 + 2], acc[rb][cb][4 * g4 + 3]);
                        *(u32x2*)(vp + rb * 32 + 8 * g4 + 4 * h) = w; }
            } else {
                const float sc = (kind == 0) ? QSCALE : 1.f;
                bf16* qp = base + ((size_t)(b * nh + hh) * S + s0) * 64 + d;
                float csum = 0.f;
#pragma unroll
                for (int rb = 0; rb < 4; ++rb)
#pragma unroll
                    for (int r = 0; r < 16; ++r) { const float v = acc[rb][cb][r]; csum += v; qp[(size_t)(rb * 32 + roff(r, h)) * 64] = f2bf(v * sc); }
                if (isKB) { csum += __shfl_xor(csum, 32); if (h == 0) atomicAdd(&ksum[((size_t)(b * 8 + hh) * 8 + (s0 >> 8)) * 64 + d], csum); }
            }
        }
    }
}
constexpr int KT_STRIDE = 144, VT_STRIDE = 528;
constexpr int AT_K_OFF = 0, AT_V_OFF = 256 * KT_STRIDE  , AT_LUT_OFF = AT_V_OFF + 64 * VT_STRIDE  , AT_KS_OFF = AT_LUT_OFF + 10240, AT_END = AT_KS_OFF + 2048;
struct AttnSt { f32x16 o0, o1; float m, l; };
__device__ __forceinline__ void attn_tile(const LAS unsigned char* lds, int kt, int lut_idx, const bf16x8 (&bq)[4], AttnSt& st, int lane, const int ADBG = 0) {
    if (ADBG & 1) return;
    const int i = lane & 31, hh = lane >> 5;
    const int kap = (i & 0x13) | ((i & 4) << 1) | ((i & 8) >> 1);
    const LAS unsigned char* kp = lds + AT_K_OFF + (kt * 32 + kap) * KT_STRIDE + 16 * hh;
    f32x16 p;
#pragma unroll
    for (int r = 0; r < 16; ++r) p[r] = 0.f;
#pragma unroll
    for (int s = 0; s < 4; ++s) { const bf16x8 kf = *(const LAS bf16x8*)(kp + 32 * s); p = MFMA32(kf, bq[s], p); }
    const LAS float* lp = (const LAS float*)(lds + AT_LUT_OFF) + lut_idx;
    float tmax = NEGBIG;
    if (!(ADBG & 6)) {
#pragma unroll
    for (int r = 0; r < 16; ++r) { p[r] += lp[23 - (16 * (r >> 3) + (r & 7))]; tmax = fmaxf(tmax, p[r]); }
    } else if (!(ADBG & 2)) {
#pragma unroll
    for (int r = 0; r < 16; ++r) tmax = fmaxf(tmax, p[r]);
    }
    tmax = fmaxf(tmax, __shfl_xor(tmax, 32));
    float ps = 0.f;
    if (ADBG & 2) { }
    else if (__all(tmax <= st.m)) {
#pragma unroll
        for (int r = 0; r < 16; ++r) { p[r] = exp2f(p[r] - st.m); ps += p[r]; }
        st.l += ps;
    } else {
        const float mn = fmaxf(st.m, tmax), alpha = exp2f(st.m - mn);
#pragma unroll
        for (int r = 0; r < 16; ++r) { p[r] = exp2f(p[r] - mn); ps += p[r]; }
        st.l = st.l * alpha + ps; st.m = mn;
#pragma unroll
        for (int r = 0; r < 16; ++r) { st.o0[r] *= alpha; st.o1[r] *= alpha; }
    }
    bf16x8 pb[2];
#pragma unroll
    for (int s = 0; s < 2; ++s) { u32x4 w; w.x = cvt_pk(p[8 * s], p[8 * s + 1]); w.y = cvt_pk(p[8 * s + 2], p[8 * s + 3]); w.z = cvt_pk(p[8 * s + 4], p[8 * s + 5]); w.w = cvt_pk(p[8 * s + 6], p[8 * s + 7]);
        pb[s] = __builtin_bit_cast(bf16x8, w); }
    const LAS unsigned char* vp = lds + AT_V_OFF + i * VT_STRIDE + (kt * 32 + 8 * hh) * 2;
#pragma unroll
    for (int s = 0; s < 2; ++s) {
        const bf16x8 v0 = *(const LAS bf16x8*)(vp + 32 * s), v1 = *(const LAS bf16x8*)(vp + 32 * VT_STRIDE + 32 * s);
        st.o0 = MFMA32(v0, pb[s], st.o0); st.o1 = MFMA32(v1, pb[s], st.o1);
    }
}
__device__ __forceinline__ void attn_ld(u32x4 (&R)[8], const bf16* kg, const bf16* vtg, int tid) {
#pragma unroll
    for (int i = 0; i < 4; ++i) { const int p = tid + NTHR * i, key = p >> 3, c = p & 7; R[i] = *(const u32x4*)(kg + (size_t)key * 64 + c * 8); }
#pragma unroll
    for (int i = 0; i < 4; ++i) { const int p = tid + NTHR * i, d = p >> 5, c = p & 31; R[4 + i] = *(const u32x4*)(vtg + (size_t)d * S + c * 8); }
}
__device__ __forceinline__ void attn_wr(LAS unsigned char* lds, const u32x4 (&R)[8], int tid) {
#pragma unroll
    for (int i = 0; i < 4; ++i) { const int p = tid + NTHR * i, key = p >> 3, c = p & 7; *(LAS u32x4*)(lds + AT_K_OFF + key * KT_STRIDE + c * 16) = R[i]; }
#pragma unroll
    for (int i = 0; i < 4; ++i) { const int p = tid + NTHR * i, d = p >> 5, c = p & 31; *(LAS u32x4*)(lds + AT_V_OFF + d * VT_STRIDE + c * 16) = R[4 + i]; }
}
__device__ __forceinline__ void attn_stage(LAS unsigned char* lds, const bf16* kg, const bf16* vtg, int tid) { u32x4 R[8]; attn_ld(R, kg, vtg, tid); attn_wr(lds, R, tid); }
__device__ __forceinline__ void attn_init(AttnSt& st) {
#pragma unroll
    for (int r = 0; r < 16; ++r) { st.o0[r] = 0.f; st.o1[r] = 0.f; }
    st.m = NEGBIG; st.l = 0.f;
}
__device__ __forceinline__ void attn_loadq(const bf16* qrow, bf16x8 (&bq)[4], int lane) {
    const int hh = lane >> 5;
#pragma unroll
    for (int s = 0; s < 4; ++s) bq[s] = *(const bf16x8*)(qrow + 16 * s + 8 * hh);
}
__device__ __forceinline__ void attn_finish(AttnSt& st, bool has_sink, float sink_l2, const float* gain, bf16* attrow, float* ssq_tok, int lane) {
    const int hh = lane >> 5;
    float l = st.l + __shfl_xor(st.l, 32), inv;
    if (has_sink) { const float mn = fmaxf(st.m, sink_l2), al = exp2f(st.m - mn); l = l * al + exp2f(sink_l2 - mn); inv = al / l; } else inv = 1.f / l;
    float sq = 0.f;
#pragma unroll
    for (int db = 0; db < 2; ++db)
#pragma unroll
        for (int g4 = 0; g4 < 4; ++g4) { const int d0 = db * 32 + 8 * g4 + 4 * hh; const f32x4 gg = *(const f32x4*)(gain + d0);
            const f32x16& o = db ? st.o1 : st.o0;
            const float v0 = o[4 * g4] * inv, v1 = o[4 * g4 + 1] * inv, v2 = o[4 * g4 + 2] * inv, v3 = o[4 * g4 + 3] * inv;
            sq += (v0 * v0 + v1 * v1) + (v2 * v2 + v3 * v3);
            u32x2 w; w.x = cvt_pk(v0 * gg.x, v1 * gg.y); w.y = cvt_pk(v2 * gg.z, v3 * gg.w); *(u32x2*)(attrow + d0) = w; }
    sq += __shfl_xor(sq, 32);
    if (hh == 0) *ssq_tok = sq;
}
__device__ __forceinline__ void phase3(const Args& a, LAS unsigned char* lds, int vcu, int G, const int ADBG = 0) {
    const int tid = threadIdx.x, lane = tid & 63, wave = __builtin_amdgcn_readfirstlane(tid >> 6), l31 = lane & 31, hh2 = lane >> 5;
    const bf16* QA = (const bf16*)(a.ws + WS_QA); const bf16* KA = (const bf16*)(a.ws + WS_KA); const bf16* VAT = (const bf16*)(a.ws + WS_VAT);
    const bf16* QB = (const bf16*)(a.ws + WS_QB); const bf16* KB = (const bf16*)(a.ws + WS_KB); const bf16* VBT = (const bf16*)(a.ws + WS_VBT);
    const float* ksum = (const float*)(a.ws + C_KSUM); const float* lut = (const float*)(a.ws + WS_LUT);
    bf16* ATT = (bf16*)(a.ws + WS_ATT); float* ssq = (float*)(a.ws + WS_SSQ);
    LAS float* lutl = (LAS float*)(lds + AT_LUT_OFF); LAS float* ksl = (LAS float*)(lds + AT_KS_OFF);
    for (int uu = vcu; uu < 256; uu += G) {
        const int bh = uu >> 2, b = bh >> 3, hd = bh & 7;
        for (int half = 0; half < 2; ++half) {
            const int qb = half ? (uu & 3) : 7 - (uu & 3);
            __syncthreads();
            for (int i = tid; i < LUTN; i += NTHR) lutl[i] = lut[(8 + hd) * LUTN + i];
            if (tid < 512) ksl[tid] = ksum[((size_t)bh * 8) * 64 + tid];
            const bf16* kbase = KB + (size_t)bh * S * 64; const bf16* vbase = VBT + (size_t)bh * 64 * S;
            attn_stage(lds, kbase + (size_t)qb * 256 * 64, vbase + qb * 256, tid);
            const int q0 = qb * 256 + wave * 32, qpos = q0 + l31;
            bf16x8 bq[4]; attn_loadq(QB + ((size_t)bh * S + qpos) * 64, bq, lane);
            __syncthreads();
            unsigned sel = 0;
            {
                float g[7];
#pragma unroll
                for (int j = 0; j < 7; ++j) { float s = 0.f;
#pragma unroll
                    for (int sI = 0; sI < 4; ++sI)
#pragma unroll
                        for (int e = 0; e < 8; ++e) s += bf2f((bf16)bq[sI][e]) * ksl[j * 64 + 16 * sI + 8 * hh2 + e];
                    s += __shfl_xor(s, 32); g[j] = (j < qb) ? s : -INFINITY; }
#pragma unroll
                for (int r = 0; r < 3; ++r) if (r < qb) { int best = 0; float bv = -INFINITY;
#pragma unroll
                    for (int j = 6; j >= 0; --j) if (j < qb && !((sel >> j) & 1u) && g[j] >= bv) { bv = g[j]; best = j; }
                    sel |= 1u << best; }
            }
            AttnSt st; attn_init(st);
            u32x4 R[8];
            if (qb > 0) attn_ld(R, kbase, vbase, tid);
            for (int kt = 0; kt <= wave; ++kt) attn_tile(lds, kt, LUT_NEG + qpos - (qb * 256 + kt * 32) - 8 * hh2 - 23, bq, st, lane, ADBG);
            for (int j = 0; j < qb; ++j) {
                __syncthreads();
                attn_wr(lds, R, tid);
                __syncthreads();
                if (j + 1 < qb) attn_ld(R, kbase + (size_t)(j + 1) * 256 * 64, vbase + (j + 1) * 256, tid);
                const bool mine = (sel >> j) & 1u;
                if (__ballot(mine) != 0ull) {
                    for (int kt = 0; kt < 8; ++kt) { const int li = mine ? (LUT_NEG + qpos - (j * 256 + kt * 32) - 8 * hh2 - 23) : 64;
                        attn_tile(lds, kt, li, bq, st, lane, ADBG); }
                }
            }
            const int t = b * S + qpos;
            attn_finish(st, false, 0.f, a.out_norm_b + hd * 64, ATT + (size_t)t * D + 512 + hd * 64, ssq + t * 16 + 8 + hd, lane);
        }
    }
    for (int u = vcu; u < 256; u += G) {
        const int b = u >> 5, kv = (u >> 4) & 1, n = u & 15;
        __syncthreads();
        for (int i = tid; i < 4 * 512; i += NTHR) { const int g = i >> 9, p = i & 511; lutl[i] = lut[(kv * 4 + g) * LUTN + p]; }
        const int kb0 = (n - 1) * 128, kld = kb0 < 0 ? 0 : kb0;
        attn_stage(lds, KA + ((size_t)(b * 2 + kv) * S + kld) * 64, VAT + (size_t)(b * 2 + kv) * 64 * S + kld, tid);
        __syncthreads();
        for (int ti = 0; ti < 2; ++ti) {
            const int tk = wave * 2 + ti, g = tk >> 2, jq = tk & 3, hd = kv * 4 + g;
            const int qpos = n * 128 + jq * 32 + l31, t = b * S + qpos;
            bf16x8 bq[4]; attn_loadq(QA + ((size_t)(b * 8 + hd) * S + qpos) * 64, bq, lane);
            AttnSt st; attn_init(st);
            if (n > 0) { for (int kt = jq + 4; kt >= jq; --kt) attn_tile(lds, kt, g * 512 + 256 + qpos - (kb0 + kt * 32) - 8 * hh2 - 23, bq, st, lane, ADBG); }
            else { for (int kt = jq; kt >= 0; --kt) attn_tile(lds, kt, g * 512 + 256 + qpos - (kt * 32) - 8 * hh2 - 23, bq, st, lane, ADBG); }
            attn_finish(st, true, a.sinks[hd] * LOG2E, a.out_norm_a + hd * 64, ATT + (size_t)t * D + hd * 64, ssq + t * 16 + hd, lane);
        }
    }
}
__device__ __forceinline__ void phase4(const Args& a, LAS unsigned char* lds, int vcu, int G) {
    typedef GemmCore<4, 2, 2, 4, 4, false, false, 2, 1> GC;
    const int tid = threadIdx.x, lane = tid & 63, wave = __builtin_amdgcn_readfirstlane(tid >> 6), wm = wave / 4, wn = wave % 4, h = lane >> 5, l31 = lane & 31;
    const bf16* ATT = (const bf16*)(a.ws + WS_ATT); const float* ssq = (const float*)(a.ws + WS_SSQ);
    const float* mod = (const float*)(a.ws + C_MOD); float* X1 = (float*)(a.ws + WS_X1);
    LAS float* rsc = (LAS float*)(lds + GC::LDS_NEED);
    for (int u = vcu; u < 64 * 4; u += G) {
        const int pm = u >> 2, pn = u & 3;
        __syncthreads();
        if (tid < 256) { const int t = pm * 256 + tid; const f32x4 q0 = *(const f32x4*)(ssq + t * 16), q1 = *(const f32x4*)(ssq + t * 16 + 4), q2 = *(const f32x4*)(ssq + t * 16 + 8), q3 = *(const f32x4*)(ssq + t * 16 + 12);
            const float sa = ((q0.x + q0.y) + (q0.z + q0.w)) + ((q1.x + q1.y) + (q1.z + q1.w)), sb = ((q2.x + q2.y) + (q2.z + q2.w)) + ((q3.x + q3.y) + (q3.z + q3.w));
            const float ra = rsqrtf(sa * (1.f / 512.f) + EPS), rb = rsqrtf(sb * (1.f / 512.f) + EPS); rsc[tid] = ra / rb; rsc[256 + tid] = rb; }
        f32x16 acc[4][2]; zero_acc(acc);
        const bf16* Ab = ATT + (size_t)pm * 256 * D; const bf16* Wb = (const bf16*)(a.ws + WS_WTOUT) + (size_t)pn * 256 * D;
        GC::run_h(lds, [&](int r) { return Ab + (size_t)r * D; }, [&](int c) { return Wb + (size_t)c * D; }, D, 32, acc, nullptr,
            [&](int ks, f32x16 (&ac)[4][2]) { if (ks == 16) {
#pragma unroll
                for (int rb = 0; rb < 4; ++rb)
#pragma unroll
                    for (int g4 = 0; g4 < 4; ++g4) { const f32x4 f = *(const LAS f32x4*)(rsc + wm * 128 + rb * 32 + 8 * g4 + 4 * h);
#pragma unroll
                        for (int e = 0; e < 4; ++e) { ac[rb][0][4 * g4 + e] *= f[e]; ac[rb][1][4 * g4 + e] *= f[e]; } } } });
        const int b = (pm * 256) / S;
#pragma unroll
        for (int cb = 0; cb < 2; ++cb) { const int col = pn * 256 + wn * 64 + cb * 32 + l31; const float g1 = mod[b * 6 * D + 2 * D + col];
#pragma unroll
            for (int rb = 0; rb < 4; ++rb)
#pragma unroll
                for (int g4 = 0; g4 < 4; ++g4) { const int lr = wm * 128 + rb * 32 + 8 * g4 + 4 * h;
                    size_t o4 = (size_t)(pm * 256 + lr) * D + col; asm volatile("" : "+v"(o4));
                    const f32x4 rv = *(const LAS f32x4*)(rsc + 256 + lr);
#pragma unroll
                    for (int e = 0; e < 4; ++e) X1[o4 + (size_t)e * D] = a.x[o4 + (size_t)e * D] + g1 * acc[rb][cb][4 * g4 + e] * rv[e]; } }
    }
}
__device__ __forceinline__ void phase5(const Args& a, LAS unsigned char* lds, int vcu, int G, bool dry = false) {
    typedef GemmCore<2, 1, 1, 8, 4, false, false, 4, 1> GC;
    const int tid = threadIdx.x, lane = tid & 63, wave = __builtin_amdgcn_readfirstlane(tid >> 6), h = lane >> 5, l31 = lane & 31;
    const float* X1 = (const float*)(a.ws + WS_X1); const float* mod = (const float*)(a.ws + C_MOD); bf16* H2 = (bf16*)(a.ws + WS_H2);
    int* cnt = (int*)(a.ws + C_CNT); int* list = (int*)(a.ws + WS_LIST); float* ew = (float*)(a.ws + WS_EW);
    LAS float* lg = (LAS float*)(lds + 65536);
    for (int u = vcu; u < NTOK / 64; u += G) {
        const int t0 = u * 64, b = t0 / S;
        for (int i = 0; i < 8; ++i) { const int t = t0 + wave * 8 + i;
            norm_mod_row(X1 + (size_t)t * D, a.norm2_g, mod + b * 6 * D + 3 * D, mod + b * 6 * D + 4 * D, H2 + (size_t)t * D, lane, a.ws + WS_X8 + (size_t)t * D); }
        asm volatile("s_waitcnt vmcnt(0)" ::: "memory");
        __syncthreads();
        f32x16 acc[2][1]; zero_acc(acc);
        const bf16* Ab = H2 + (size_t)t0 * D;
        const bf16* WR = (const bf16*)(a.ws + WS_WTR);
        GC::run(lds, [&](int r) { return Ab + (size_t)r * D; }, [&](int c) { return WR + (size_t)c * D; }, D, D / 32, acc, nullptr);
#pragma unroll
        for (int rb = 0; rb < 2; ++rb)
#pragma unroll
            for (int r = 0; r < 16; ++r) lg[(rb * 32 + roff(r, h)) * 256 + wave * 32 + l31] = acc[rb][0][r];
        __syncthreads();
        for (int i = 0; i < 8; ++i) {
            const int row = wave * 8 + i, t = t0 + row;
            const f32x4 lv = *(const LAS f32x4*)(lg + row * 256 + lane * 4); const f32x4 eb = *(const f32x4*)(a.e_bias + lane * 4);
            float sc[4], sl[4];
#pragma unroll
            for (int j = 0; j < 4; ++j) { sc[j] = 1.f / (1.f + __expf(-lv[j])); sl[j] = sc[j] + eb[j]; }
            float m1 = fmaxf(sl[0], sl[1]), m2 = fminf(sl[0], sl[1]);
            { const float c1 = fmaxf(sl[2], sl[3]), c2 = fminf(sl[2], sl[3]); const float n1 = fmaxf(m1, c1), n2 = fmaxf(fminf(m1, c1), fmaxf(m2, c2)); m1 = n1; m2 = n2; }
#pragma unroll
            for (int o = 1; o < 8; o <<= 1) { const float c1 = __shfl_xor(m1, o), c2 = __shfl_xor(m2, o); const float n1 = fmaxf(m1, c1), n2 = fmaxf(fminf(m1, c1), fmaxf(m2, c2)); m1 = n1; m2 = n2; }
            const float gs = m1 + m2; const int grp = lane >> 3;
            int rank = 0;
#pragma unroll
            for (int g2 = 0; g2 < 8; ++g2) { const float og = __shfl(gs, g2 * 8); rank += (og > gs || (og == gs && g2 < grp)) ? 1 : 0; }
            const bool gsel = rank < 4;
#pragma unroll
            for (int j = 0; j < 4; ++j) if (!gsel) sl[j] = -INFINITY;
            int myidx = 0; float mysc = 0.f, wsum = 0.f;
            for (int r = 0; r < TOPK; ++r) {
                float bv = sl[0]; int bi = 0;
#pragma unroll
                for (int j = 1; j < 4; ++j) if (sl[j] > bv) { bv = sl[j]; bi = j; }
                bi += lane * 4;
#pragma unroll
                for (int o = 1; o < 64; o <<= 1) { const float ov = __shfl_xor(bv, o); const int oi = __shfl_xor(bi, o); if (ov > bv || (ov == bv && oi < bi)) { bv = ov; bi = oi; } }
                const int j = bi & 3; const bool own = (bi >> 2) == lane;
                const float scj = (j == 0) ? sc[0] : (j == 1) ? sc[1] : (j == 2) ? sc[2] : sc[3];
                const float scw = __shfl(scj, bi >> 2);
                if (own) { if (j == 0) sl[0] = -INFINITY; else if (j == 1) sl[1] = -INFINITY; else if (j == 2) sl[2] = -INFINITY; else sl[3] = -INFINITY; }
                wsum += scw;
                if (lane == r) { myidx = bi; mysc = scw; }
            }
            if (lane < TOPK && !dry) { const int slot = atomicAdd(&cnt[myidx], 1); list[(size_t)myidx * NTOK + slot] = t * 8 + lane; ew[t * 8 + lane] = mysc / wsum * 2.5f; }
        }
        __syncthreads();
    }
}
constexpr int P45_STR = 2064;
template <int PF>
__device__ __forceinline__ void phase45(const Args& a, LAS unsigned char* lds, int vcu, int G) {
    const bf16* ATT = (const bf16*)(a.ws + WS_ATT); const float* ssq = (const float*)(a.ws + WS_SSQ); const float* mod = (const float*)(a.ws + C_MOD);
    bf16* X1b = (bf16*)(a.ws + WS_X1); unsigned char* X8 = a.ws + WS_X8;
    const bf16* WTO = (const bf16*)(a.ws + WS_WTOUT); const bf16* WTR = (const bf16*)(a.ws + WS_WTR);
    int* cnt = (int*)(a.ws + C_CNT); int* list = (int*)(a.ws + WS_LIST); float* ew = (float*)(a.ws + WS_EW);
    LAS float* red = (LAS float*)(lds + 64 * P45_STR);
    LAS float* lg = (LAS float*)lds;
    for (int u = vcu; u < NTOK / 64; u += G) {
        int tid = threadIdx.x; asm volatile("" : "+v"(tid));
        const int lane = tid & 63, wave = __builtin_amdgcn_readfirstlane(tid >> 6), h = lane >> 5, l31 = lane & 31;
        const int t0 = u * 64, b = t0 / S;
        __syncthreads();
        if (!(PF & 16)) {
            u32x4 xr[16];
#pragma unroll
            for (int i = 0; i < 16; ++i) { const int p = tid + NTHR * i, row = p >> 7, c = p & 127; xr[i] = *(const u32x4*)(ATT + (size_t)(t0 + row) * D + c * 8); }
#pragma unroll
            for (int i = 0; i < 16; ++i) { const int p = tid + NTHR * i, row = p >> 7, c = p & 127; *(LAS u32x4*)(lds + row * P45_STR + c * 16) = xr[i]; }
        }
        float rat[2], rbs[2];
#pragma unroll
        for (int rb = 0; rb < 2; ++rb) { const int t = t0 + rb * 32 + l31;
            const f32x4 q0 = *(const f32x4*)(ssq + t * 16), q1 = *(const f32x4*)(ssq + t * 16 + 4), q2 = *(const f32x4*)(ssq + t * 16 + 8), q3 = *(const f32x4*)(ssq + t * 16 + 12);
            const float sa = ((q0.x + q0.y) + (q0.z + q0.w)) + ((q1.x + q1.y) + (q1.z + q1.w)), sb = ((q2.x + q2.y) + (q2.z + q2.w)) + ((q3.x + q3.y) + (q3.z + q3.w));
            float sa1 = sa * (1.f / 512.f) + EPS; asm volatile("" : "+v"(sa1));
            const float sb1 = sb * (1.f / 512.f) + EPS;
            const float ra = rsqrtf(sa1), rbv = rsqrtf(sb1); rat[rb] = ra / rbv; rbs[rb] = rbv; }
        __syncthreads();
        f32x16 acc[2][4]; zero_acc(acc);
        if (!(PF & 4)) {
            const bf16* wb0 = WTO + (size_t)(128 * wave + l31) * 32 + 16 * h;
            const LAS unsigned char* al = lds + l31 * P45_STR + 32 * h;
            bf16x8 wr[4][4];
            auto ldw = [&](int d, int q) { const bf16* p = wb0 + (size_t)(q >> 1) * (D * 32) + 8 * (q & 1);
#pragma unroll
                for (int cb = 0; cb < 4; ++cb) wr[d][cb] = *(const bf16x8*)(p + cb * 32 * 32); };
#pragma unroll
            for (int d = 0; d < 4; ++d) ldw(d, d);
#pragma unroll 1
            for (int q0 = 0; q0 < 64; q0 += 4) {
                if (q0 == 32) {
#pragma unroll
                    for (int rb = 0; rb < 2; ++rb)
#pragma unroll
                        for (int cb = 0; cb < 4; ++cb)
#pragma unroll
                            for (int r = 0; r < 16; ++r) acc[rb][cb][r] *= rat[rb]; }
#pragma unroll
                for (int d = 0; d < 4; ++d) { const int q = q0 + d;
                    const bf16x8 a0 = *(const LAS bf16x8*)(al + 64 * (q >> 1) + 16 * (q & 1)), a1 = *(const LAS bf16x8*)(al + 32 * P45_STR + 64 * (q >> 1) + 16 * (q & 1));
#pragma unroll
                    for (int cb = 0; cb < 4; ++cb) { acc[0][cb] = MFMA32(wr[d][cb], a0, acc[0][cb]); acc[1][cb] = MFMA32(wr[d][cb], a1, acc[1][cb]); }
                    ldw(d, min(q + 4, 60 + d)); asm volatile("" ::: "memory"); }
            }
            asm volatile("s_waitcnt vmcnt(0)" ::: "memory");
        }
        float ss[2] = {0.f, 0.f};
#pragma unroll
        for (int rb = 0; rb < 2; ++rb) { const size_t rowoff = (size_t)(t0 + rb * 32 + l31) * D;
#pragma unroll
            for (int cb = 0; cb < 4; ++cb)
#pragma unroll
                for (int g4 = 0; g4 < 4; ++g4) { int col = 128 * wave + cb * 32 + 8 * g4 + 4 * h; asm volatile("" : "+v"(col));
                    const f32x4 xv = (PF & 8) ? (f32x4){1.f, 1.f, 1.f, 1.f} : *(const f32x4*)(a.x + rowoff + col), g1 = *(const f32x4*)(mod + b * 6 * D + 2 * D + col);
                    f32x4 o; o.x = xv.x + g1.x * acc[rb][cb][4 * g4] * rbs[rb]; o.y = xv.y + g1.y * acc[rb][cb][4 * g4 + 1] * rbs[rb]; o.z = xv.z + g1.z * acc[rb][cb][4 * g4 + 2] * rbs[rb]; o.w = xv.w + g1.w * acc[rb][cb][4 * g4 + 3] * rbs[rb];
                    if (!(PF & 8)) { u32x2 w1; w1.x = cvt_pk(o.x, o.y); w1.y = cvt_pk(o.z, o.w); *(u32x2*)(X1b + rowoff + col) = w1; } ss[rb] += (o.x * o.x + o.y * o.y) + (o.z * o.z + o.w * o.w);
                    acc[rb][cb][4 * g4] = o.x; acc[rb][cb][4 * g4 + 1] = o.y; acc[rb][cb][4 * g4 + 2] = o.z; acc[rb][cb][4 * g4 + 3] = o.w; } }
#pragma unroll
        for (int rb = 0; rb < 2; ++rb) { ss[rb] += __shfl_xor(ss[rb], 32); if (h == 0) red[wave * 64 + rb * 32 + l31] = ss[rb]; }
        __syncthreads();
#pragma unroll
        for (int rb = 0; rb < 2; ++rb) { const int row = rb * 32 + l31; float s = 0.f;
#pragma unroll
            for (int w = 0; w < NWAVE; ++w) s += red[w * 64 + row];
            const float rstd = rsqrtf(s * (1.f / D) + EPS);
#pragma unroll
            for (int cb = 0; cb < 4; ++cb)
#pragma unroll
                for (int g4 = 0; g4 < 4; ++g4) { int col = 128 * wave + cb * 32 + 8 * g4 + 4 * h; asm volatile("" : "+v"(col));
                    const f32x4 gg = *(const f32x4*)(a.norm2_g + col), s1 = *(const f32x4*)(mod + b * 6 * D + 4 * D + col), s0 = *(const f32x4*)(mod + b * 6 * D + 3 * D + col);
                    const float o0 = acc[rb][cb][4 * g4] * rstd * gg.x * (1.f + s1.x) + s0.x, o1 = acc[rb][cb][4 * g4 + 1] * rstd * gg.y * (1.f + s1.y) + s0.y;
                    const float o2 = acc[rb][cb][4 * g4 + 2] * rstd * gg.z * (1.f + s1.z) + s0.z, o3 = acc[rb][cb][4 * g4 + 3] * rstd * gg.w * (1.f + s1.w) + s0.w;
                    u32x2 w; w.x = cvt_pk(o0, o1); w.y = cvt_pk(o2, o3); *(LAS u32x2*)(lds + row * P45_STR + col * 2) = w; } }
        __syncthreads();
#pragma unroll 2
        for (int i = 0; i < 8; ++i) { const int row = wave * 8 + i;
            const u32x4 v0 = *(const LAS u32x4*)(lds + row * P45_STR + lane * 32), v1 = *(const LAS u32x4*)(lds + row * P45_STR + lane * 32 + 16);
            auto f = [](unsigned w2) { return __uint_as_float(w2 << 16); }; auto g = [](unsigned w2) { return __uint_as_float(w2 & 0xffff0000u); };
            u32x4 o;
            { int p = __builtin_amdgcn_cvt_pk_fp8_f32(f(v0.x), g(v0.x), 0, false); p = __builtin_amdgcn_cvt_pk_fp8_f32(f(v0.y), g(v0.y), p, true); o.x = (unsigned)p; }
            { int p = __builtin_amdgcn_cvt_pk_fp8_f32(f(v0.z), g(v0.z), 0, false); p = __builtin_amdgcn_cvt_pk_fp8_f32(f(v0.w), g(v0.w), p, true); o.y = (unsigned)p; }
            { int p = __builtin_amdgcn_cvt_pk_fp8_f32(f(v1.x), g(v1.x), 0, false); p = __builtin_amdgcn_cvt_pk_fp8_f32(f(v1.y), g(v1.y), p, true); o.z = (unsigned)p; }
            { int p = __builtin_amdgcn_cvt_pk_fp8_f32(f(v1.z), g(v1.z), 0, false); p = __builtin_amdgcn_cvt_pk_fp8_f32(f(v1.w), g(v1.w), p, true); o.w = (unsigned)p; }
            *(u32x4*)(X8 + (size_t)(t0 + row) * D + lane * 16) = o; }
        if (PF & 2) continue;
        {
            f32x16 lacc[2];
#pragma unroll
            for (int r = 0; r < 16; ++r) { lacc[0][r] = 0.f; lacc[1][r] = 0.f; }
            const bf16* wb0 = WTR + (size_t)(32 * wave + l31) * 32 + 16 * h;
            const LAS unsigned char* al = lds + l31 * P45_STR + 32 * h;
            bf16x8 wr[8];
#pragma unroll
            for (int d = 0; d < 8; ++d) wr[d] = *(const bf16x8*)(wb0 + (size_t)(d >> 1) * (NE * 32) + 8 * (d & 1));
#pragma unroll 1
            for (int q0 = 0; q0 < 64; q0 += 8) {
#pragma unroll
                for (int d = 0; d < 8; ++d) { const int q = q0 + d;
                    const bf16x8 a0 = *(const LAS bf16x8*)(al + 64 * (q >> 1) + 16 * (q & 1)), a1 = *(const LAS bf16x8*)(al + 32 * P45_STR + 64 * (q >> 1) + 16 * (q & 1));
                    lacc[0] = MFMA32(wr[d], a0, lacc[0]); lacc[1] = MFMA32(wr[d], a1, lacc[1]);
                    const int qn = min(q + 8, 56 + d); wr[d] = *(const bf16x8*)(wb0 + (size_t)(qn >> 1) * (NE * 32) + 8 * (qn & 1)); asm volatile("" ::: "memory"); }
            }
            asm volatile("s_waitcnt vmcnt(0)" ::: "memory");
            __syncthreads();
#pragma unroll
            for (int rb = 0; rb < 2; ++rb)
#pragma unroll
                for (int g4 = 0; g4 < 4; ++g4) *(LAS f32x4*)(lg + (rb * 32 + l31) * 260 + 32 * wave + 8 * g4 + 4 * h) = (f32x4){lacc[rb][4 * g4], lacc[rb][4 * g4 + 1], lacc[rb][4 * g4 + 2], lacc[rb][4 * g4 + 3]};
        }
        __syncthreads();
        const f32x4 eb = *(const f32x4*)(a.e_bias + lane * 4);
#pragma unroll 1
        for (int i0 = 0; i0 < 8; i0 += 4) {
            float sc[4][4], sl[4][4], wsum[4], mysc[4]; int myidx[4];
#pragma unroll
            for (int q = 0; q < 4; ++q) { const int row = wave * 8 + i0 + q;
                const f32x4 lv = *(const LAS f32x4*)(lg + row * 260 + lane * 4);
#pragma unroll
                for (int j = 0; j < 4; ++j) { sc[q][j] = __builtin_amdgcn_rcpf(1.f + __expf(-lv[j])); sl[q][j] = sc[q][j] + eb[j]; }
                wsum[q] = 0.f; mysc[q] = 0.f; myidx[q] = 0; }
            float m1[4], m2[4];
#pragma unroll
            for (int q = 0; q < 4; ++q) { m1[q] = fmaxf(sl[q][0], sl[q][1]); m2[q] = fminf(sl[q][0], sl[q][1]);
                const float c1 = fmaxf(sl[q][2], sl[q][3]), c2 = fminf(sl[q][2], sl[q][3]); const float n1 = fmaxf(m1[q], c1), n2 = fmaxf(fminf(m1[q], c1), fmaxf(m2[q], c2)); m1[q] = n1; m2[q] = n2; }
#pragma unroll
            for (int o = 1; o < 8; o <<= 1)
#pragma unroll
                for (int q = 0; q < 4; ++q) { const float c1 = __shfl_xor(m1[q], o), c2 = __shfl_xor(m2[q], o); const float n1 = fmaxf(m1[q], c1), n2 = fmaxf(fminf(m1[q], c1), fmaxf(m2[q], c2)); m1[q] = n1; m2[q] = n2; }
            const int grp = lane >> 3;
#pragma unroll
            for (int q = 0; q < 4; ++q) { const float gs = m1[q] + m2[q]; int rank = 0;
#pragma unroll
                for (int g2 = 0; g2 < 8; ++g2) { const float og = __shfl(gs, g2 * 8); rank += (og > gs || (og == gs && g2 < grp)) ? 1 : 0; }
                if (rank >= 4) { sl[q][0] = -INFINITY; sl[q][1] = -INFINITY; sl[q][2] = -INFINITY; sl[q][3] = -INFINITY; } }
#pragma unroll 1
            for (int r = 0; r < TOPK; ++r) {
                float bv[4]; int bi[4];
#pragma unroll
                for (int q = 0; q < 4; ++q) { bv[q] = sl[q][0]; bi[q] = 0;
#pragma unroll
                    for (int j = 1; j < 4; ++j) if (sl[q][j] > bv[q]) { bv[q] = sl[q][j]; bi[q] = j; }
                    bi[q] += lane * 4; }
#pragma unroll
                for (int o = 1; o < 64; o <<= 1)
#pragma unroll
                    for (int q = 0; q < 4; ++q) { const float ov = __shfl_xor(bv[q], o); const int oi = __shfl_xor(bi[q], o); if (ov > bv[q] || (ov == bv[q] && oi < bi[q])) { bv[q] = ov; bi[q] = oi; } }
#pragma unroll
                for (int q = 0; q < 4; ++q) { const int j = bi[q] & 3; const bool own = (bi[q] >> 2) == lane;
                    const float scj = (j == 0) ? sc[q][0] : (j == 1) ? sc[q][1] : (j == 2) ? sc[q][2] : sc[q][3];
                    const float scw = __shfl(scj, bi[q] >> 2);
                    if (own) { if (j == 0) sl[q][0] = -INFINITY; else if (j == 1) sl[q][1] = -INFINITY; else if (j == 2) sl[q][2] = -INFINITY; else sl[q][3] = -INFINITY; }
                    wsum[q] += scw;
                    if (lane == r) { myidx[q] = bi[q]; mysc[q] = scw; } }
            }
#pragma unroll
            for (int q = 0; q < 4; ++q) { const int t = t0 + wave * 8 + i0 + q;
                if (lane < TOPK && !(PF & 1)) { const int slot = atomicAdd(&cnt[myidx[q]], 1); list[(size_t)myidx[q] * NTOK + slot] = t * 8 + lane; ew[t * 8 + lane] = mysc[q] / wsum[q] * 2.5f; } }
        }
    }
}
constexpr int MOE_H_OFF = 81920;
__device__ __forceinline__ void phase6_old(const Args& a, LAS unsigned char* lds, int vcu, int G, const XcdBarrier rbar, const bool use_rbar) {
    typedef GemmCore<2, 4, 2, 4, 8, false, true, 2> G1;
    typedef GemmCore<2, 4, 2, 4, 8, true, true, 2> G2;
    static_assert(G1::LDS_NEED <= MOE_H_OFF && MOE_H_OFF + 8 * 8192 <= LDS_CTL_OFF, "MoE LDS map");
    const int tid = threadIdx.x, lane = tid & 63, wave = __builtin_amdgcn_readfirstlane(tid >> 6), wm = wave / 4, wn = wave % 4, h = lane >> 5, l31 = lane & 31;
    const bf16* H2 = (const bf16*)(a.ws + WS_H2); const int* cnt = (const int*)(a.ws + C_CNT); const int* list = (const int*)(a.ws + WS_LIST); const float* ew = (const float*)(a.ws + WS_EW);
    bf16* YBUF = (bf16*)(a.ws + WS_YBUF); bf16* YSH = (bf16*)(a.ws + WS_YSH);
    LAS int* pf = (LAS int*)(lds + 0);
    __syncthreads();
    if (tid < NE) pf[tid + 1] = (cnt[tid] + 127) >> 7;
    if (tid == 0) pf[0] = 0;
    __syncthreads();
    if (tid == 0) { int s = 0; for (int e = 0; e < NE; ++e) { s += pf[e + 1]; pf[e + 1] = s; } }
    __syncthreads();
    const int R = pf[NE];
    const int NSH = NTOK / 128;
    LAS int* myu = (LAS int*)(lds + LDS_CTL_OFF + 256);
    const int total = NSH + R;
    int nmy = 0;
    for (int u = vcu; u < total; u += G) ++nmy;
    if (nmy > 16) nmy = 16;
    if (tid < nmy) { const int u = vcu + tid * G; int e, ci;
        if (u < NSH) { e = NE; ci = u; }
        else { const int ru = u - NSH; int lo = 0, hi = NE - 1; while (lo < hi) { const int mid = (lo + hi) >> 1; if (pf[mid + 1] > ru) hi = mid; else lo = mid + 1; } e = lo; ci = ru - pf[lo]; }
        myu[tid] = e; myu[16 + tid] = ci; }
    __syncthreads();
    LAS int* rowa = (LAS int*)(lds + LDS_CTL_OFF + 384);
    const int nrounds = (total + G - 1) / G;
    for (int iu = 0; iu < nrounds; ++iu) {
        if (use_rbar && iu > 0) xcd_barrier(rbar);
        if (iu >= nmy) continue;
        const int e = myu[iu], ci = myu[16 + iu];
        const int n = (e < NE) ? min(128, cnt[e] - ci * 128) : 128;
        const float* W1 = (e < NE) ? a.w1 + (size_t)e * D * ED : a.ws1; const float* W3 = (e < NE) ? a.w3 + (size_t)e * D * ED : a.ws3; const float* W2 = (e < NE) ? a.w2 + (size_t)e * ED * D : a.ws2;
        __syncthreads();
        if (tid < 128) rowa[tid] = (tid < n) ? ((e < NE) ? list[(size_t)e * NTOK + ci * 128 + tid] : ci * 128 + tid) : -1;
        __syncthreads();
        f32x16 acc[2][4]; zero_acc(acc);
        G1::run(lds, [&](int r) { const int aid = rowa[r]; const int tok = (e < NE) ? (aid >> 3) : aid; return (aid < 0) ? (const bf16*)nullptr : (H2 + (size_t)tok * D); },
                [&](int c) { const int w4 = c >> 7, within = c & 127; return (within < 64) ? (W1 + 64 * w4 + within) : (W3 + 64 * w4 + within - 64); }, ED, D / 32, acc, nullptr);
        {
#pragma unroll
            for (int rb = 0; rb < 2; ++rb) { const int row = wm * 64 + rb * 32 + l31;
#pragma unroll
                for (int cb = 0; cb < 2; ++cb)
#pragma unroll
                    for (int g4 = 0; g4 < 4; ++g4) { float hv[4];
#pragma unroll
                        for (int e4 = 0; e4 < 4; ++e4) { const float gt = acc[rb][cb][4 * g4 + e4], up = acc[rb][cb + 2][4 * g4 + e4]; hv[e4] = gt / (1.f + __expf(-gt)) * up; }
                        u32x2 w; w.x = cvt_pk(hv[0], hv[1]); w.y = cvt_pk(hv[2], hv[3]);
                        const int ks2 = 2 * wn + cb;
                        *(LAS u32x2*)(lds + MOE_H_OFF + ks2 * 8192 + row * 64 + ((g4 ^ ((row >> 2) & 3)) << 4) + 8 * h) = w; } }
        }
        __syncthreads();
        const int aid0 = rowa[wm * 64 + l31], aid1 = rowa[wm * 64 + 32 + l31];
        for (int nh = 0; nh < 2; ++nh) {
            zero_acc(acc);
            G2::run(lds, [&](int) { return (const bf16*)nullptr; }, [&](int c) { return W2 + nh * 512 + c; }, D, ED / 32, acc, lds + MOE_H_OFF);
#pragma unroll
            for (int rb = 0; rb < 2; ++rb) { const int aid = rb ? aid1 : aid0; if (aid < 0) continue;
                const float wgt = (e < NE) ? ew[aid] : 1.f; bf16* dst = ((e < NE) ? YBUF : YSH) + (size_t)aid * D + nh * 512 + wn * 128;
#pragma unroll
                for (int cb = 0; cb < 4; ++cb)
#pragma unroll
                    for (int g4 = 0; g4 < 4; ++g4) { u32x2 w; w.x = cvt_pk(acc[rb][cb][4 * g4] * wgt, acc[rb][cb][4 * g4 + 1] * wgt); w.y = cvt_pk(acc[rb][cb][4 * g4 + 2] * wgt, acc[rb][cb][4 * g4 + 3] * wgt);
                        *(u32x2*)(dst + cb * 32 + 8 * g4 + 4 * h) = w; } }
        }
    }
}
constexpr int MOE_TOK_OFF = 32768, MOE_AID_OFF = MOE_TOK_OFF + 4096, MOE_W_OFF = MOE_AID_OFF + 4096;
template <int NRB, int NCB>
__device__ __forceinline__ void moe_unit(LAS unsigned char* lds, const bf16* H2, const float* W1, const float* W3, const float* W2, bf16* hb, bf16* ybase, const int nrb) {
    constexpr int COLS = NCB * 32, HU = COLS / 2, TASKS = 4 * (COLS / 4), NG = NTHR / TASKS;
    constexpr int P1 = 256 / HU, T1 = P1 * 32, P2 = 1024 / COLS, T2 = P2 * 8, T = T1 + T2, SLOT = COLS * 64;
    static_assert(NG >= 2 && (NG & (NG - 1)) == 0 && T1 % 2 == 0, "moe_unit geometry");
    const int tid = threadIdx.x, lane = tid & 63, wave = __builtin_amdgcn_readfirstlane(tid >> 6), h = lane >> 5, l31 = lane & 31;
    const int grp = __builtin_amdgcn_readfirstlane(tid / TASKS), q = tid % TASKS, cg = q % (COLS / 4), kg = q / (COLS / 4), c0 = 4 * cg;
    const LAS int* r_tok = (const LAS int*)(lds + MOE_TOK_OFF); const LAS int* r_aid = (const LAS int*)(lds + MOE_AID_OFF); const LAS float* r_w = (const LAS float*)(lds + MOE_W_OFF);
    int xoff[NRB];
#pragma unroll
    for (int rb = 0; rb < NRB; ++rb) { const int row = (rb * 8 + wave) * 32 + l31; xoff[rb] = r_tok[row] * D + 16 * h; }
    const int hoff0 = (wave * 32 + l31) * ED;
    f32x16 acc[NRB][NCB]; zero_acc(acc);
    f32x4 wreg[8];
    bf16x8 xa[NRB][2], xb[NRB][2];
    const int wwo = c0 * 64 + ((kg ^ (cg & 3)) << 4);
    const int swz = (l31 >> 2) & 3, rs0 = l31 * 64 + (((2 * h) ^ swz) << 4), rs1 = l31 * 64 + (((2 * h + 1) ^ swz) << 4);
    auto issue_w = [&](int tt) {
        const float* p; int ld;
        if (tt < T1) { const int ps = tt >> 5, ks = tt & 31; ld = ED; p = ((c0 < HU) ? (W1 + ps * HU + c0) : (W3 + ps * HU + (c0 - HU))) + (size_t)(32 * ks + 8 * kg) * ED; }
        else { const int t2 = tt - T1, qs = t2 >> 3, ks = t2 & 7; ld = D; p = W2 + qs * COLS + c0 + (size_t)(32 * ks + 8 * kg) * D; }
#pragma unroll
        for (int i = 0; i < 8; ++i) wreg[i] = *(const f32x4*)(p + (size_t)i * ld);
    };
    auto write_w = [&](int tt) {
        LAS unsigned char* sb = lds + (tt & 1) * SLOT + wwo;
#pragma unroll
        for (int j = 0; j < 4; ++j) { u32x4 w; w.x = cvt_pk(wreg[0][j], wreg[1][j]); w.y = cvt_pk(wreg[2][j], wreg[3][j]); w.z = cvt_pk(wreg[4][j], wreg[5][j]); w.w = cvt_pk(wreg[6][j], wreg[7][j]);
            *(LAS u32x4*)(sb + j * 64) = w; }
    };
    auto load_x = [&](bf16x8 (&x)[NRB][2], int tt) {
#pragma unroll
        for (int rb = 0; rb < NRB; ++rb) if (rb < nrb) {
            const bf16* p = (tt < T1) ? (H2 + xoff[rb] + 32 * (tt & 31)) : (hb + hoff0 + rb * (256 * ED) + 16 * h + 32 * ((tt - T1) & 7));
            x[rb][0] = *(const bf16x8*)p; x[rb][1] = *(const bf16x8*)(p + 8); }
    };
    auto compute = [&](const bf16x8 (&x)[NRB][2], int tt) {
        const LAS unsigned char* base = lds + (tt & 1) * SLOT;
#pragma unroll
        for (int s = 0; s < 2; ++s) {
#pragma unroll
            for (int cb = 0; cb < NCB; ++cb) { const bf16x8 wf = *(const LAS bf16x8*)(base + cb * 2048 + (s ? rs1 : rs0));
#pragma unroll
                for (int rb = 0; rb < NRB; ++rb) if (rb < nrb) acc[rb][cb] = MFMA32(wf, x[rb][s], acc[rb][cb]); }
        }
    };
    auto epi1 = [&](int ps) {
#pragma unroll
        for (int rb = 0; rb < NRB; ++rb) if (rb < nrb) {
#pragma unroll
            for (int cb = 0; cb < NCB / 2; ++cb)
#pragma unroll
                for (int g4 = 0; g4 < 4; ++g4) { float hv[4];
#pragma unroll
                    for (int e4 = 0; e4 < 4; ++e4) { const float gt = acc[rb][cb][4 * g4 + e4], up = acc[rb][cb + NCB / 2][4 * g4 + e4]; hv[e4] = gt / (1.f + __expf(-gt)) * up; }
                    u32x2 w; w.x = cvt_pk(hv[0], hv[1]); w.y = cvt_pk(hv[2], hv[3]);
                    *(u32x2*)(hb + hoff0 + rb * (256 * ED) + ps * HU + cb * 32 + 8 * g4 + 4 * h) = w; } }
    };
    auto epi2 = [&](int qs) {
#pragma unroll
        for (int rb = 0; rb < NRB; ++rb) if (rb < nrb) { const int row = (rb * 8 + wave) * 32 + l31; const int aid = r_aid[row]; if (aid < 0) continue;
            bf16* dst = ybase + (size_t)aid * D + qs * COLS + 4 * h; const float wg = r_w[row];
#pragma unroll
            for (int cb = 0; cb < NCB; ++cb)
#pragma unroll
                for (int g4 = 0; g4 < 4; ++g4) { u32x2 w; w.x = cvt_pk(acc[rb][cb][4 * g4] * wg, acc[rb][cb][4 * g4 + 1] * wg); w.y = cvt_pk(acc[rb][cb][4 * g4 + 2] * wg, acc[rb][cb][4 * g4 + 3] * wg);
                    *(u32x2*)(dst + cb * 32 + 8 * g4) = w; } }
    };
    issue_w(grp);
    load_x(xa, 0);
    if (grp == 0) write_w(0);
    __syncthreads();
    int t = 0;
    auto two_steps = [&](bool last_of_stage1) {
        if ((t & (NG - 1)) == grp && t + NG < T) issue_w(t + NG);
        load_x(xb, t + 1);
        compute(xa, t);
        if (((t + 1) & (NG - 1)) == grp) write_w(t + 1);
        __syncthreads();
        const int t1 = t + 1;
        if ((t1 & (NG - 1)) == grp && t1 + NG < T) issue_w(t1 + NG);
        if (t1 + 1 < T && !last_of_stage1) load_x(xa, t1 + 1);
        compute(xb, t1);
        if (((t1 + 1) & (NG - 1)) == grp && t1 + 1 < T) write_w(t1 + 1);
        __syncthreads();
        t += 2;
    };
#pragma unroll 1
    for (int ps = 0; ps < P1; ++ps) {
#pragma unroll 1
        for (int k2 = 0; k2 < 16; ++k2) two_steps(ps == P1 - 1 && k2 == 15);
        epi1(ps); zero_acc(acc);
    }
    asm volatile("s_waitcnt vmcnt(0)" ::: "memory");
    load_x(xa, T1);
#pragma unroll 1
    for (int qs = 0; qs < P2; ++qs) {
#pragma unroll 1
        for (int k2 = 0; k2 < 4; ++k2) two_steps(false);
        epi2(qs); zero_acc(acc);
    }
}
__device__ __forceinline__ void phase6_v2(const Args& a, LAS unsigned char* lds, int vcu, int G) {
    const int tid = threadIdx.x;
    const bf16* H2 = (const bf16*)(a.ws + WS_H2); const int* cnt = (const int*)(a.ws + C_CNT); const int* list = (const int*)(a.ws + WS_LIST); const float* ew = (const float*)(a.ws + WS_EW);
    bf16* YBUF = (bf16*)(a.ws + WS_YBUF); bf16* YSH = (bf16*)(a.ws + WS_YSH); int* qhead = (int*)(a.ws + C_QHEAD);
    bf16* hb = (bf16*)(a.ws + WS_HB) + (size_t)(vcu & 255) * 768 * ED;
    LAS int* r_tok = (LAS int*)(lds + MOE_TOK_OFF); LAS int* r_aid = (LAS int*)(lds + MOE_AID_OFF); LAS float* r_w = (LAS float*)(lds + MOE_W_OFF);
    volatile LAS int* qslot = (volatile LAS int*)(lds + LDS_CTL_OFF + 256);
    int e = vcu;
    bool routed = e < NE;
    for (;;) {
        int n, r0 = 0, sh_c = 0;
        if (routed) n = cnt[e];
        else { __syncthreads(); if (tid == 0) *qslot = atomicAdd(qhead, 1); __syncthreads(); sh_c = *qslot; if (sh_c >= NTOK / 256) break; n = 256; }
        const float* W1 = routed ? a.w1 + (size_t)e * D * ED : a.ws1; const float* W3 = routed ? a.w3 + (size_t)e * D * ED : a.ws3; const float* W2 = routed ? a.w2 + (size_t)e * ED * D : a.ws2;
        for (; r0 < n; r0 += 768) {
            const int ns = min(768, n - r0);
            __syncthreads();
            for (int i = tid; i < 768; i += NTHR) { int tok = 0, aid = -1; float w = 0.f;
                if (i < ns) { if (routed) { aid = list[(size_t)e * NTOK + r0 + i]; tok = aid >> 3; w = ew[aid]; } else { tok = sh_c * 256 + i; aid = tok; w = 1.f; } }
                r_tok[i] = tok; r_aid[i] = aid; r_w[i] = w; }
            if (tid == 0) { __builtin_amdgcn_fence(__ATOMIC_ACQUIRE, "agent"); asm volatile("s_waitcnt vmcnt(0)" ::: "memory"); }
            __syncthreads();
            if (ns > 512) moe_unit<3, 2>(lds, H2, W1, W3, W2, hb, routed ? YBUF : YSH, 3);
            else moe_unit<2, 4>(lds, H2, W1, W3, W2, hb, routed ? YBUF : YSH, ns > 256 ? 2 : 1);
        }
        if (routed) { e += G; routed = e < NE; }
    }
}
constexpr int M3_TAB = 81920;
constexpr int M3_ROWS = 1536;
template <int PF>
__device__ __forceinline__ void phase6(const Args& a, LAS unsigned char* lds, int vcu, int G) {
    const int tid = threadIdx.x, lane = tid & 63, wave = __builtin_amdgcn_readfirstlane(tid >> 6), h = lane >> 5, l31 = lane & 31;
    const bf16* H2 = (const bf16*)(a.ws + WS_H2); const int* cnt = (const int*)(a.ws + C_CNT); const int* list = (const int*)(a.ws + WS_LIST); const float* ew = (const float*)(a.ws + WS_EW);
    bf16* YBUF = (bf16*)(a.ws + WS_YBUF); bf16* YSH = (bf16*)(a.ws + WS_YSH);
    {
        typedef GemmCore<2, 2, 1, 8, 4, false, true, 2, 1> S1;
        typedef GemmCore<2, 2, 1, 8, 4, true, true, 2, 1> S2;
        constexpr int HOFF = S1::LDS_NEED;
        static_assert(HOFF + 8 * 4096 <= LDS_CTL_OFF, "shared-expert LDS map");
        const bf16* W13 = (const bf16*)(a.ws + WS_WS13T); const bf16* W2T = (const bf16*)(a.ws + WS_WS2T);
        if (!(PF & 1)) for (int su = vcu; su < NTOK / 64; su += G) {
            const int t0 = su * 64;
            f32x16 acc[2][2]; zero_acc(acc);
            __syncthreads();
            S1::run(lds, [&](int r) { return H2 + (size_t)(t0 + r) * D; },
                    [&](int c) { const int w8 = c >> 6, within = c & 63; return W13 + (size_t)((within < 32) ? (32 * w8 + within) : (ED + 32 * w8 + within - 32)) * D; }, D, D / 32, acc, nullptr);
#pragma unroll
            for (int rb = 0; rb < 2; ++rb) { const int row = rb * 32 + l31;
#pragma unroll
                for (int g4 = 0; g4 < 4; ++g4) { float hv[4];
#pragma unroll
                    for (int e4 = 0; e4 < 4; ++e4) { const float gt = acc[rb][0][4 * g4 + e4], up = acc[rb][1][4 * g4 + e4]; hv[e4] = gt / (1.f + __expf(-gt)) * up; }
                    u32x2 w; w.x = cvt_pk(hv[0], hv[1]); w.y = cvt_pk(hv[2], hv[3]);
                    *(LAS u32x2*)(lds + HOFF + wave * 4096 + row * 64 + ((g4 ^ ((row >> 2) & 3)) << 4) + 8 * h) = w; } }
            __syncthreads();
            for (int nh = 0; nh < 2; ++nh) {
                zero_acc(acc);
                S2::run(lds, [&](int) { return (const bf16*)nullptr; }, [&](int c) { return W2T + (size_t)(nh * 512 + c) * ED; }, ED, ED / 32, acc, lds + HOFF);
#pragma unroll
                for (int rb = 0; rb < 2; ++rb) { bf16* dst = YSH + (size_t)(t0 + rb * 32 + l31) * D + nh * 512 + wave * 64 + 4 * h;
#pragma unroll
                    for (int cb = 0; cb < 2; ++cb)
#pragma unroll
                        for (int g4 = 0; g4 < 4; ++g4) { u32x2 w; w.x = cvt_pk(acc[rb][cb][4 * g4], acc[rb][cb][4 * g4 + 1]); w.y = cvt_pk(acc[rb][cb][4 * g4 + 2], acc[rb][cb][4 * g4 + 3]);
                            *(u32x2*)(dst + cb * 32 + 8 * g4) = w; } }
            }
        }
    }
    typedef GemmCore<2, 4, 8, 1, 2, false, true, 2, 0> GE;
    static_assert(GE::LDS_NEED <= M3_TAB && M3_TAB + 3 * M3_ROWS * 4 <= LDS_CTL_OFF, "expert LDS map");
    LAS int* r_tok = (LAS int*)(lds + M3_TAB); LAS int* r_aid = r_tok + M3_ROWS; LAS float* r_w = (LAS float*)(r_aid + M3_ROWS);
    bf16* hb = (bf16*)(a.ws + WS_HB) + (size_t)(vcu & 255) * M3_ROWS * ED;
    for (int e = vcu; e < NE; e += G) {
        const int n = cnt[e];
        const float* W1 = a.w1 + (size_t)e * D * ED; const float* W3 = a.w3 + (size_t)e * D * ED; const float* W2 = a.w2 + (size_t)e * ED * D;
        for (int sg0 = 0; sg0 < n; sg0 += M3_ROWS) {
            const int ns = (PF & 16) ? min(512, n - sg0) : min(M3_ROWS, n - sg0), nrg = (ns + 511) >> 9;
            __syncthreads();
            for (int i = tid; i < nrg * 512; i += NTHR) { int tok = 0, aid = -1; float w = 0.f;
                if (i < ns) { aid = list[(size_t)e * NTOK + sg0 + i]; tok = (PF & 8) ? ((e * 64 + i) & (NTOK - 1)) : (aid >> 3); w = ew[aid]; }
                r_tok[i] = tok; r_aid[i] = aid; r_w[i] = w; }
            __syncthreads();
            if (!(PF & 4)) for (int p = 0; p < 4; ++p)
                for (int rg = 0; rg < nrg; ++rg) {
                    f32x16 acc[2][4]; zero_acc(acc);
                    GE::run(lds, [&](int r) { return (r_aid[rg * 512 + r] < 0) ? (const bf16*)nullptr : (H2 + (size_t)r_tok[rg * 512 + r] * D); },
                            [&](int c) { return (c < 64) ? (W1 + 64 * p + c) : (W3 + 64 * p + c - 64); }, ED, D / 32, acc, nullptr);
#pragma unroll
                    for (int rb = 0; rb < 2; ++rb) { bf16* hrow = hb + (size_t)(rg * 512 + wave * 64 + rb * 32 + l31) * ED + 64 * p + 4 * h;
#pragma unroll
                        for (int cb = 0; cb < 2; ++cb)
#pragma unroll
                            for (int g4 = 0; g4 < 4; ++g4) { float hv[4];
#pragma unroll
                                for (int e4 = 0; e4 < 4; ++e4) { const float gt = acc[rb][cb][4 * g4 + e4], up = acc[rb][cb + 2][4 * g4 + e4]; hv[e4] = gt / (1.f + __expf(-gt)) * up; }
                                u32x2 w; w.x = cvt_pk(hv[0], hv[1]); w.y = cvt_pk(hv[2], hv[3]);
                                *(u32x2*)(hrow + cb * 32 + 8 * g4) = w; } }
                }
            asm volatile("s_waitcnt vmcnt(0)" ::: "memory");
            __syncthreads();
            if (tid == 0) { __builtin_amdgcn_fence(__ATOMIC_ACQUIRE, "agent"); asm volatile("s_waitcnt vmcnt(0)" ::: "memory"); }
            __syncthreads();
            if (!(PF & 2)) for (int qs = 0; qs < 8; ++qs)
                for (int rg = 0; rg < nrg; ++rg) {
                    f32x16 acc[2][4]; zero_acc(acc);
                    GE::run(lds, [&](int r) { return (r_aid[rg * 512 + r] < 0) ? (const bf16*)nullptr : (hb + (size_t)(rg * 512 + r) * ED); }, [&](int c) { return W2 + 128 * qs + c; }, D, ED / 32, acc, nullptr);
#pragma unroll
                    for (int rb = 0; rb < 2; ++rb) { const int row = rg * 512 + wave * 64 + rb * 32 + l31; const int aid = r_aid[row]; if (aid < 0) continue;
                        const float wg = r_w[row]; bf16* dst = YBUF + (size_t)aid * D + 128 * qs + 4 * h;
#pragma unroll
                        for (int cb = 0; cb < 4; ++cb)
#pragma unroll
                            for (int g4 = 0; g4 < 4; ++g4) { u32x2 w; w.x = cvt_pk(acc[rb][cb][4 * g4] * wg, acc[rb][cb][4 * g4 + 1] * wg); w.y = cvt_pk(acc[rb][cb][4 * g4 + 2] * wg, acc[rb][cb][4 * g4 + 3] * wg);
                                *(u32x2*)(dst + cb * 32 + 8 * g4) = w; } }
                }
        }
    }
}
constexpr int F8_TILE = 16384, F8_EXP_BYTES = 48 * F8_TILE;
constexpr float F8_S1 = 64.f, F8_S2 = 32.f;
template <int BMD, int SKIP = 0, int DBG = 0>
__device__ __forceinline__ void moe_chunk(const Args& a, LAS unsigned char* lds, int e, int ci) {
    constexpr int PDX = (BMD == 2) ? 1 : 4;
    typedef GemmCore<2, 4, 2, 4, 8, false, true, PDX, BMD, DBG> G1;
    typedef GemmCore<2, 4, 2, 4, 8, true, true, PDX, BMD> G2;
    static_assert(G1::LDS_NEED <= MOE_H_OFF && MOE_H_OFF + 8 * 8192 <= LDS_CTL_OFF, "MoE LDS map");
    const int tid = threadIdx.x, lane = tid & 63, wave = __builtin_amdgcn_readfirstlane(tid >> 6), wm = wave / 4, wn = wave % 4, h = lane >> 5, l31 = lane & 31;
    const bf16* H2 = (const bf16*)(a.ws + WS_H2); const int* cnt = (const int*)(a.ws + C_CNT); const int* list = (const int*)(a.ws + WS_LIST); const float* ew = (const float*)(a.ws + WS_EW);
    bf16* YBUF = (bf16*)(a.ws + WS_YBUF);
    LAS int* rowa = (LAS int*)(lds + LDS_CTL_OFF + 384);
    const int n = min(128, cnt[e] - ci * 128);
    const float* W1 = a.w1 + (size_t)e * D * ED; const float* W3 = a.w3 + (size_t)e * D * ED; const float* W2 = a.w2 + (size_t)e * ED * D;
    unsigned char* f8 = a.ws + WS_HB + (size_t)e * F8_EXP_BYTES;
    const float s1 = (BMD == 3) ? 1.f / F8_S1 : 1.f, s2 = (BMD == 3) ? 1.f / F8_S2 : 1.f;
    __syncthreads();
    if (tid < 128) rowa[tid] = (tid < n) ? list[(size_t)e * NTOK + ci * 128 + tid] : -1;
    __syncthreads();
    f32x16 acc[2][4]; zero_acc(acc);
    if (SKIP != 2) G1::run(lds, [&](int r) { const int aid = rowa[r]; return (aid < 0) ? (const bf16*)nullptr : (H2 + (size_t)(aid >> 3) * D); },
            [&](int c) { const int w4 = c >> 7, within = c & 127; return (within < 64) ? (W1 + 64 * w4 + within) : (W3 + 64 * w4 + within - 64); }, ED, D / 32, acc, nullptr, f8, F8_S1, (e * 5 + ci * 11) & 31);
#pragma unroll
    for (int rb = 0; rb < 2; ++rb) { const int row = wm * 64 + rb * 32 + l31;
#pragma unroll
        for (int cb = 0; cb < 2; ++cb)
#pragma unroll
            for (int g4 = 0; g4 < 4; ++g4) { float hv[4];
#pragma unroll
                for (int e4 = 0; e4 < 4; ++e4) { const float gt = acc[rb][cb][4 * g4 + e4] * s1, up = acc[rb][cb + 2][4 * g4 + e4] * s1; hv[e4] = gt / (1.f + __expf(-gt)) * up; }
                u32x2 w; w.x = cvt_pk(hv[0], hv[1]); w.y = cvt_pk(hv[2], hv[3]);
                *(LAS u32x2*)(lds + MOE_H_OFF + (2 * wn + cb) * 8192 + row * 64 + ((g4 ^ ((row >> 2) & 3)) << 4) + 8 * h) = w; } }
    __syncthreads();
    const int aid0 = rowa[wm * 64 + l31], aid1 = rowa[wm * 64 + 32 + l31];
    if (SKIP != 1) for (int nh = 0; nh < 2; ++nh) {
        zero_acc(acc);
        G2::run(lds, [&](int) { return (const bf16*)nullptr; }, [&](int c) { return W2 + nh * 512 + c; }, D, ED / 32, acc, lds + MOE_H_OFF, f8 + (size_t)(32 + nh * 8) * F8_TILE, F8_S2, (e * 3 + ci + nh * 4) & 7);
#pragma unroll
        for (int rb = 0; rb < 2; ++rb) {
            const int aid = rb ? aid1 : aid0; const float wgt = (aid < 0) ? 0.f : ew[aid] * s2;
            LAS unsigned char* yrow = lds + (wm * 32 + l31) * 1040 + (wn * 128 + 4 * h) * 2;
            __syncthreads();
#pragma unroll
            for (int cb = 0; cb < 4; ++cb)
#pragma unroll
                for (int g4 = 0; g4 < 4; ++g4) { u32x2 w; w.x = cvt_pk(acc[rb][cb][4 * g4] * wgt, acc[rb][cb][4 * g4 + 1] * wgt); w.y = cvt_pk(acc[rb][cb][4 * g4 + 2] * wgt, acc[rb][cb][4 * g4 + 3] * wgt);
                    *(LAS u32x2*)(yrow + (cb * 32 + 8 * g4) * 2) = w; }
            __syncthreads();
#pragma unroll
            for (int i = 0; i < 8; ++i) { const int lr = wave * 8 + i;
                const int ra = rowa[(lr >> 5) * 64 + rb * 32 + (lr & 31)];
                if (ra >= 0) *(u32x4*)(YBUF + (size_t)ra * D + nh * 512 + lane * 8) = *(const LAS u32x4*)(lds + lr * 1040 + lane * 16); }
        }
    }
}
__device__ __forceinline__ void moe_shared(const Args& a, LAS unsigned char* lds, int vcu, int G) {
    const int lane = threadIdx.x & 63, wave = __builtin_amdgcn_readfirstlane(threadIdx.x >> 6), h = lane >> 5, l31 = lane & 31;
    const bf16* H2 = (const bf16*)(a.ws + WS_H2); bf16* YSH = (bf16*)(a.ws + WS_YSH);
    typedef GemmCore<2, 2, 1, 8, 4, false, true, 4, 1> S1;
    typedef GemmCore<2, 2, 1, 8, 4, true, true, 4, 1> S2;
    constexpr int HOFF = S1::LDS_NEED;
    static_assert(HOFF + 8 * 4096 <= LDS_CTL_OFF, "shared-expert LDS map");
    const bf16* W13 = (const bf16*)(a.ws + WS_WS13T); const bf16* W2T = (const bf16*)(a.ws + WS_WS2T);
    for (int su = vcu; su < NTOK / 64; su += G) {
        const int t0 = su * 64;
        f32x16 acc[2][2]; zero_acc(acc);
        __syncthreads();
        S1::run(lds, [&](int r) { return H2 + (size_t)(t0 + r) * D; },
                [&](int c) { const int w8 = c >> 6, within = c & 63; return W13 + (size_t)((within < 32) ? (32 * w8 + within) : (ED + 32 * w8 + within - 32)) * D; }, D, D / 32, acc, nullptr);
#pragma unroll
        for (int rb = 0; rb < 2; ++rb) { const int row = rb * 32 + l31;
#pragma unroll
            for (int g4 = 0; g4 < 4; ++g4) { float hv[4];
#pragma unroll
                for (int e4 = 0; e4 < 4; ++e4) { const float gt = acc[rb][0][4 * g4 + e4], up = acc[rb][1][4 * g4 + e4]; hv[e4] = gt / (1.f + __expf(-gt)) * up; }
                u32x2 w; w.x = cvt_pk(hv[0], hv[1]); w.y = cvt_pk(hv[2], hv[3]);
                *(LAS u32x2*)(lds + HOFF + wave * 4096 + row * 64 + ((g4 ^ ((row >> 2) & 3)) << 4) + 8 * h) = w; } }
        __syncthreads();
        for (int nh = 0; nh < 2; ++nh) {
            zero_acc(acc);
            S2::run(lds, [&](int) { return (const bf16*)nullptr; }, [&](int c) { return W2T + (size_t)(nh * 512 + c) * ED; }, ED, ED / 32, acc, lds + HOFF);
#pragma unroll
            for (int rb = 0; rb < 2; ++rb) { bf16* dst = YSH + (size_t)(t0 + rb * 32 + l31) * D + nh * 512 + wave * 64 + 4 * h;
#pragma unroll
                for (int cb = 0; cb < 2; ++cb)
#pragma unroll
                    for (int g4 = 0; g4 < 4; ++g4) { u32x2 w; w.x = cvt_pk(acc[rb][cb][4 * g4], acc[rb][cb][4 * g4 + 1]); w.y = cvt_pk(acc[rb][cb][4 * g4 + 2], acc[rb][cb][4 * g4 + 3]);
                        *(u32x2*)(dst + cb * 32 + 8 * g4) = w; } }
        }
    }
}
template <int PARTS>
__device__ __forceinline__ void phase6_v6(const Args& a, LAS unsigned char* lds, int vcu, int G, const XcdBarrier bar) {
    const int tid = threadIdx.x;
    const int* cnt = (const int*)(a.ws + C_CNT);
    if (PARTS & 1) moe_shared(a, lds, vcu, G);
    if (PARTS & 2) for (int e = vcu; e < NE; e += G) if (cnt[e] > 0) moe_chunk<2>(a, lds, e, 0);
    xcd_barrier(bar);
    if (!(PARTS & 4)) return;
    LAS int* pf = (LAS int*)(lds + 0);
    __syncthreads();
    if (tid < NE) { const int c = (cnt[tid] + 127) >> 7; pf[tid + 1] = c > 0 ? c - 1 : 0; }
    if (tid == 0) pf[0] = 0;
    __syncthreads();
    if (tid == 0) { int s = 0; for (int e = 0; e < NE; ++e) { s += pf[e + 1]; pf[e + 1] = s; } }
    __syncthreads();
    const int total = pf[NE];
    LAS int* myu = (LAS int*)(lds + LDS_CTL_OFF + 256);
    int nmy = 0;
    for (int u = vcu; u < total; u += G) ++nmy;
    if (nmy > 16) nmy = 16;
    if (tid < nmy) { const int u = vcu + tid * G; int lo = 0, hi = NE - 1; while (lo < hi) { const int mid = (lo + hi) >> 1; if (pf[mid + 1] > u) hi = mid; else lo = mid + 1; }
        myu[tid] = lo; myu[16 + tid] = u - pf[lo] + 1; }
    __syncthreads();
    for (int iu = 0; iu < nmy; ++iu) { if (PARTS & 8) moe_chunk<3, 1, (PARTS >> 8)>(a, lds, myu[iu], myu[16 + iu]); else if (PARTS & 16) moe_chunk<3, 2>(a, lds, myu[iu], myu[16 + iu]); else moe_chunk<3>(a, lds, myu[iu], myu[16 + iu]); }
}
typedef long i64;
#define MFMA8(a, b, c) __builtin_amdgcn_mfma_f32_32x32x16_fp8_fp8((a), (b), (c), 0, 0, 0)
__device__ __forceinline__ i64 lo64(const u32x4& v) { return __builtin_bit_cast(i64, __builtin_shufflevector(v, v, 0, 1)); }
__device__ __forceinline__ i64 hi64(const u32x4& v) { return __builtin_bit_cast(i64, __builtin_shufflevector(v, v, 2, 3)); }
constexpr float F8_SH = 4.f;
constexpr float F8_SY = 16.f;
__device__ __forceinline__ void moe_convert(const Args& a, LAS unsigned char* lds, int vcu, int G) {
    const int lane = threadIdx.x & 63, wave = __builtin_amdgcn_readfirstlane(threadIdx.x >> 6);
    LAS float* scr = (LAS float*)(lds + wave * 8448);
    const int NIT = (NE + 1) * 48 * 8;
    for (int it = vcu * NWAVE + wave; it < NIT; it += G * NWAVE) {
        const int g = it & 7, T = (it >> 3) % 48, e = it / (48 * 8);
        const float* W1 = (e < NE) ? a.w1 + (size_t)e * D * ED : a.ws1; const float* W3 = (e < NE) ? a.w3 + (size_t)e * D * ED : a.ws3; const float* W2 = (e < NE) ? a.w2 + (size_t)e * ED * D : a.ws2;
        const float* src; int ld; float sc;
        if (T < 32) { src = ((lane & 32) ? W3 : W1) + (size_t)(32 * T) * ED + 32 * g - (lane & 32); ld = ED; sc = F8_S1; }
        else { const int t2 = T - 32, nh = t2 >> 3, ks = t2 & 7; src = W2 + (size_t)(32 * ks) * D + nh * 512 + 64 * g; ld = D; sc = F8_S2; }
#pragma unroll 8
        for (int k = 0; k < 32; ++k) scr[k * 65 + lane] = src[(size_t)k * ld + lane];
        asm volatile("s_waitcnt lgkmcnt(0)" ::: "memory");
        unsigned o[8];
#pragma unroll
        for (int d = 0; d < 8; ++d) { int p = __builtin_amdgcn_cvt_pk_fp8_f32(scr[(4 * d) * 65 + lane] * sc, scr[(4 * d + 1) * 65 + lane] * sc, 0, false);
            p = __builtin_amdgcn_cvt_pk_fp8_f32(scr[(4 * d + 2) * 65 + lane] * sc, scr[(4 * d + 3) * 65 + lane] * sc, p, true); o[d] = (unsigned)p; }
        unsigned char* dst = ((e < NE) ? a.ws + WS_HB + (size_t)e * F8_EXP_BYTES : a.ws + WS_WS13T) + (size_t)T * F8_TILE + (size_t)(64 * g + lane) * 32;
        *(u32x4*)dst = (u32x4){o[0], o[1], o[2], o[3]}; *(u32x4*)(dst + 16) = (u32x4){o[4], o[5], o[6], o[7]};
        asm volatile("s_waitcnt lgkmcnt(0)" ::: "memory");
    }
}
constexpr int M8_H = 0, M8_HSTR = 272, M8_Y = 36864;
__device__ __forceinline__ void moe_chunk8(const Args& a, LAS unsigned char* lds, int e, int ci) {
    int tid = threadIdx.x; asm volatile("" : "+v"(tid));
    const int lane = tid & 63, wave = __builtin_amdgcn_readfirstlane(tid >> 6), h = lane >> 5, l31 = lane & 31;
    const int* cnt = (const int*)(a.ws + C_CNT); const int* list = (const int*)(a.ws + WS_LIST); const float* ew = (const float*)(a.ws + WS_EW);
    const bool routed = e < NE;
    const unsigned char* X8 = a.ws + WS_X8;
    LAS int* rowa = (LAS int*)(lds + LDS_CTL_OFF + 384);
    const int n = routed ? min(128, cnt[e] - ci * 128) : 128;
#ifdef PROF_SECT
    unsigned long long* tsq = (unsigned long long*)(a.ws + C_TS); unsigned long long tq0 = __builtin_amdgcn_s_memrealtime();
#define SECT(i) do { if (blockIdx.x == 0 && threadIdx.x == 0) { const unsigned long long tq1 = __builtin_amdgcn_s_memrealtime(); tsq[21 + 2 * (i)] += tq1 - tq0; tq0 = tq1; } } while (0)
#else
#define SECT(i) do {} while (0)
#endif
    const unsigned char* f8 = (routed ? a.ws + WS_HB + (size_t)e * F8_EXP_BYTES : a.ws + WS_WS13T) + (size_t)(64 * wave + l31) * 32 + 16 * h;
    __syncthreads();
    if (tid < 128) rowa[tid] = (tid < n) ? (routed ? list[(size_t)e * NTOK + ci * 128 + tid] : ci * 128 + tid) : -1;
    __syncthreads();
    const int tsh = routed ? 3 : 0;
    {
        u32x4 xr[16];
#pragma unroll
        for (int i = 0; i < 16; ++i) { const int p = tid + NTHR * i, row = p >> 6, c = p & 63; const int ra = rowa[row];
            xr[i] = *(const u32x4*)(X8 + (size_t)((ra < 0) ? (p & (NTOK - 1)) : (ra >> tsh)) * D + c * 16); }
#pragma unroll
        for (int i = 0; i < 16; ++i) { const int p = tid + NTHR * i, row = p >> 6, c = p & 63; *(LAS u32x4*)(lds + row * 1040 + c * 16) = xr[i]; }
    }
    __syncthreads();
    SECT(0);
    f32x16 acc[4][2]; zero_acc(acc);
    typedef int i32x8 __attribute__((ext_vector_type(8)));
#define MFMAX(a8, b8, c) __builtin_amdgcn_mfma_scale_f32_32x32x64_f8f6f4((a8), (b8), (c), 0, 0, 0, 0x7f7f7f7f, 0, 0x7f7f7f7f)
    u32x4 wb[4][2][2];
    const unsigned char* f8h = f8 - 16 * h + (size_t)h * F8_TILE;
    const LAS unsigned char* xl = lds + l31 * 1040 + 32 * h;
    auto ld1 = [&](int d, int KS) { const unsigned char* p = f8h + (size_t)(2 * KS) * F8_TILE;
        wb[d][0][0] = *(const u32x4*)p; wb[d][0][1] = *(const u32x4*)(p + 16); wb[d][1][0] = *(const u32x4*)(p + 1024); wb[d][1][1] = *(const u32x4*)(p + 1040); };
    auto mk8 = [&](const u32x4 lo, const u32x4 hi) { return (i32x8){(int)lo.x, (int)lo.y, (int)lo.z, (int)lo.w, (int)hi.x, (int)hi.y, (int)hi.z, (int)hi.w}; };
#pragma unroll
    for (int d = 0; d < 4; ++d) ld1(d, d);
#pragma unroll 1
    for (int ks0 = 0; ks0 < 16; ks0 += 4) {
#pragma unroll
        for (int d = 0; d < 4; ++d) { const int KS = ks0 + d;
            const i32x8 b0 = mk8(wb[d][0][0], wb[d][0][1]), b1 = mk8(wb[d][1][0], wb[d][1][1]);
#pragma unroll
            for (int rb = 0; rb < 4; ++rb) { const i32x8 x = mk8(*(const LAS u32x4*)(xl + rb * 32 * 1040 + 64 * KS), *(const LAS u32x4*)(xl + rb * 32 * 1040 + 64 * KS + 16));
                acc[rb][0] = MFMAX(b0, x, acc[rb][0]); acc[rb][1] = MFMAX(b1, x, acc[rb][1]); }
            ld1(d, min(KS + 4, 12 + d)); asm volatile("" ::: "memory"); }
    }
    asm volatile("s_waitcnt vmcnt(0)" ::: "memory");
    auto ld2 = [&](int nh2) { const unsigned char* p2 = f8h + (size_t)(32 + nh2 * 8) * F8_TILE;
#pragma unroll
        for (int d = 0; d < 4; ++d) { const unsigned char* p = p2 + (size_t)(2 * d) * F8_TILE;
            wb[d][0][0] = *(const u32x4*)p; wb[d][0][1] = *(const u32x4*)(p + 16); wb[d][1][0] = *(const u32x4*)(p + 1024); wb[d][1][1] = *(const u32x4*)(p + 1040); } };
    __syncthreads();
    SECT(1);
    {
        const float s1 = 1.f / F8_S1;
#pragma unroll
        for (int rb = 0; rb < 4; ++rb) { const int row = rb * 32 + l31;
#pragma unroll
            for (int g4 = 0; g4 < 4; ++g4) { float hv[4];
#pragma unroll
                for (int e4 = 0; e4 < 4; ++e4) { const float gt = acc[rb][0][4 * g4 + e4] * s1, up = acc[rb][1][4 * g4 + e4] * s1; hv[e4] = fminf(fmaxf(gt * __builtin_amdgcn_rcpf(1.f + __expf(-gt)) * up * F8_SH, -440.f), 440.f); }
                int p = __builtin_amdgcn_cvt_pk_fp8_f32(hv[0], hv[1], 0, false); p = __builtin_amdgcn_cvt_pk_fp8_f32(hv[2], hv[3], p, true);
                *(LAS int*)(lds + M8_H + row * M8_HSTR + 32 * wave + 8 * g4 + 4 * h) = p; } }
    }
    ld2(0);
    __syncthreads();
    SECT(2);
    const LAS unsigned char* hp = lds + M8_H + l31 * M8_HSTR + 32 * h;
    for (int nh = 0; nh < 2; ++nh) {
        zero_acc(acc);
        if (nh == 1) ld2(1);
#pragma unroll
        for (int d = 0; d < 4; ++d) {
            const i32x8 b0 = mk8(wb[d][0][0], wb[d][0][1]), b1 = mk8(wb[d][1][0], wb[d][1][1]);
#pragma unroll
            for (int rb = 0; rb < 4; ++rb) { const i32x8 x = mk8(*(const LAS u32x4*)(hp + rb * 32 * M8_HSTR + 64 * d), *(const LAS u32x4*)(hp + rb * 32 * M8_HSTR + 64 * d + 16));
                acc[rb][0] = MFMAX(b0, x, acc[rb][0]); acc[rb][1] = MFMAX(b1, x, acc[rb][1]); }
        }
        SECT(3);
        const float s2 = F8_SY / (F8_S2 * F8_SH);
        unsigned char* Y8 = a.ws + (routed ? WS_YBUF : WS_YSH);
#pragma unroll
        for (int hf = 0; hf < 2; ++hf) {
            __syncthreads();
#pragma unroll
            for (int r2 = 0; r2 < 2; ++r2) { const int rb = hf * 2 + r2; const int aid = rowa[rb * 32 + l31]; const float wgt = (aid < 0) ? 0.f : (routed ? ew[aid] : 1.f) * s2;
                LAS unsigned char* yrow = lds + M8_Y + (r2 * 32 + l31) * 528 + wave * 64 + 4 * h;
#pragma unroll
                for (int cb = 0; cb < 2; ++cb)
#pragma unroll
                    for (int g4 = 0; g4 < 4; ++g4) { int p = __builtin_amdgcn_cvt_pk_fp8_f32(acc[rb][cb][4 * g4] * wgt, acc[rb][cb][4 * g4 + 1] * wgt, 0, false);
                        p = __builtin_amdgcn_cvt_pk_fp8_f32(acc[rb][cb][4 * g4 + 2] * wgt, acc[rb][cb][4 * g4 + 3] * wgt, p, true);
                        *(LAS int*)(yrow + cb * 32 + 8 * g4) = p; } }
            __syncthreads();
#pragma unroll
            for (int i = 0; i < 4; ++i) { const int lr = wave * 8 + i * 2 + h; const int ra = rowa[hf * 64 + lr];
                if (ra >= 0) *(u32x4*)(Y8 + (size_t)ra * D + nh * 512 + l31 * 16) = *(const LAS u32x4*)(lds + M8_Y + lr * 528 + l31 * 16); }
        }
        SECT(4);
    }
}
template <int PARTS>
__device__ __forceinline__ void phase6_v7(const Args& a, LAS unsigned char* lds, int vcu, int G, const XcdBarrier bar) {
    const int tid = threadIdx.x;
    const int* cnt = (const int*)(a.ws + C_CNT);
    if (PARTS & 1) moe_convert(a, lds, vcu, G);
    __syncthreads();
    xcd_barrier(bar);
    if (!(PARTS & 4)) return;
    LAS int* pf = (LAS int*)(lds + 65536);
    __syncthreads();
    if (tid < NE) pf[tid + 1] = (cnt[tid] + 127) >> 7;
    if (tid == 0) pf[0] = 0;
    __syncthreads();
    if (tid == 0) { int s = 0; for (int e = 0; e < NE; ++e) { s += pf[e + 1]; pf[e + 1] = s; } }
    __syncthreads();
    constexpr int NSH = NTOK / 128;
    const int total = NSH + pf[NE];
    LAS int* myu = (LAS int*)(lds + LDS_CTL_OFF + 256);
    int nmy = 0;
    for (int u = vcu; u < total; u += G) ++nmy;
    if (nmy > 16) nmy = 16;
    if (tid < nmy) { const int u = vcu + tid * G;
        if (u < NSH) { myu[tid] = NE; myu[16 + tid] = u; }
        else { const int ru = u - NSH; int lo = 0, hi = NE - 1; while (lo < hi) { const int mid = (lo + hi) >> 1; if (pf[mid + 1] > ru) hi = mid; else lo = mid + 1; }
            myu[tid] = lo; myu[16 + tid] = ru - pf[lo]; } }
    __syncthreads();
    for (int iu = 0; iu < nmy; ++iu) moe_chunk8(a, lds, myu[iu], myu[16 + iu]);
}
__device__ __forceinline__ void phase7(const Args& a, int vcu, int G) {
    const int lane = threadIdx.x & 63, gw = vcu * NWAVE + (threadIdx.x >> 6), NGW = G * NWAVE;
#ifdef PROF_K
    const unsigned long long* ts = (const unsigned long long*)(a.ws + C_TS);
    const float prof_b1 = rintf(log2f(fmaxf((float)(ts[PROF_K + 1] - ts[PROF_K]) * 0.01f, 1.f)) * 4.f), prof_us2 = exp2f(rintf(log2f(fmaxf((float)(ts[PROF_KE] - ts[PROF_K2]) * 0.01f, 1.f)) * 4.f) * 0.25f);
    const float prof_scale = 1.f + prof_b1 * PROF_S;
#else
    const float prof_scale = 1.f;
#endif
    const bf16* X1b = (const bf16*)(a.ws + WS_X1); const float* mod = (const float*)(a.ws + C_MOD);
    const unsigned char* YB = a.ws + WS_YBUF; const unsigned char* YS = a.ws + WS_YSH;
    for (int t = gw; t < NTOK; t += NGW) { const int b = t / S, c0 = lane * 16;
        float m[16];
        { const u32x4 w = *(const u32x4*)(YS + (size_t)t * D + c0);
#pragma unroll
          for (int d = 0; d < 4; ++d) { const auto lo = __builtin_amdgcn_cvt_pk_f32_fp8((int)w[d], false), hi = __builtin_amdgcn_cvt_pk_f32_fp8((int)w[d], true); m[4 * d] = lo[0]; m[4 * d + 1] = lo[1]; m[4 * d + 2] = hi[0]; m[4 * d + 3] = hi[1]; } }
#pragma unroll
        for (int r = 0; r < 8; ++r) { const u32x4 w = *(const u32x4*)(YB + ((size_t)t * 8 + r) * D + c0);
#pragma unroll
            for (int d = 0; d < 4; ++d) { const auto lo = __builtin_amdgcn_cvt_pk_f32_fp8((int)w[d], false), hi = __builtin_amdgcn_cvt_pk_f32_fp8((int)w[d], true); m[4 * d] += lo[0]; m[4 * d + 1] += lo[1]; m[4 * d + 2] += hi[0]; m[4 * d + 3] += hi[1]; } }
        f32x4 v[4]; float s = 0.f;
        const u32x4 xa = *(const u32x4*)(X1b + (size_t)t * D + c0), xb = *(const u32x4*)(X1b + (size_t)t * D + c0 + 8);
#pragma unroll
        for (int j = 0; j < 4; ++j) { const unsigned w0 = (j < 2) ? xa[2 * j] : xb[2 * j - 4], w1 = (j < 2) ? xa[2 * j + 1] : xb[2 * j - 3];
            const f32x4 xv = (f32x4){__uint_as_float(w0 << 16), __uint_as_float(w0 & 0xffff0000u), __uint_as_float(w1 << 16), __uint_as_float(w1 & 0xffff0000u)}, g2 = *(const f32x4*)(mod + b * 6 * D + 5 * D + c0 + 4 * j);
            v[j].x = xv.x + g2.x * m[4 * j] * (1.f / F8_SY); v[j].y = xv.y + g2.y * m[4 * j + 1] * (1.f / F8_SY); v[j].z = xv.z + g2.z * m[4 * j + 2] * (1.f / F8_SY); v[j].w = xv.w + g2.w * m[4 * j + 3] * (1.f / F8_SY);
            s += (v[j].x * v[j].x + v[j].y * v[j].y) + (v[j].z * v[j].z + v[j].w * v[j].w); }
        const float rstd = rsqrtf(wave_sum(s) * (1.f / D) + EPS);
#pragma unroll
        for (int j = 0; j < 4; ++j) { const f32x4 fg = *(const f32x4*)(a.final_g + c0 + 4 * j);
            f32x4 o; o.x = v[j].x * rstd * fg.x * prof_scale; o.y = v[j].y * rstd * fg.y * prof_scale; o.z = v[j].z * rstd * fg.z * prof_scale; o.w = v[j].w * rstd * fg.w * prof_scale;
#ifdef PROF_K
            if (t == 0 && lane == 0 && j == 0) o.x = prof_us2;
#endif
            *(f32x4*)(a.out + (size_t)t * D + c0 + 4 * j) = o; }
    }
}
__global__ void __launch_bounds__(NTHR, 2) mega(Args a) {
    extern __shared__ __attribute__((aligned(16))) unsigned char lds_raw[];
    LAS unsigned char* lds = (LAS unsigned char*)lds_raw;
    const int tid = threadIdx.x, G = gridDim.x;
    const int bx = blockIdx.x, vcu = (G % 8 == 0) ? (bx % 8) * (G / 8) + bx / 8 : bx;
    volatile LAS unsigned* ctl = (volatile LAS unsigned*)(lds + LDS_CTL_OFF);
    if (tid < 64) ctl[tid] = 0u;
    __syncthreads();
    XcdBarrier bar = xcd_barrier_post((unsigned*)(a.ws + C_BAR) + a.ph_lo * XCD_BAR_WORDS, ctl);
    const int lo = a.ph_lo, hi = a.ph_hi;
#ifndef ONLY_PHASE
#define ONLY_PHASE -1
#endif
#define IN(k) (lo <= (k) && (k) < hi && (ONLY_PHASE < 0 || ONLY_PHASE == (k)))
#ifndef XBAR
#define XBAR 1
#endif
#ifdef PROF_K
#define STAMP(i) do { if (blockIdx.x == 0 && tid == 0) ((unsigned long long*)(a.ws + C_TS))[i] = __builtin_amdgcn_s_memrealtime(); } while (0)
#else
#define STAMP(i) do {} while (0)
#endif
#define SEAM(k) do { if (IN(k) && IN((k) + 1)) { STAMP(2 * (k) + 1); for (int xb = 0; xb < XBAR; ++xb) xcd_barrier(bar); STAMP(2 * (k) + 2); } } while (0)
    STAMP(0);
#ifndef REP_PHASE
#define REP_PHASE -1
#endif
#ifndef REP_N
#define REP_N 1
#endif
#define NREP(k) ((REP_PHASE == (k)) ? REP_N : 1)
    if (IN(0))
#pragma unroll 1
    for (int rep = 0; rep < NREP(0); ++rep) { phase0(a, lds, vcu, G); __syncthreads(); }
    SEAM(0);
    if (IN(1)) for (int rep = 0; rep < NREP(1); ++rep) phase1(a, vcu, G);
    SEAM(1);
    if (IN(2)) for (int rep = 0; rep < NREP(2); ++rep) phase2(a, lds, vcu, G);
    SEAM(2);
#ifndef PROBE_A
#define PROBE_A 0
#endif
    if (IN(3)) for (int rep = (PROBE_A ? 0 : 1); rep < 2; ++rep) { phase3(a, lds, vcu, G, rep == 0 ? PROBE_A : 0); __syncthreads(); }
    SEAM(3);
#if FUSE45
#ifdef PROBE_45
    if (IN(4)) { phase45<PROBE_45>(a, lds, vcu, G); __syncthreads(); }
#endif
    if (IN(4)) phase45<0>(a, lds, vcu, G);
#else
    if (IN(4)) for (int rep = 0; rep < NREP(4); ++rep) phase4(a, lds, vcu, G);
    SEAM(4);
    if (IN(5)) for (int rep = 0; rep < NREP(5); ++rep) phase5(a, lds, vcu, G, rep > 0);
#endif
    SEAM(5);
#ifndef MOE_V2
#define MOE_V2 7
#endif
#ifdef PROBE_MOE
    if (IN(6)) { phase6_v7<PROBE_MOE>(a, lds, vcu, G, bar); xcd_barrier(bar); }
#endif
    if (IN(6)) for (int rep = 0; rep < NREP(6); ++rep) { if (MOE_V2 == 7) phase6_v7<7>(a, lds, vcu, G, bar); else if (MOE_V2 == 6) phase6_v6<7>(a, lds, vcu, G, bar); else if (MOE_V2 == 3) phase6<0>(a, lds, vcu, G); else if (MOE_V2 == 2) phase6_v2(a, lds, vcu, G); else phase6_old(a, lds, vcu, G, bar, false); }
    SEAM(6);
    if (IN(7)) for (int rep = 0; rep < NREP(7); ++rep) phase7(a, vcu, G);
#undef IN
#undef SEAM
}

#ifndef OPT_MASK
#define OPT_MASK 0xFF
#endif
static void launch_mega(const Args& base, int lo, int hi, int grid, hipStream_t stream) {
    Args a = base; a.ph_lo = lo; a.ph_hi = hi;
    hipLaunchKernelGGL(mega, dim3(grid), dim3(NTHR), LDS_BYTES, stream, a);
}
extern "C" void kernel_launch(void* const* d_in, const int* in_sizes, int n_in, void* d_out, int out_size, void* d_ws, size_t ws_size, hipStream_t stream) {
    static int grid = 0;
    if (grid == 0) {
        if (n_in != 21 || ws_size < WS_END) { fprintf(stderr, "kernel_launch: unexpected n_in %d or ws_size %zu\n", n_in, ws_size); grid = -1; return; }
        int dev = 0, cus = 0, per_cu = 0;
        if (hipGetDevice(&dev) != hipSuccess || hipDeviceGetAttribute(&cus, hipDeviceAttributeMultiprocessorCount, dev) != hipSuccess) { grid = -1; return; }
        if (hipFuncSetAttribute((const void*)mega, hipFuncAttributeMaxDynamicSharedMemorySize, LDS_BYTES) != hipSuccess) { fprintf(stderr, "kernel_launch: hipFuncSetAttribute failed\n"); grid = -1; return; }
        if (hipOccupancyMaxActiveBlocksPerMultiprocessor(&per_cu, (const void*)mega, NTHR, LDS_BYTES) != hipSuccess || per_cu < 1) { fprintf(stderr, "kernel_launch: occupancy query says %d blocks per CU\n", per_cu); (void)hipGetLastError(); grid = -1; return; }
        grid = cus;
    }
    if (grid < 0) return;
    unsigned char* ws = (unsigned char*)d_ws;
    Args a{};
    a.x = (const float*)d_in[0]; a.c = (const float*)d_in[1]; a.w_ada = (const float*)d_in[2]; a.b_ada = (const float*)d_in[3]; a.norm1_g = (const float*)d_in[4]; a.w_in = (const float*)d_in[5];
    a.sinks = (const float*)d_in[6]; a.rel_table = (const float*)d_in[7]; a.out_norm_a = (const float*)d_in[8]; a.out_norm_b = (const float*)d_in[9]; a.w_out = (const float*)d_in[10];
    a.norm2_g = (const float*)d_in[11]; a.w_router = (const float*)d_in[12]; a.e_bias = (const float*)d_in[13]; a.w1 = (const float*)d_in[14]; a.w3 = (const float*)d_in[15]; a.w2 = (const float*)d_in[16];
    a.ws1 = (const float*)d_in[17]; a.ws3 = (const float*)d_in[18]; a.ws2 = (const float*)d_in[19]; a.final_g = (const float*)d_in[20];
    a.out = (float*)d_out; a.ws = ws; a.ph_lo = 0; a.ph_hi = 8;
    (void)hipMemsetAsync(ws + WS_CTL, 0, CTL_BYTES, stream);
#if defined(P0_TIMING)
    for (int r = 0; r < P0_TIMING; ++r) launch_mega(a, 0, 1, grid, stream);
    launch_mega(a, 1, 8, grid, stream);
#elif OPT_MASK == 0xFF && !defined(SPLIT_LAUNCH)
    launch_mega(a, 0, 8, grid, stream);
#else
    float* mod = (float*)(ws + C_MOD); float* ksum = (float*)(ws + C_KSUM); float* ssq = (float*)(ws + WS_SSQ); int* cnt = (int*)(ws + C_CNT);
    float* lut = (float*)(ws + WS_LUT); bf16* H = (bf16*)(ws + WS_H);
    bf16* QA = (bf16*)(ws + WS_QA); bf16* KA = (bf16*)(ws + WS_KA); bf16* VAT = (bf16*)(ws + WS_VAT); bf16* QB = (bf16*)(ws + WS_QB); bf16* KB = (bf16*)(ws + WS_KB); bf16* VBT = (bf16*)(ws + WS_VBT);
    bf16* ATT = (bf16*)(ws + WS_ATT); float* X1 = (float*)(ws + WS_X1); bf16* H2 = (bf16*)(ws + WS_H2); float* EW = (float*)(ws + WS_EW); int* LIST = (int*)(ws + WS_LIST);
    bf16* YSH = (bf16*)(ws + WS_YSH); bf16* YBUF = (bf16*)(ws + WS_YBUF);
    if (OPT_MASK & 1) launch_mega(a, 0, 1, grid, stream); else { k_mod<<<24, 256, 0, stream>>>(a.c, a.w_ada, a.b_ada, mod); k_lut<<<(16 * LUTN + 255) / 256, 256, 0, stream>>>(a.rel_table, lut); }
    if (OPT_MASK & 2) launch_mega(a, 1, 2, grid, stream); else k_norm_mod<<<NTOK, 256, 0, stream>>>(a.x, a.norm1_g, mod, 0, D, H);
    if (OPT_MASK & 4) launch_mega(a, 2, 3, grid, stream); else k_inproj<<<dim3(INC / 256, NTOK), 256, 0, stream>>>(H, a.w_in, QA, KA, VAT, QB, KB, VBT, ksum);
    if (OPT_MASK & 8) launch_mega(a, 3, 4, grid, stream); else { k_swa<<<NTOK * 8 / 64, 64, 0, stream>>>(QA, KA, VAT, lut, a.sinks, a.out_norm_a, ATT, ssq); k_moba<<<NTOK * 8 / 64, 64, 0, stream>>>(QB, KB, VBT, ksum, lut, a.out_norm_b, ATT, ssq); }
    if (OPT_MASK & 16) launch_mega(a, 4, 5, grid, stream); else k_outproj<<<dim3(D / 256, NTOK), 256, 0, stream>>>(ATT, ssq, a.w_out, a.x, mod, X1);
    if (OPT_MASK & 32) launch_mega(a, 5, 6, grid, stream); else { k_norm_mod<<<NTOK, 256, 0, stream>>>(X1, a.norm2_g, mod, 3 * D, 4 * D, H2); k_router<<<NTOK, 256, 0, stream>>>(H2, a.w_router, a.e_bias, cnt, LIST, EW); }
    if (OPT_MASK & 64) launch_mega(a, 6, 7, grid, stream); else k_moe<<<dim3(NTOK / 8, NE + 1), 256, 0, stream>>>(H2, cnt, LIST, EW, a.w1, a.w3, a.w2, a.ws1, a.ws3, a.ws2, YBUF, YSH);
    if (OPT_MASK & 128) launch_mega(a, 7, 8, grid, stream); else k_final<<<NTOK, 256, 0, stream>>>(X1, YBUF, YSH, mod, a.final_g, (float*)d_out);
#endif
}
```
